# Optimizing an MI355X kernel written in HIP

```python
import math
import jax, jax.numpy as jnp
from jax import lax
import numpy as np

D_MODEL = 1024
BATCH = 2
SEQ = 16384
DEPTH = 2
DEC_BATCH = 16
DEC_SEQ = 16
PAST_LEN = 1024

CHUNK = 64
D_MIX = D_MODEL
D_A = D_MIX // 4
D_B = D_MIX // 2
D_C = D_MIX // 4
CONV_A_WIDTH = 3
CONV_C_WIDTH = 31
HEAD_DIM = 64
N_HEADS = D_B // HEAD_DIM
N_KV_HEADS = 2
GROUP = N_HEADS // N_KV_HEADS
KV_DIM = N_KV_HEADS * HEAD_DIM
WINDOW = 128
WINDOW_CHUNKS = WINDOW // CHUNK
D_IN_A = 3 * D_A
D_IN_B = D_B + 2 * KV_DIM
D_IN_C = 2 * D_C
D_IN = D_IN_A + D_IN_B + D_IN_C
XA_HEADS = 4
XA_HEAD_DIM = D_MODEL // XA_HEADS
N_MEM = 256
D_FF = 2816
ROPE_THETA = 10000.0
EPS = 1e-6
NEG_INF = -1e30

kernel_name = "hybrid_streaming_encoder_step"


def rms_norm(x, g):
    xf = x.astype(jnp.float32)
    y = xf * lax.rsqrt(jnp.mean(xf * xf, axis=-1, keepdims=True) + EPS)
    return (y * g.astype(jnp.float32)).astype(x.dtype)


def layer_norm(x, g, b):
    xf = x.astype(jnp.float32)
    mu = jnp.mean(xf, axis=-1, keepdims=True)
    xc = xf - mu
    var = jnp.mean(xc * xc, axis=-1, keepdims=True)
    y = xc * lax.rsqrt(var + EPS) * g.astype(jnp.float32) + b.astype(jnp.float32)
    return y.astype(x.dtype)


def swiglu(x, wg, wu, wd):
    return (jax.nn.silu(x @ wg) * (x @ wu)) @ wd


def rope(x, pos):
    half = HEAD_DIM // 2
    inv = 1.0 / (ROPE_THETA ** (jnp.arange(half, dtype=jnp.float32) / half))
    ang = pos.astype(jnp.float32)[:, None] * inv[None, :]
    cos = jnp.cos(ang)[:, None, :]
    sin = jnp.sin(ang)[:, None, :]
    xf = x.astype(jnp.float32)
    x1, x2 = xf[..., :half], xf[..., half:]
    out = jnp.concatenate([x1 * cos - x2 * sin, x2 * cos + x1 * sin], axis=-1)
    return out.astype(x.dtype)


def causal_dwconv(x, prev, w):
    width = w.shape[0]
    xp = jnp.concatenate([prev.astype(x.dtype), x], axis=1)
    y = lax.conv_general_dilated(xp, w[:, None, :].astype(x.dtype), window_strides=(1,), padding='VALID',
                                 dimension_numbers=('NWC', 'WIO', 'NWC'), feature_group_count=x.shape[-1])
    return y, xp[:, -(width - 1):]


def attend_with_sinks(q, k, v, sinks, mask):
    s = jnp.einsum('...qkgd,...jkd->...kgqj', q, k, preferred_element_type=jnp.float32) * (HEAD_DIM ** -0.5)
    if mask is not None:
        s = jnp.where(mask, s, NEG_INF)
    sk = sinks.astype(jnp.float32).reshape(N_KV_HEADS, GROUP)[:, :, None, None]
    m = jnp.maximum(jnp.max(s, axis=-1, keepdims=True), sk)
    p = jnp.exp(s - m)
    p = p / (jnp.sum(p, axis=-1, keepdims=True) + jnp.exp(sk - m))
    return jnp.einsum('...kgqj,...jkd->...qkgd', p.astype(v.dtype), v)


def swa_prompt(q, k, v, sinks):
    B, S = q.shape[:2]
    n_blk = S // CHUNK
    qb = q.reshape(B, n_blk, CHUNK, N_KV_HEADS, GROUP, HEAD_DIM)
    pad = ((0, 0), (WINDOW_CHUNKS * CHUNK, 0), (0, 0), (0, 0))
    kc = jnp.pad(k, pad).reshape(B, n_blk + WINDOW_CHUNKS, CHUNK, N_KV_HEADS, HEAD_DIM)
    vc = jnp.pad(v, pad).reshape(B, n_blk + WINDOW_CHUNKS, CHUNK, N_KV_HEADS, HEAD_DIM)
    kb = jnp.concatenate([kc[:, j:j + n_blk] for j in range(WINDOW_CHUNKS + 1)], axis=2)
    vb = jnp.concatenate([vc[:, j:j + n_blk] for j in range(WINDOW_CHUNKS + 1)], axis=2)
    key_chunk = jnp.arange(n_blk)[:, None] - WINDOW_CHUNKS + jnp.arange(WINDOW_CHUNKS + 1)[None, :]
    valid = jnp.repeat(key_chunk >= 0, CHUNK, axis=1)
    mask = valid[None, :, None, None, None, :]
    o = attend_with_sinks(qb, kb, vb, sinks, mask)
    return o.reshape(B, S, D_B)


def swa_sample(q, k_new, v_new, past_k, past_v, sinks):
    B, S = q.shape[:2]
    qb = q.reshape(B, S, N_KV_HEADS, GROUP, HEAD_DIM)
    kk = jnp.concatenate([past_k.astype(k_new.dtype), k_new], axis=1)
    vv = jnp.concatenate([past_v.astype(v_new.dtype), v_new], axis=1)
    o = attend_with_sinks(qb, kk, vv, sinks, None)
    return o.reshape(B, S, D_B)


def mixer_block(h, pos, prev_a, prev_c, past_k, past_v, p):
    B, S = h.shape[:2]
    u = h @ p['w_in']
    ua = u[..., :D_IN_A]
    ub = u[..., D_IN_A:D_IN_A + D_IN_B]
    uc = u[..., D_IN_A + D_IN_B:]
    gate_b, gate_c, xv = jnp.split(ua, 3, axis=-1)
    conv_a, new_a = causal_dwconv(gate_c * xv, prev_a, p['conv_a_w'])
    y_a = gate_b * conv_a
    q = rope(ub[..., :D_B].reshape(B, S, N_HEADS, HEAD_DIM), pos)
    k = rope(ub[..., D_B:D_B + KV_DIM].reshape(B, S, N_KV_HEADS, HEAD_DIM), pos)
    v = ub[..., D_B + KV_DIM:].reshape(B, S, N_KV_HEADS, HEAD_DIM)
    if past_k is None:
        y_b = swa_prompt(q, k, v, p['swa_sinks'])
        new_k, new_v = k[:, -WINDOW:], v[:, -WINDOW:]
    else:
        y_b = swa_sample(q, k, v, past_k, past_v, p['swa_sinks'])
        new_k, new_v = k, v
    glu = uc[..., :D_C] * jax.nn.sigmoid(uc[..., D_C:])
    conv_c, new_c = causal_dwconv(glu, prev_c, p['conv_c_w'])
    conv_c = conv_c + p['conv_c_b']
    y_c = jax.nn.silu(layer_norm(conv_c, p['conv_c_ln_g'], p['conv_c_ln_b']))
    g = p['mix_out_norm']
    y = jnp.concatenate([rms_norm(y_a, g[:D_A]), rms_norm(y_b, g[D_A:D_A + D_B]), rms_norm(y_c, g[D_A + D_B:])], axis=-1)
    return y @ p['w_out'], new_a, new_c, new_k, new_v


def memory_kv(mem, g, wk, wv):
    B = mem.shape[0]
    m = rms_norm(mem, g)
    return ((m @ wk).reshape(B, N_MEM, XA_HEADS, XA_HEAD_DIM), (m @ wv).reshape(B, N_MEM, XA_HEADS, XA_HEAD_DIM))


def cross_attend(h, mk, mv, wq, wo):
    B, S = h.shape[:2]
    q = (h @ wq).reshape(B, S, XA_HEADS, XA_HEAD_DIM)
    s = jnp.einsum('bqhd,bjhd->bhqj', q, mk.astype(q.dtype), preferred_element_type=jnp.float32) * (XA_HEAD_DIM ** -0.5)
    pr = jax.nn.softmax(s, axis=-1)
    o = jnp.einsum('bhqj,bjhd->bqhd', pr.astype(q.dtype), mv.astype(q.dtype)).reshape(B, S, D_MODEL)
    return o @ wo


def layer(x, pos, mem_k, mem_v, prev_a, prev_c, past_k, past_v, p):
    x = x + 0.5 * swiglu(rms_norm(x, p['ffn1_norm']), p['ffn1_wg'], p['ffn1_wu'], p['ffn1_wd'])
    y_mix, new_a, new_c, new_k, new_v = mixer_block(rms_norm(x, p['mix_norm']), pos, prev_a, prev_c, past_k, past_v, p)
    x = x + y_mix
    x = x + cross_attend(rms_norm(x, p['xattn_norm']), mem_k, mem_v, p['xattn_wq'], p['xattn_wo'])
    x = x + 0.5 * swiglu(rms_norm(x, p['ffn2_norm']), p['ffn2_wg'], p['ffn2_wu'], p['ffn2_wd'])
    return x, new_k, new_v, new_a, new_c


def setup_inputs(seed: int = 0) -> dict:
    key = jax.random.key(seed)
    ks = iter(jax.random.split(key, 40))

    def nrm(shape, scale):
        return scale * jax.random.normal(next(ks), shape, jnp.float32)

    def gain(shape):
        return 1.0 + 0.05 * jax.random.normal(next(ks), shape, jnp.float32)

    swa_cache = min(WINDOW, PAST_LEN)
    L = DEPTH
    return {
        'x_prompt': nrm((BATCH, SEQ, D_MODEL), 1.0),
        'x_sample': nrm((DEC_BATCH, DEC_SEQ, D_MODEL), 1.0),
        'cache_swa_k': nrm((L, DEC_BATCH, swa_cache, N_KV_HEADS, HEAD_DIM), 1.0),
        'cache_swa_v': nrm((L, DEC_BATCH, swa_cache, N_KV_HEADS, HEAD_DIM), 1.0),
        'state_conv_a': nrm((L, DEC_BATCH, CONV_A_WIDTH - 1, D_A), 1.0),
        'state_conv_c': nrm((L, DEC_BATCH, CONV_C_WIDTH - 1, D_C), 1.0),
        'cache_mem_k': nrm((L, DEC_BATCH, N_MEM, XA_HEADS, XA_HEAD_DIM), 1.0),
        'cache_mem_v': nrm((L, DEC_BATCH, N_MEM, XA_HEADS, XA_HEAD_DIM), 1.0),
        'mem_prompt': nrm((BATCH, N_MEM, D_MODEL), 1.0),
        'ffn1_norm': gain((L, D_MODEL)),
        'ffn1_wg': nrm((L, D_MODEL, D_FF), D_MODEL ** -0.5),
        'ffn1_wu': nrm((L, D_MODEL, D_FF), D_MODEL ** -0.5),
        'ffn1_wd': nrm((L, D_FF, D_MODEL), D_FF ** -0.5),
        'mix_norm': gain((L, D_MODEL)),
        'w_in': nrm((L, D_MODEL, D_IN), D_MODEL ** -0.5),
        'conv_a_w': nrm((L, CONV_A_WIDTH, D_A), CONV_A_WIDTH ** -0.5),
        'swa_sinks': nrm((L, N_HEADS), 0.5),
        'conv_c_w': nrm((L, CONV_C_WIDTH, D_C), CONV_C_WIDTH ** -0.5),
        'conv_c_b': nrm((L, D_C), 0.01),
        'conv_c_ln_g': gain((L, D_C)),
        'conv_c_ln_b': nrm((L, D_C), 0.01),
        'mix_out_norm': gain((L, D_MIX)),
        'w_out': nrm((L, D_MIX, D_MODEL), D_MIX ** -0.5),
        'xattn_norm': gain((L, D_MODEL)),
        'mem_norm': gain((L, D_MODEL)),
        'xattn_wq': nrm((L, D_MODEL, D_MODEL), D_MODEL ** -0.5),
        'xattn_wk': nrm((L, D_MODEL, D_MODEL), D_MODEL ** -0.5),
        'xattn_wv': nrm((L, D_MODEL, D_MODEL), D_MODEL ** -0.5),
        'xattn_wo': nrm((L, D_MODEL, D_MODEL), D_MODEL ** -0.5),
        'ffn2_norm': gain((L, D_MODEL)),
        'ffn2_wg': nrm((L, D_MODEL, D_FF), D_MODEL ** -0.5),
        'ffn2_wu': nrm((L, D_MODEL, D_FF), D_MODEL ** -0.5),
        'ffn2_wd': nrm((L, D_FF, D_MODEL), D_FF ** -0.5),
        'final_norm': gain((D_MODEL,)),
    }


def reference(x_prompt, x_sample, cache_swa_k, cache_swa_v, state_conv_a, state_conv_c, cache_mem_k, cache_mem_v,
              mem_prompt, ffn1_norm, ffn1_wg, ffn1_wu, ffn1_wd, mix_norm, w_in, conv_a_w, swa_sinks, conv_c_w,
              conv_c_b, conv_c_ln_g, conv_c_ln_b, mix_out_norm, w_out, xattn_norm, mem_norm, xattn_wq, xattn_wk,
              xattn_wv, xattn_wo, ffn2_norm, ffn2_wg, ffn2_wu, ffn2_wd, final_norm):
    B, S = x_prompt.shape[:2]
    DS = x_sample.shape[1]
    pos_p = jnp.arange(S)
    pos_s = PAST_LEN + jnp.arange(DS)
    zeros_a = jnp.zeros((B, CONV_A_WIDTH - 1, D_A), x_prompt.dtype)
    zeros_c = jnp.zeros((B, CONV_C_WIDTH - 1, D_C), x_prompt.dtype)
    xp, xs = x_prompt, x_sample
    kp_l, vp_l, ap_l, cp_l, mkp_l, mvp_l = [], [], [], [], [], []
    ks_l, vs_l, as_l, cs_l = [], [], [], []
    for l in range(DEPTH):
        p = {
            'ffn1_norm': ffn1_norm[l], 'ffn1_wg': ffn1_wg[l], 'ffn1_wu': ffn1_wu[l], 'ffn1_wd': ffn1_wd[l],
            'mix_norm': mix_norm[l], 'w_in': w_in[l], 'conv_a_w': conv_a_w[l], 'swa_sinks': swa_sinks[l],
            'conv_c_w': conv_c_w[l], 'conv_c_b': conv_c_b[l], 'conv_c_ln_g': conv_c_ln_g[l],
            'conv_c_ln_b': conv_c_ln_b[l], 'mix_out_norm': mix_out_norm[l], 'w_out': w_out[l],
            'xattn_norm': xattn_norm[l], 'xattn_wq': xattn_wq[l], 'xattn_wo': xattn_wo[l],
            'ffn2_norm': ffn2_norm[l], 'ffn2_wg': ffn2_wg[l], 'ffn2_wu': ffn2_wu[l], 'ffn2_wd': ffn2_wd[l],
        }
        mk_p, mv_p = memory_kv(mem_prompt, mem_norm[l], xattn_wk[l], xattn_wv[l])
        xp, k_p, v_p, a_p, c_p = layer(xp, pos_p, mk_p, mv_p, zeros_a, zeros_c, None, None, p)
        xs, k_s, v_s, a_s, c_s = layer(xs, pos_s, cache_mem_k[l], cache_mem_v[l], state_conv_a[l], state_conv_c[l],
                                       cache_swa_k[l], cache_swa_v[l], p)
        kp_l.append(k_p); vp_l.append(v_p); ap_l.append(a_p); cp_l.append(c_p)
        mkp_l.append(mk_p); mvp_l.append(mv_p)
        ks_l.append(k_s); vs_l.append(v_s); as_l.append(a_s); cs_l.append(c_s)
    y_prompt = rms_norm(xp, final_norm)
    y_sample = rms_norm(xs, final_norm)
    return (y_prompt, y_sample,
            jnp.stack(kp_l), jnp.stack(vp_l), jnp.stack(ap_l), jnp.stack(cp_l), jnp.stack(mkp_l), jnp.stack(mvp_l),
            jnp.stack(ks_l), jnp.stack(vs_l), jnp.stack(as_l), jnp.stack(cs_l))
```

```cpp
#include <hip/hip_runtime.h>
#include <hip/hip_cooperative_groups.h>
#include <cstdio>
#include <cstdint>
namespace cg = cooperative_groups;
#ifndef PROBE
#define PROBE 0
#endif
namespace pg8 {
#define PG8_LAS __attribute__((address_space(3)))
typedef unsigned short bf16_t;
typedef short bf16x8 __attribute__((ext_vector_type(8)));
typedef float f32x4 __attribute__((ext_vector_type(4)));
typedef unsigned u32x4 __attribute__((ext_vector_type(4)));
constexpr int BM = 256, BK = 64, HALF = 128, HTB = HALF * BK * 2  , STAGE_BYTES = 8 * HTB, NXCD = 8, WGM = 8;

__host__ __device__ __forceinline__ int lds_byte(int r, int c) { const int st = (r >> 4) * 2 + (c >> 5), rr = r & 15, cc = c & 31, ob = rr * 64 + cc * 2; return st * 1024 + (ob ^ (((ob >> 9) & 1) << 5)); }
__host__ __device__ __forceinline__ void stage_rc(int b, int& R, int& C) { const int st = b / 1024, sb = b % 1024, swz = sb ^ (((sb >> 9) & 1) << 5); R = (st >> 1) * 16 + swz / 64; C = (st & 1) * 32 + (swz % 64) / 2; }
__host__ __device__ __forceinline__ int perm32(int rho) { const int n = rho >> 4, i = rho & 15; return 8 * (i >> 2) + 4 * n + (i & 3); }


struct Unit { int pm, pn; size_t aoff, boff; int npm, par; };
struct Gemm { const bf16_t* A; const bf16_t* Bt; int lda, ldb, K, wv; };

template <int NM, int NN, size_t A_M, size_t A_N, size_t B_B, size_t B_N, int BSHIFT> struct Sched {
    int G, c;
    __device__ bool next(int i, Unit& u) const {
        constexpr int nwg = NM * NN;
        const long L = (long)i * G + c; if (L >= nwg) return false;
        int wgid = (int)L; { constexpr int q = nwg / NXCD, r = nwg % NXCD; const int xcd = wgid % NXCD, off = wgid / NXCD; wgid = (xcd < r ? xcd * (q + 1) : r * (q + 1) + (xcd - r) * q) + off; }
        constexpr int nig = WGM * NN; const int gid = wgid / nig, fm = gid * WGM, gsz = (NM - fm) < WGM ? (NM - fm) : WGM;
        u.pm = fm + ((wgid % nig) % gsz); u.pn = (wgid % nig) / gsz;
        u.aoff = (size_t)u.pm * A_M + (size_t)u.pn * A_N; u.boff = (size_t)(u.pm >> BSHIFT) * B_B + (size_t)u.pn * B_N; return true;
    }
    __device__ __forceinline__ void a_ready(const Unit&) const {}
    __device__ __forceinline__ void done(const Unit&) const {}
};
template <class Epi, class Sched, bool ALIGN_EPI = false, bool SP2 = false>
__device__ __forceinline__ void gemm_phase(PG8_LAS unsigned char* lds, const Gemm g, const Sched& S, const Epi& E) {
    unsigned z_ = 0u; asm volatile("" : "+v"(z_)); const int tid_ = g.wv * 64 + (int)__builtin_amdgcn_mbcnt_hi(~0u, __builtin_amdgcn_mbcnt_lo(~0u, z_)); const int tid = tid_, wid = __builtin_amdgcn_readfirstlane(tid >> 6), lane = tid & 63, wr = wid >> 2, wc = wid & 3, fr = lane & 15, fq = lane >> 4;
    const int K = g.K, nt = K / BK;
    unsigned voffA[2], voffB[2];
#pragma unroll
    for (int i = 0; i < 2; ++i) { int R, C; stage_rc(tid * 16 + i * 8192, R, C); const int Rb = Epi::PERM ? ((R & ~31) + perm32(R & 31)) : R;
        voffA[i] = (unsigned)(R * g.lda + C) * 2u; voffB[i] = (unsigned)(Rb * g.ldb + C) * 2u; }
    const size_t kstep = (size_t)(BK * 2);
    const size_t hstepA = (size_t)HALF * g.lda * 2, hstepB = (size_t)HALF * g.ldb * 2;
    const unsigned ldsw = (unsigned)wid * 1024u;
    const int aoff = lds_byte(wr * 64 + fr, fq * 8), boff = lds_byte(wc * 32 + fr, fq * 8);
#define PG8_SA(b, h) (((b) * 2 + (h)) * HTB)
#define PG8_SB(b, h) ((4 + (b) * 2 + (h)) * HTB)
#define PG8_STAGE(bufoff, gbase, voff) do { _Pragma("unroll") for (int _i = 0; _i < 2; ++_i) \
        __builtin_amdgcn_global_load_lds((const unsigned*)((const char*)(gbase) + (voff)[_i]), (PG8_LAS unsigned*)(lds + (bufoff) + ldsw + _i * 8192), 16, 0, 0); } while (0)
#define PG8_LDA(dst, b, h) do { _Pragma("unroll") for (int m = 0; m < 4; ++m) _Pragma("unroll") for (int k = 0; k < 2; ++k) dst[m][k] = *(const PG8_LAS bf16x8*)(lds + PG8_SA(b, h) + aoff + m * 2048 + k * 1024); } while (0)
#define PG8_LDB(dst, b, h) do { _Pragma("unroll") for (int n = 0; n < 2; ++n) _Pragma("unroll") for (int k = 0; k < 2; ++k) dst[n][k] = *(const PG8_LAS bf16x8*)(lds + PG8_SB(b, h) + boff + n * 2048 + k * 1024); } while (0)
#define PG8_MMA(ai, bj, At, Bt) do { __builtin_amdgcn_s_setprio(1); _Pragma("unroll") for (int m = 0; m < 4; ++m) _Pragma("unroll") for (int n = 0; n < 2; ++n) _Pragma("unroll") for (int k = 0; k < 2; ++k) \
        acc[ai][bj][m][n] = __builtin_amdgcn_mfma_f32_16x16x32_bf16(Bt[n][k], At[m][k], acc[ai][bj][m][n], 0, 0, 0); __builtin_amdgcn_s_setprio(0); } while (0)
#define PG8_WAIT_V(n) asm volatile("s_waitcnt vmcnt(" #n ")" ::: "memory")
#define PG8_WAIT_L(n) asm volatile("s_waitcnt lgkmcnt(" #n ")" ::: "memory")
#define PG8_BAR __builtin_amdgcn_s_barrier()
#define PG8_SCHED __builtin_amdgcn_sched_barrier(0)
    Unit cur, nxt; int ui = 0;
    if (!S.next(0, cur)) return;
    f32x4 acc[2][2][4][2];
#pragma unroll
    for (int a = 0; a < 2; ++a)
#pragma unroll
        for (int b = 0; b < 2; ++b)
#pragma unroll
            for (int m = 0; m < 4; ++m)
#pragma unroll
                for (int n = 0; n < 2; ++n) acc[a][b][m][n] = (f32x4){0.f, 0.f, 0.f, 0.f};
    bf16x8 At[4][2], B0[2][2], B1[2][2];
    const char* cA = (const char*)g.A + cur.aoff; const char* cB = (const char*)g.Bt + cur.boff;
    S.a_ready(cur);
    if constexpr (SP2) {
        PG8_STAGE(PG8_SB(0, 0), cB, voffB); PG8_STAGE(PG8_SB(0, 1), cB + hstepB, voffB); PG8_STAGE(PG8_SA(0, 0), cA, voffA); PG8_STAGE(PG8_SA(0, 1), cA + hstepA, voffA);
        if (wr == 1) PG8_BAR;
        PG8_WAIT_V(2); PG8_BAR;
        PG8_STAGE(PG8_SB(1, 0), cB + kstep, voffB); PG8_STAGE(PG8_SA(1, 0), cA + kstep, voffA); PG8_STAGE(PG8_SB(1, 1), cB + hstepB + kstep, voffB);
        PG8_WAIT_V(6); PG8_BAR;
    } else {
        PG8_STAGE(PG8_SB(0, 0), cB, voffB); PG8_STAGE(PG8_SA(0, 0), cA, voffA); PG8_STAGE(PG8_SB(0, 1), cB + hstepB, voffB); PG8_STAGE(PG8_SA(0, 1), cA + hstepA, voffA);
        if (wr == 1) PG8_BAR;
        PG8_WAIT_V(4); PG8_BAR;
        PG8_STAGE(PG8_SB(1, 0), cB + kstep, voffB); PG8_STAGE(PG8_SA(1, 0), cA + kstep, voffA); PG8_STAGE(PG8_SB(1, 1), cB + hstepB + kstep, voffB);
        PG8_WAIT_V(6); PG8_BAR;
    }
    for (;;) {
        const bool has_next = S.next(ui + 1, nxt);
        const char* nA = has_next ? (const char*)g.A + nxt.aoff : cA; const char* nB = has_next ? (const char*)g.Bt + nxt.boff : cB;
#pragma unroll 1
        for (int t = 0; t < nt; t += 2) {
            const bool last = (t == nt - 2);
            const char* a1 = cA + (size_t)(t + 1) * kstep;
            const char* a2 = last ? nA : cA + (size_t)(t + 2) * kstep; const char* b2 = last ? nB : cB + (size_t)(t + 2) * kstep;
            const char* a3 = a2 + kstep; const char* b3 = b2 + kstep;
            if (last && has_next) S.a_ready(nxt);
            if constexpr (SP2) {
            PG8_LDB(B0, 0, 0); PG8_LDB(B1, 0, 1); PG8_SCHED; PG8_LDA(At, 0, 0); PG8_STAGE(PG8_SA(1, 1), a1 + hstepA, voffA);
            PG8_WAIT_V(8); PG8_WAIT_L(0); PG8_BAR; PG8_MMA(0, 0, At, B0); PG8_MMA(0, 1, At, B1); PG8_BAR; PG8_SCHED;
            PG8_LDA(At, 0, 1); PG8_STAGE(PG8_SB(0, 0), b2, voffB); PG8_STAGE(PG8_SB(0, 1), b2 + hstepB, voffB); PG8_STAGE(PG8_SA(0, 0), a2, voffA);
            PG8_WAIT_V(8); PG8_WAIT_L(0); PG8_BAR; PG8_MMA(1, 0, At, B0); PG8_MMA(1, 1, At, B1); PG8_BAR; PG8_SCHED;
            PG8_LDB(B0, 1, 0); PG8_LDB(B1, 1, 1); PG8_SCHED; PG8_LDA(At, 1, 0); PG8_STAGE(PG8_SA(0, 1), a2 + hstepA, voffA);
            PG8_WAIT_V(8); PG8_WAIT_L(0); PG8_BAR; PG8_MMA(0, 0, At, B0); PG8_MMA(0, 1, At, B1); PG8_BAR; PG8_SCHED;
            PG8_LDA(At, 1, 1); PG8_STAGE(PG8_SB(1, 0), b3, voffB); PG8_STAGE(PG8_SB(1, 1), b3 + hstepB, voffB); PG8_STAGE(PG8_SA(1, 0), a3, voffA);
            PG8_WAIT_V(8); PG8_WAIT_L(0); PG8_BAR; PG8_MMA(1, 0, At, B0); PG8_MMA(1, 1, At, B1); PG8_BAR; PG8_SCHED;
            } else {
            PG8_LDB(B0, 0, 0); PG8_SCHED; PG8_LDA(At, 0, 0); PG8_STAGE(PG8_SA(1, 1), a1 + hstepA, voffA);
            PG8_WAIT_L(8); PG8_BAR; PG8_WAIT_L(0); PG8_MMA(0, 0, At, B0); PG8_BAR; PG8_SCHED;
            PG8_LDB(B1, 0, 1); PG8_STAGE(PG8_SB(0, 0), b2, voffB);
            PG8_BAR; PG8_WAIT_L(0); PG8_MMA(0, 1, At, B1); PG8_BAR;
            PG8_LDA(At, 0, 1); PG8_STAGE(PG8_SA(0, 0), a2, voffA);
            PG8_BAR; PG8_WAIT_L(0); PG8_MMA(1, 0, At, B0); PG8_BAR; PG8_SCHED;
            PG8_STAGE(PG8_SB(0, 1), b2 + hstepB, voffB);
            PG8_WAIT_V(6); PG8_BAR; PG8_MMA(1, 1, At, B1); PG8_BAR;
            PG8_LDB(B0, 1, 0); PG8_SCHED; PG8_LDA(At, 1, 0); PG8_STAGE(PG8_SA(0, 1), a2 + hstepA, voffA);
            PG8_WAIT_L(8); PG8_BAR; PG8_WAIT_L(0); PG8_MMA(0, 0, At, B0); PG8_BAR; PG8_SCHED;
            PG8_LDB(B1, 1, 1); PG8_STAGE(PG8_SB(1, 0), b3, voffB);
            PG8_BAR; PG8_WAIT_L(0); PG8_MMA(0, 1, At, B1); PG8_BAR;
            PG8_LDA(At, 1, 1); PG8_STAGE(PG8_SA(1, 0), a3, voffA);
            PG8_BAR; PG8_WAIT_L(0); PG8_MMA(1, 0, At, B0); PG8_BAR; PG8_SCHED;
            PG8_STAGE(PG8_SB(1, 1), b3 + hstepB, voffB);
            PG8_WAIT_V(6); PG8_BAR; PG8_MMA(1, 1, At, B1); PG8_BAR;
            }
        }
        if constexpr (ALIGN_EPI) { if (wr == 0) PG8_BAR; }
        if constexpr (!Epi::AFTER_DRAIN) { E(acc, cur, wr, wc, fr, fq); S.done(cur); }
        if (!has_next) break;
#pragma unroll
        for (int a = 0; a < 2; ++a)
#pragma unroll
            for (int b = 0; b < 2; ++b)
#pragma unroll
                for (int m = 0; m < 4; ++m)
#pragma unroll
                    for (int n = 0; n < 2; ++n) acc[a][b][m][n] = (f32x4){0.f, 0.f, 0.f, 0.f};
        cur = nxt; cA = nA; cB = nB; ++ui;
        if constexpr (ALIGN_EPI) { if (wr == 1) PG8_BAR; }
    }
    PG8_WAIT_V(0);
    if constexpr (!ALIGN_EPI) { if (wr == 0) PG8_BAR; }
    PG8_BAR;
    if constexpr (Epi::AFTER_DRAIN) { E.fused(acc, cur, wr, wc, fr, fq, lds, wid, lane); S.done(cur); }
#undef PG8_SA
#undef PG8_SB
#undef PG8_STAGE
#undef PG8_LDA
#undef PG8_LDB
#undef PG8_MMA
#undef PG8_WAIT_V
#undef PG8_WAIT_L
#undef PG8_BAR
#undef PG8_SCHED
}}

#define DI __device__ __forceinline__
#define LAS __attribute__((address_space(3)))
typedef unsigned short bf16;
typedef short bf16x8 __attribute__((ext_vector_type(8)));
typedef float f32x4 __attribute__((ext_vector_type(4)));
typedef float f32x16 __attribute__((ext_vector_type(16)));
typedef unsigned u32x4 __attribute__((ext_vector_type(4)));
typedef unsigned u32x2 __attribute__((ext_vector_type(2)));
typedef __bf16 bf16x2_t __attribute__((ext_vector_type(2)));
typedef float f32x2_t __attribute__((ext_vector_type(2)));
using pg8::Unit;

constexpr int D = 1024, S = 16384, NB = 2, MP = NB * S, MS = 256, MT = MP + MS, FF = 2816, NL = 2, NTHR = 512;
constexpr float EPS = 1e-6f, LOG2E = 1.4426950408889634f;
constexpr size_t MiB = 1u << 20;
constexpr size_t WS_SS_OLD = 0;
constexpr size_t WS_LINV = 2 * MiB;
constexpr size_t WS_ROPE = 3 * MiB;
constexpr size_t WS_MN = 7 * MiB;
constexpr size_t WS_MKB = 8 * MiB;
constexpr size_t WS_MVT = 10 * MiB;
constexpr size_t WS_W = 12 * MiB, LW = 47 * MiB;
constexpr size_t W_1 = 0, W_D1 = 11 * MiB, W_IN = W_D1 + 11 * MiB / 2, W_OUT = W_IN + 4 * MiB, W_Q = W_OUT + 2 * MiB, W_O = W_Q + 2 * MiB, W_2 = W_O + 2 * MiB, W_D2 = W_2 + 11 * MiB, W_KV = W_D2 + 11 * MiB / 2;
static_assert(W_KV + 4 * MiB == LW, "weights map");
constexpr size_t WS_XB = WS_W + 2 * LW;
constexpr size_t WS_R = WS_XB + 65 * MiB;
constexpr size_t R_H = 0;
constexpr size_t R_GB = 0, R_CV = R_GB + (size_t)MT * 256 * 2, R_Q = R_CV + (size_t)MT * 256 * 2, R_K = R_Q + (size_t)MT * 512 * 2, R_VT = R_K + (size_t)MT * 128 * 2,
                 R_VS = R_VT + (size_t)NB * 128 * S * 2, R_GLU = R_VS + (size_t)MS * 128 * 2, R_YMIX = 101 * MiB;
static_assert(R_GLU + (size_t)MT * 256 * 2 <= R_YMIX, "R map");
constexpr size_t R_QX = 0, R_P = 68 * MiB;
constexpr size_t WS_SS = WS_R + 178 * MiB;
constexpr size_t WS_END = WS_SS + 19 * MiB;
static_assert((size_t)9 * MT * 64 <= 19 * MiB, "ss");
static_assert((size_t)MT * FF * 2 <= 178 * MiB && (size_t)MT * D * 2 <= 65 * MiB, "sizes");
constexpr size_t O_YP = 0, O_YS = O_YP + (size_t)MP * D, O_KP = O_YS + (size_t)MS * D, O_VP = O_KP + 65536, O_AP = O_VP + 65536, O_CP = O_AP + 2048, O_MK = O_CP + 30720,
                 O_MV = O_MK + 1048576, O_KS = O_MV + 1048576, O_VS = O_KS + 65536, O_AS = O_VS + 65536, O_CS = O_AS + 16384, O_END = O_CS + 245760;
constexpr int LDS_BYTES = 162816, LDS_EPI = 131072, LDS_TAB = 162816 - 512;

struct Args { const float* in[34]; float* out; unsigned char* ws; int ph_lo, ph_hi; };
enum { I_XP = 0, I_XS, I_CK, I_CV, I_SA, I_SC, I_MK, I_MV, I_MEM, I_F1N, I_F1G, I_F1U, I_F1D, I_MIXN, I_WIN, I_CAW, I_SINK, I_CCW, I_CCB, I_LNG, I_LNB, I_MON, I_WOUT,
       I_XAN, I_MEMN, I_WQ, I_WK, I_WV, I_WO, I_F2N, I_F2G, I_F2U, I_F2D, I_FIN };

DI const float* tab_ptr(LAS unsigned char* lds, int idx) { const u32x2 v = *((const LAS u32x2*)(lds + LDS_TAB) + idx); const unsigned lo = __builtin_amdgcn_readfirstlane(v.x), hi = __builtin_amdgcn_readfirstlane(v.y); return (const float*)(((unsigned long long)hi << 32) | lo); }
#define IN(idx) tab_ptr(lds, idx)
DI float ss_row(const float* ss, int row) { const f32x4* p = (const f32x4*)(ss + (size_t)row * 16); const f32x4 a = p[0], b = p[1], c = p[2], d = p[3]; return (((a[0] + a[1]) + (a[2] + a[3])) + ((b[0] + b[1]) + (b[2] + b[3]))) + (((c[0] + c[1]) + (c[2] + c[3])) + ((d[0] + d[1]) + (d[2] + d[3]))); }
DI float bf2f(unsigned short b) { return __uint_as_float((unsigned)b << 16); }
DI unsigned pk2(float lo, float hi) { f32x2_t v = {lo, hi}; bf16x2_t b = __builtin_convertvector(v, bf16x2_t); return __builtin_bit_cast(unsigned, b); }
DI bf16 f2bf(float f) { return (bf16)(pk2(f, 0.f) & 0xffffu); }
DI void st4bf(bf16* p, f32x4 v) { u32x2 w; w.x = pk2(v[0], v[1]); w.y = pk2(v[2], v[3]); *(u32x2*)p = w; }
DI f32x4 unpk4(u32x2 w) { return (f32x4){__uint_as_float(w.x << 16), __uint_as_float(w.x & 0xffff0000u), __uint_as_float(w.y << 16), __uint_as_float(w.y & 0xffff0000u)}; }
DI f32x4 ld4bf(const bf16* p) { return unpk4(*(const u32x2*)p); }
DI void st8bf(bf16* p, f32x4 a, f32x4 b) { u32x4 w; w.x = pk2(a[0], a[1]); w.y = pk2(a[2], a[3]); w.z = pk2(b[0], b[1]); w.w = pk2(b[2], b[3]); *(u32x4*)p = w; }
DI float dpp_f(float v, const int ctrl_tag);
template <int CTRL> DI float dppx(float v) { return __builtin_bit_cast(float, __builtin_amdgcn_update_dpp(0, __builtin_bit_cast(int, v), CTRL, 0xf, 0xf, true)); }
DI float wave_sum(float v) {
    v += dppx<0xB1>(v); v += dppx<0x4E>(v); v += dppx<0x141>(v); v += dppx<0x140>(v);
    const float a = __builtin_bit_cast(float, __builtin_amdgcn_readlane(__builtin_bit_cast(int, v), 0)), b = __builtin_bit_cast(float, __builtin_amdgcn_readlane(__builtin_bit_cast(int, v), 16)),
                c = __builtin_bit_cast(float, __builtin_amdgcn_readlane(__builtin_bit_cast(int, v), 32)), d = __builtin_bit_cast(float, __builtin_amdgcn_readlane(__builtin_bit_cast(int, v), 48));
    return (a + b) + (c + d);
}
DI float wave_max(float v) {
#pragma unroll
    for (int o = 1; o < 64; o <<= 1) v = fmaxf(v, __shfl_xor(v, o));
    return v;
}
DI float sigmoidf_(float x) { return __builtin_amdgcn_rcpf(1.f + __builtin_amdgcn_exp2f(-LOG2E * x)); }
#define LDS_WAIT() asm volatile("s_waitcnt lgkmcnt(0)" ::: "memory")
#define EPI_BAR() do { asm volatile("s_waitcnt lgkmcnt(0)" ::: "memory"); __builtin_amdgcn_s_barrier(); asm volatile("" ::: "memory"); } while (0)

template <class F> struct EpiA {
    static constexpr bool PERM = F::PERM, AFTER_DRAIN = false; F f;
    template <int KIND> DI void body(const f32x4 (&acc)[2][2][4][2], const Unit& u, int wr, int wc, int fr, int fq) const {
#pragma unroll
        for (int ai = 0; ai < 2; ++ai)
#pragma unroll
            for (int m = 0; m < 4; ++m) {
                const int lr = ai * 128 + wr * 64 + m * 16 + fr, row = u.pm * 256 + lr; typename F::Row rc; f.row_begin(rc, row, u.pn, lr);
                if constexpr (F::PERM) f.template apply8<KIND>(rc, row, u.pn, wc * 32 + fq * 8, acc[ai][0][m][0], acc[ai][0][m][1], acc[ai][1][m][0], acc[ai][1][m][1]);
                else {
#pragma unroll
                for (int n = 0; n < 2; ++n) f.template apply<KIND>(rc, row, u.pn, wc * 32 + n * 16 + fq * 4, acc[ai][0][m][n], acc[ai][1][m][n]); }
                f.row_end(rc, row, u.pn, fq, wc);
            }
    }
    DI void operator()(const f32x4 (&acc)[2][2][4][2], const Unit& u, int wr, int wc, int fr, int fq) const {
        asm volatile("" : "+v"(fr), "+v"(fq));
        if constexpr (F::USE_SS) {
            const int t = (wr * 4 + wc) * 64 + fq * 16 + fr;
            if (t < 256) f.rsl[t] = rsqrtf(ss_row(f.ss, u.pm * 256 + t) * (1.f / D) + EPS);
            EPI_BAR();
        } else { EPI_BAR(); }
        if constexpr (F::NKIND == 1) body<0>(acc, u, wr, wc, fr, fq);
        else { const int kd = f.kind(u.pn);
            if (kd == 0) body<0>(acc, u, wr, wc, fr, fq); else if (kd == 1) body<1>(acc, u, wr, wc, fr, fq);
            else if constexpr (F::NKIND > 2) { if (kd == 2) body<2>(acc, u, wr, wc, fr, fq); else if (kd == 3) body<3>(acc, u, wr, wc, fr, fq); else body<4>(acc, u, wr, wc, fr, fq); } }    }
};
template <class F> DI void apply_two(const F& f, int row, int pn, int c, const f32x4 (&v0)[2], const f32x4 (&v1)[2], int fq, int sub) {
    typename F::Row rc; f.row_begin(rc, row, pn, -1);
#pragma unroll
    for (int wb = 0; wb < 2; ++wb) {
        if constexpr (F::NKIND == 1) f.template apply<0>(rc, row, pn, c + wb * 16, v0[wb], v1[wb]);
        else { const int kd = f.kind(pn);
            if (kd == 0) f.template apply<0>(rc, row, pn, c + wb * 16, v0[wb], v1[wb]); else if (kd == 1) f.template apply<1>(rc, row, pn, c + wb * 16, v0[wb], v1[wb]);
            else if constexpr (F::NKIND > 2) { if (kd == 2) f.template apply<2>(rc, row, pn, c + wb * 16, v0[wb], v1[wb]); else if (kd == 3) f.template apply<3>(rc, row, pn, c + wb * 16, v0[wb], v1[wb]); else f.template apply<4>(rc, row, pn, c + wb * 16, v0[wb], v1[wb]); } }
    }
    f.row_end(rc, row, pn, fq, sub);
}

struct FUp {
    static constexpr int NKIND = 1; static constexpr bool USE_SS = true, PERM = true; const float* ss; bf16* h; LAS float* rsl;
    struct Row { float rs; };
    DI void row_begin(Row& rc, int row, int, int lr) const { rc.rs = lr >= 0 ? rsl[lr] : rsqrtf(ss_row(ss, row) * (1.f / D) + EPS); }
    template <int> DI void apply(const Row& rc, int row, int pn, int c, f32x4 v0, f32x4 v1) const {
        f32x4 o;
#pragma unroll
        for (int e = 0; e < 4; ++e) { const float g = v0[e] * rc.rs, u = v1[e] * rc.rs; o[e] = g * sigmoidf_(g) * u; }
        st4bf(h + (size_t)row * FF + pn * 128 + c, o);
    }
    template <int> DI void apply8(const Row& rc, int row, int pn, int c, f32x4 g0, f32x4 g1, f32x4 u0, f32x4 u1) const {
        f32x4 o0, o1;
#pragma unroll
        for (int e = 0; e < 4; ++e) { const float ga = g0[e] * rc.rs, gb = g1[e] * rc.rs; o0[e] = ga * sigmoidf_(ga) * (u0[e] * rc.rs); o1[e] = gb * sigmoidf_(gb) * (u1[e] * rc.rs); }
        st8bf(h + (size_t)row * FF + pn * 128 + c, o0, o1);
    }
    DI void row_end(const Row&, int, int, int, int) const {}
};
struct FUpCheap {
    static constexpr int NKIND = 1; static constexpr bool USE_SS = false, PERM = false; bf16* h;
    struct Row { float rs; };
    DI void row_begin(Row&, int, int, int) const {}
    template <int> DI void apply(const Row&, int row, int pn, int c, f32x4 v0, f32x4 v1) const { st4bf(h + (size_t)row * FF + pn * 128 + c, v0 + v1); }
    DI void row_end(const Row&, int, int, int, int) const {}
};
struct FRes {
    static constexpr int NKIND = 1; static constexpr bool USE_SS = false, PERM = true; bf16* xb; float* ssn; float alpha;
    struct Row { float a; };
    DI void row_begin(Row& rc, int, int, int) const { rc.a = 0.f; }
    template <int> DI void apply(Row& rc, int row, int pn, int c, f32x4 v0, f32x4 v1) const {
#pragma unroll
        for (int bj = 0; bj < 2; ++bj) {
            bf16* p = xb + (size_t)row * D + pn * 256 + bj * 128 + c; const f32x4 x = ld4bf(p); const f32x4 v = bj ? v1 : v0;
            u32x2 w; w.x = pk2(x[0] + alpha * v[0], x[1] + alpha * v[1]); w.y = pk2(x[2] + alpha * v[2], x[3] + alpha * v[3]); *(u32x2*)p = w;
            const f32x4 r = unpk4(w); rc.a += (r[0] * r[0] + r[1] * r[1]) + (r[2] * r[2] + r[3] * r[3]);
        }
    }
    template <int> DI void apply8(Row& rc, int row, int pn, int c, f32x4 a0, f32x4 a1, f32x4 b0, f32x4 b1) const {
#pragma unroll
        for (int bj = 0; bj < 2; ++bj) {
            bf16* p = xb + (size_t)row * D + pn * 256 + bj * 128 + c; const u32x4 xw = *(const u32x4*)p; const f32x4 x0 = unpk4((u32x2){xw.x, xw.y}), x1 = unpk4((u32x2){xw.z, xw.w});
            const f32x4 v0 = bj ? b0 : a0, v1 = bj ? b1 : a1;
            u32x4 w; w.x = pk2(x0[0] + alpha * v0[0], x0[1] + alpha * v0[1]); w.y = pk2(x0[2] + alpha * v0[2], x0[3] + alpha * v0[3]); w.z = pk2(x1[0] + alpha * v1[0], x1[1] + alpha * v1[1]); w.w = pk2(x1[2] + alpha * v1[2], x1[3] + alpha * v1[3]);
            *(u32x4*)p = w; const f32x4 r0 = unpk4((u32x2){w.x, w.y}), r1 = unpk4((u32x2){w.z, w.w});
            rc.a += ((r0[0] * r0[0] + r0[1] * r0[1]) + (r0[2] * r0[2] + r0[3] * r0[3])) + ((r1[0] * r1[0] + r1[1] * r1[1]) + (r1[2] * r1[2] + r1[3] * r1[3]));
        }
    }
    DI void row_end(const Row& rc, int row, int pn, int fq, int sub) const { float s = rc.a; s += __shfl_xor(s, 16); s += __shfl_xor(s, 32); if (fq == 0) ssn[(size_t)row * 16 + pn * 4 + sub] = s; }
};
struct FScale {
    static constexpr int NKIND = 1; static constexpr bool USE_SS = true, PERM = true; const float* ss; bf16* o; float sc; LAS float* rsl;
    struct Row { float rs; };
    DI void row_begin(Row& rc, int row, int, int lr) const { rc.rs = (lr >= 0 ? rsl[lr] : rsqrtf(ss_row(ss, row) * (1.f / D) + EPS)) * sc; }
    template <int> DI void apply(const Row& rc, int row, int pn, int c, f32x4 v0, f32x4 v1) const {
        st4bf(o + (size_t)row * D + pn * 256 + c, v0 * rc.rs); st4bf(o + (size_t)row * D + pn * 256 + 128 + c, v1 * rc.rs);
    }
    template <int> DI void apply8(const Row& rc, int row, int pn, int c, f32x4 a0, f32x4 a1, f32x4 b0, f32x4 b1) const { st8bf(o + (size_t)row * D + pn * 256 + c, a0 * rc.rs, a1 * rc.rs); st8bf(o + (size_t)row * D + pn * 256 + 128 + c, b0 * rc.rs, b1 * rc.rs); }
    DI void row_end(const Row&, int, int, int, int) const {}
};
struct FPV {
    static constexpr int NKIND = 1; static constexpr bool USE_SS = false, PERM = true; const float* linv; bf16* o;
    struct Row { float s; };
    DI void row_begin(Row& rc, int row, int pn, int) const { rc.s = linv[(size_t)row * 4 + pn]; }
    template <int> DI void apply(const Row& rc, int row, int pn, int c, f32x4 v0, f32x4 v1) const {
        st4bf(o + (size_t)row * D + pn * 256 + c, v0 * rc.s); st4bf(o + (size_t)row * D + pn * 256 + 128 + c, v1 * rc.s);
    }
    template <int> DI void apply8(const Row& rc, int row, int pn, int c, f32x4 a0, f32x4 a1, f32x4 b0, f32x4 b1) const { st8bf(o + (size_t)row * D + pn * 256 + c, a0 * rc.s, a1 * rc.s); st8bf(o + (size_t)row * D + pn * 256 + 128 + c, b0 * rc.s, b1 * rc.s); }
    DI void row_end(const Row&, int, int, int, int) const {}
};
struct FMemKV {
    static constexpr int NKIND = 2; static constexpr bool USE_SS = false, PERM = false; float* ok; float* ov; bf16* mkb; bf16* mvt;
    struct Row { int d; };
    DI int kind(int pn) const { return pn < 4 ? 0 : 1; }
    DI void row_begin(Row&, int, int, int) const {}
    template <int KIND> DI void apply(const Row&, int row, int pn, int c, f32x4 v0, f32x4 v1) const {
        if constexpr (KIND == 0) {
#pragma unroll
            for (int bj = 0; bj < 2; ++bj) { const int col = pn * 256 + bj * 128 + c; const f32x4 v = bj ? v1 : v0; *(f32x4*)(ok + (size_t)row * D + col) = v; st4bf(mkb + (size_t)row * D + col, v); }
        } else {
            const int h = pn - 4, b = row >> 8, mem = row & 255;
#pragma unroll
            for (int bj = 0; bj < 2; ++bj) { const int dd = bj * 128 + c; const f32x4 v = bj ? v1 : v0; *(f32x4*)(ov + (size_t)row * D + h * 256 + dd) = v;
#pragma unroll
                for (int e = 0; e < 4; ++e) mvt[((size_t)(b * 4 + h) * 256 + dd + e) * 256 + mem] = f2bf(v[e]); }
        }
    }
    DI void row_end(const Row&, int, int, int, int) const {}
};
struct FWin {
    static constexpr int NKIND = 5; static constexpr bool USE_SS = true, PERM = true; const float* ss; unsigned char* ws; float* out; int l; LAS float* rsl;
    struct Row { float rs; int pos, b, t; bool smp; };
    DI int kind(int pn) const { return pn == 0 ? 0 : pn <= 2 ? 1 : pn <= 4 ? 2 : pn == 5 ? 3 : 4; }
    DI void row_begin(Row& rc, int row, int, int lr) const {
        rc.rs = lr >= 0 ? rsl[lr] : rsqrtf(ss_row(ss, row) * (1.f / D) + EPS);
        if (row < MP) { rc.smp = false; rc.b = row >> 14; rc.pos = row & (S - 1); rc.t = 0; } else { const int sr = row - MP; rc.smp = true; rc.b = sr >> 4; rc.t = sr & 15; rc.pos = 1024 + rc.t; }
    }
    template <int KIND> DI void apply(const Row& rc, int row, int pn, int c, f32x4 v0, f32x4 v1) const {
        unsigned char* R = ws + WS_R; const f32x4 a0 = v0 * rc.rs, a1 = v1 * rc.rs;
        if constexpr (KIND == 0) { bf16* gb = (bf16*)(R + R_GB) + (size_t)row * 256 + c; st4bf(gb, a0); st4bf(gb + 128, a1); }
        else if constexpr (KIND == 1) {
            const int ch = (pn - 1) * 128 + c; const f32x4 p = a0 * a1; st4bf((bf16*)(R + R_CV) + (size_t)row * 256 + ch, p);
            if (!rc.smp) { if (rc.pos >= S - 2) *(f32x4*)(out + O_AP + (size_t)l * 1024 + (size_t)(rc.b * 2 + rc.pos - (S - 2)) * 256 + ch) = p; }
            else if (rc.t >= 14) *(f32x4*)(out + O_AS + (size_t)l * 8192 + (size_t)(rc.b * 2 + rc.t - 14) * 256 + ch) = p;
        } else if constexpr (KIND == 2 || KIND == 3) {
            const int blk = c >> 5, i = c & 31;
            if (KIND == 3 && blk >= 2) {
                const int kvh = blk - 2;
                if (!rc.smp) {
                    bf16* vT = (bf16*)(R + R_VT) + ((size_t)(rc.b * 2 + kvh) * 64 + i) * S + rc.pos;
#pragma unroll
                    for (int e = 0; e < 4; ++e) { vT[(size_t)e * S] = f2bf(a0[e]); vT[(size_t)(32 + e) * S] = f2bf(a1[e]); }
                    if (rc.pos >= S - 128) { float* o = out + O_VP + (size_t)l * 32768 + ((size_t)(rc.b * 128 + rc.pos - (S - 128)) * 2 + kvh) * 64 + i; *(f32x4*)o = a0; *(f32x4*)(o + 32) = a1; }
                } else {
                    bf16* p = (bf16*)(R + R_VS) + (size_t)(row - MP) * 128 + kvh * 64 + i; st4bf(p, a0); st4bf(p + 32, a1);
                    float* o = out + O_VS + (size_t)l * 32768 + ((size_t)(rc.b * 16 + rc.t) * 2 + kvh) * 64 + i; *(f32x4*)o = a0; *(f32x4*)(o + 32) = a1;
                }
            } else {
                const float* rcos = (const float*)(ws + WS_ROPE) + (size_t)rc.pos * 32 + i;
                const f32x4 cs = *(const f32x4*)rcos, sn = *(const f32x4*)(rcos + (size_t)S * 32);
                const f32x4 o1 = a0 * cs - a1 * sn, o2 = a1 * cs + a0 * sn;
                if constexpr (KIND == 2) { const int head = (pn - 3) * 4 + blk; const float QS = 0.125f * LOG2E; bf16* p = (bf16*)(R + R_Q) + (size_t)row * 512 + head * 64 + i; st4bf(p, o1 * QS); st4bf(p + 32, o2 * QS); }
                else {
                    bf16* p = (bf16*)(R + R_K) + (size_t)row * 128 + blk * 64 + i; st4bf(p, o1); st4bf(p + 32, o2);
                    if (!rc.smp) { if (rc.pos >= S - 128) { float* o = out + O_KP + (size_t)l * 32768 + ((size_t)(rc.b * 128 + rc.pos - (S - 128)) * 2 + blk) * 64 + i; *(f32x4*)o = o1; *(f32x4*)(o + 32) = o2; } }
                    else { float* o = out + O_KS + (size_t)l * 32768 + ((size_t)(rc.b * 16 + rc.t) * 2 + blk) * 64 + i; *(f32x4*)o = o1; *(f32x4*)(o + 32) = o2; }
                }
            }
        } else {
            const int ch = (pn - 6) * 128 + c; f32x4 g;
#pragma unroll
            for (int e = 0; e < 4; ++e) g[e] = a0[e] * sigmoidf_(a1[e]);
            st4bf((bf16*)(R + R_GLU) + (size_t)row * 256 + ch, g);
            if (!rc.smp) { if (rc.pos >= S - 30) *(f32x4*)(out + O_CP + (size_t)l * 15360 + (size_t)(rc.b * 30 + rc.pos - (S - 30)) * 256 + ch) = g; }
            else *(f32x4*)(out + O_CS + (size_t)l * 122880 + (size_t)(rc.b * 30 + 14 + rc.t) * 256 + ch) = g;
        }
    }
    template <int KIND> DI void apply8(const Row& rc, int row, int pn, int c, f32x4 v0a, f32x4 v0b, f32x4 v1a, f32x4 v1b) const {
        unsigned char* R = ws + WS_R; const f32x4 a0 = v0a * rc.rs, a1 = v0b * rc.rs, b0 = v1a * rc.rs, b1 = v1b * rc.rs;
        if constexpr (KIND == 0) { bf16* gb = (bf16*)(R + R_GB) + (size_t)row * 256 + c; st8bf(gb, a0, a1); st8bf(gb + 128, b0, b1); }
        else if constexpr (KIND == 1) {
            const int ch = (pn - 1) * 128 + c; const f32x4 p0 = a0 * b0, p1 = a1 * b1; st8bf((bf16*)(R + R_CV) + (size_t)row * 256 + ch, p0, p1);
            if (rc.pos >= S - 2) { float* o = out + O_AP + (size_t)l * 1024 + (size_t)(rc.b * 2 + rc.pos - (S - 2)) * 256 + ch; *(f32x4*)o = p0; *(f32x4*)(o + 4) = p1; }
        } else if constexpr (KIND == 2 || KIND == 3) {
            const int blk = c >> 5, i = c & 31;
            if (KIND == 3 && blk >= 2) { apply<3>(rc, row, pn, c, v0a, v1a); apply<3>(rc, row, pn, c + 4, v0b, v1b); }
            else {
                const float* rcos = (const float*)(ws + WS_ROPE) + (size_t)rc.pos * 32 + i; const float* rsin = rcos + (size_t)S * 32;
                const f32x4 c0 = *(const f32x4*)rcos, c1 = *(const f32x4*)(rcos + 4), s0 = *(const f32x4*)rsin, s1 = *(const f32x4*)(rsin + 4);
                const f32x4 o1a = a0 * c0 - b0 * s0, o1b = a1 * c1 - b1 * s1, o2a = b0 * c0 + a0 * s0, o2b = b1 * c1 + a1 * s1;
                if constexpr (KIND == 2) { const int head = (pn - 3) * 4 + blk; const float QS = 0.125f * LOG2E; bf16* p = (bf16*)(R + R_Q) + (size_t)row * 512 + head * 64 + i; st8bf(p, o1a * QS, o1b * QS); st8bf(p + 32, o2a * QS, o2b * QS); }
                else {
                    bf16* p = (bf16*)(R + R_K) + (size_t)row * 128 + blk * 64 + i; st8bf(p, o1a, o1b); st8bf(p + 32, o2a, o2b);
                    if (rc.pos >= S - 128) { float* o = out + O_KP + (size_t)l * 32768 + ((size_t)(rc.b * 128 + rc.pos - (S - 128)) * 2 + blk) * 64 + i; *(f32x4*)o = o1a; *(f32x4*)(o + 4) = o1b; *(f32x4*)(o + 32) = o2a; *(f32x4*)(o + 36) = o2b; }
                }
            }
        } else {
            const int ch = (pn - 6) * 128 + c; f32x4 g0, g1;
#pragma unroll
            for (int e = 0; e < 4; ++e) { g0[e] = a0[e] * sigmoidf_(b0[e]); g1[e] = a1[e] * sigmoidf_(b1[e]); }
            st8bf((bf16*)(R + R_GLU) + (size_t)row * 256 + ch, g0, g1);
            if (rc.pos >= S - 30) { float* o = out + O_CP + (size_t)l * 15360 + (size_t)(rc.b * 30 + rc.pos - (S - 30)) * 256 + ch; *(f32x4*)o = g0; *(f32x4*)(o + 4) = g1; }
        }
    }
    DI void row_end(const Row&, int, int, int, int) const {}
};
struct EpiS {
    static constexpr bool PERM = true, AFTER_DRAIN = false;
    bf16* P; float* linv; LAS float* sc;
    DI void operator()(const f32x4 (&acc)[2][2][4][2], const Unit& u, int wr, int wc, int fr, int fq) const {
        LAS float* Pm = sc; LAS float* Ps = sc + 1024;
#pragma unroll
        for (int ai = 0; ai < 2; ++ai)
#pragma unroll
            for (int m = 0; m < 4; ++m) {
                float mx = -3.0e38f;
#pragma unroll
                for (int bj = 0; bj < 2; ++bj)
#pragma unroll
                    for (int n = 0; n < 2; ++n) { const f32x4 x = acc[ai][bj][m][n]; mx = fmaxf(mx, fmaxf(fmaxf(x[0], x[1]), fmaxf(x[2], x[3]))); }
                mx = fmaxf(mx, __shfl_xor(mx, 16)); mx = fmaxf(mx, __shfl_xor(mx, 32));
                if (fq == 0) Pm[(ai * 128 + wr * 64 + m * 16 + fr) * 4 + wc] = mx;
            }
        EPI_BAR();
#pragma unroll
        for (int ai = 0; ai < 2; ++ai)
#pragma unroll
            for (int m = 0; m < 4; ++m) {
                const int r = ai * 128 + wr * 64 + m * 16 + fr; const f32x4 m4 = *(LAS f32x4*)(Pm + r * 4);
                const float mx = fmaxf(fmaxf(m4[0], m4[1]), fmaxf(m4[2], m4[3])); float sum = 0.f;
                bf16* prow = P + (size_t)(u.pm * 256 + r) * D + u.pn * 256 + wc * 32 + fq * 8;
#pragma unroll
                for (int bj = 0; bj < 2; ++bj) {
                    const f32x4 x = acc[ai][bj][m][0], y = acc[ai][bj][m][1]; u32x4 w;
                    w.x = pk2(__builtin_amdgcn_exp2f(x[0] - mx), __builtin_amdgcn_exp2f(x[1] - mx)); w.y = pk2(__builtin_amdgcn_exp2f(x[2] - mx), __builtin_amdgcn_exp2f(x[3] - mx));
                    w.z = pk2(__builtin_amdgcn_exp2f(y[0] - mx), __builtin_amdgcn_exp2f(y[1] - mx)); w.w = pk2(__builtin_amdgcn_exp2f(y[2] - mx), __builtin_amdgcn_exp2f(y[3] - mx));
                    *(u32x4*)(prow + bj * 128) = w; const f32x4 p0 = unpk4((u32x2){w.x, w.y}), p1 = unpk4((u32x2){w.z, w.w}); sum += ((p0[0] + p0[1]) + (p0[2] + p0[3])) + ((p1[0] + p1[1]) + (p1[2] + p1[3]));
                }
                sum += __shfl_xor(sum, 16); sum += __shfl_xor(sum, 32);
                if (fq == 0) Ps[r * 4 + wc] = sum;
            }
        EPI_BAR();
        const int tid = (wr * 4 + wc) * 64 + fq * 16 + fr;
        if (tid < 256) { const f32x4 s4 = *(LAS f32x4*)(Ps + tid * 4); linv[(size_t)(u.pm * 256 + tid) * 4 + u.pn] = 1.f / ((s4[0] + s4[1]) + (s4[2] + s4[3])); }
    }
};

template <int K, class F> DI void sample_gemm(int wv, LAS unsigned char* lds, const bf16* A, int lda, const bf16* Bt, int ldb, int nN, const F& f, int G, int c0) {
    unsigned z_ = 0u; asm volatile("" : "+v"(z_)); const int tid_ = wv * 64 + (int)__builtin_amdgcn_mbcnt_hi(~0u, __builtin_amdgcn_mbcnt_lo(~0u, z_)); const int tid = tid_, w = __builtin_amdgcn_readfirstlane(tid >> 6), lane = tid & 63, fr = lane & 15, fq = lane >> 4;
    LAS float* red = (LAS float*)lds;
    constexpr int kw = K / 8, NKS = kw / 32, KB = 4;
    const int n_mu = 16 * nN * 4;
    for (int mu = c0; mu < n_mu; mu += G) {
        const int rb = mu & 15, t = mu >> 4, pn = t >> 2, s = t & 3, row0 = MP + rb * 16;
        f32x4 acc[4];
#pragma unroll
        for (int j = 0; j < 4; ++j) acc[j] = (f32x4){0.f, 0.f, 0.f, 0.f};
        const bf16* ap = A + (size_t)(row0 + fr) * lda + w * kw + fq * 8;
        const bf16* bp = Bt + (size_t)(pn * 256 + s * 32 + fr) * ldb + w * kw + fq * 8;
#pragma unroll
        for (int k0 = 0; k0 < NKS; k0 += KB) {
            bf16x8 a[KB], b[KB][4];
#pragma unroll
            for (int kk = 0; kk < KB; ++kk) if (k0 + kk < NKS) {
                a[kk] = *(const bf16x8*)(ap + (k0 + kk) * 32);
#pragma unroll
                for (int j = 0; j < 4; ++j) b[kk][j] = *(const bf16x8*)(bp + (size_t)((j >> 1) * 128 + (j & 1) * 16) * ldb + (k0 + kk) * 32);
            }
#pragma unroll
            for (int kk = 0; kk < KB; ++kk) if (k0 + kk < NKS) {
#pragma unroll
                for (int j = 0; j < 4; ++j) acc[j] = __builtin_amdgcn_mfma_f32_16x16x32_bf16(b[kk][j], a[kk], acc[j], 0, 0, 0);
            }
        }
#pragma unroll
        for (int j = 0; j < 4; ++j) *(LAS f32x4*)(red + ((w * 4 + j) * 64 + lane) * 4) = acc[j];
        __syncthreads();
        if (w == 0) {
            f32x4 v0[2], v1[2];
#pragma unroll
            for (int wb = 0; wb < 2; ++wb) { v0[wb] = (f32x4){0.f, 0.f, 0.f, 0.f}; v1[wb] = v0[wb];
#pragma unroll
                for (int ww = 0; ww < 8; ++ww) { v0[wb] += *(LAS f32x4*)(red + ((ww * 4 + wb) * 64 + lane) * 4); v1[wb] += *(LAS f32x4*)(red + ((ww * 4 + wb + 2) * 64 + lane) * 4); } }
            apply_two(f, row0 + fr, pn, s * 32 + fq * 4, v0, v1, fq, s);
        }
        __syncthreads();
    }
}

template <class F> DI void sample_gemm_wide(int wv, LAS unsigned char* lds, const bf16* A, const bf16* Bt, int nN, const F& f, int G, int c0) {
    unsigned z_ = 0u; asm volatile("" : "+v"(z_)); const int lane = (int)__builtin_amdgcn_mbcnt_hi(~0u, __builtin_amdgcn_mbcnt_lo(~0u, z_)), fr = lane & 15, fq = lane >> 4, w = wv;
    constexpr int K = D;
    LAS float* red = (LAS float*)lds;
    const int n_mu = 4 * nN * 4;
    for (int mu = c0; mu < n_mu; mu += G) {
        const int rg = mu & 3, t = mu >> 2, pn = t >> 2, s = t & 3, row0 = MP + rg * 64;
        f32x4 acc[4][4];
#pragma unroll
        for (int rb = 0; rb < 4; ++rb)
#pragma unroll
            for (int j = 0; j < 4; ++j) acc[rb][j] = (f32x4){0.f, 0.f, 0.f, 0.f};
        const bf16* ap = A + (size_t)(row0 + fr) * K + w * 128 + fq * 8;
        const bf16* bp = Bt + (size_t)(pn * 256 + s * 32 + fr) * K + w * 128 + fq * 8;
        bf16x8 a[4][4], b[4][4];
#pragma unroll
        for (int kk = 0; kk < 4; ++kk)
#pragma unroll
            for (int x = 0; x < 4; ++x) { a[kk][x] = *(const bf16x8*)(ap + (size_t)x * 16 * K + kk * 32); b[kk][x] = *(const bf16x8*)(bp + (size_t)((x >> 1) * 128 + (x & 1) * 16) * K + kk * 32); }
#pragma unroll
        for (int kk = 0; kk < 4; ++kk)
#pragma unroll
            for (int rb = 0; rb < 4; ++rb)
#pragma unroll
                for (int j = 0; j < 4; ++j) acc[rb][j] = __builtin_amdgcn_mfma_f32_16x16x32_bf16(b[kk][j], a[kk][rb], acc[rb][j], 0, 0, 0);
#pragma unroll
        for (int rb = 0; rb < 4; ++rb)
#pragma unroll
            for (int j = 0; j < 4; ++j) *(LAS f32x4*)(red + ((w * 16 + rb * 4 + j) * 64 + lane) * 4) = acc[rb][j];
        __syncthreads();
        {
            const int rb = w >> 1, wb = w & 1; f32x4 v0 = (f32x4){0.f, 0.f, 0.f, 0.f}, v1 = v0;
#pragma unroll
            for (int ww = 0; ww < 8; ++ww) { v0 += *(LAS f32x4*)(red + ((ww * 16 + rb * 4 + wb) * 64 + lane) * 4); v1 += *(LAS f32x4*)(red + ((ww * 16 + rb * 4 + wb + 2) * 64 + lane) * 4); }
            const int row = row0 + rb * 16 + fr, c = s * 32 + wb * 16 + fq * 4; typename F::Row rc; f.row_begin(rc, row, pn, -1);
            if constexpr (F::NKIND == 1) f.template apply<0>(rc, row, pn, c, v0, v1);
            else { const int kd = f.kind(pn);
                if (kd == 0) f.template apply<0>(rc, row, pn, c, v0, v1); else if (kd == 1) f.template apply<1>(rc, row, pn, c, v0, v1);
                else if constexpr (F::NKIND > 2) { if (kd == 2) f.template apply<2>(rc, row, pn, c, v0, v1); else if (kd == 3) f.template apply<3>(rc, row, pn, c, v0, v1); else f.template apply<4>(rc, row, pn, c, v0, v1); } }
        }
        __syncthreads();
    }
}

DI void tr_item(const float* W, int N, int sc0, const float* gain, bf16* WT, int K, int n0, int k0, LAS float* scr, int lane) {
#pragma unroll
    for (int i = 0; i < 8; ++i) { const int kk = 8 * i + (lane >> 3), n4 = (lane & 7) * 4; const float g = gain ? gain[k0 + kk] : 1.f; const f32x4 v = *(const f32x4*)(W + (size_t)(k0 + kk) * N + sc0 + n4);
        LAS float* d = scr + kk * 33 + n4; d[0] = v[0] * g; d[1] = v[1] * g; d[2] = v[2] * g; d[3] = v[3] * g; }
    LDS_WAIT();
    const int c = lane & 7;
#pragma unroll
    for (int j = 0; j < 4; ++j) { const int n = (lane >> 3) + 8 * j; const LAS float* s = scr + (8 * c) * 33 + n;
        u32x4 o; o.x = pk2(s[0 * 33], s[1 * 33]); o.y = pk2(s[2 * 33], s[3 * 33]); o.z = pk2(s[4 * 33], s[5 * 33]); o.w = pk2(s[6 * 33], s[7 * 33]);
        *(u32x4*)(WT + (size_t)(n0 + n) * K + k0 + 8 * c) = o; }
    LDS_WAIT();
}
DI int map_win(int n0) {
    const int t = n0 >> 8, r = n0 & 255, hb = r >> 7, rr = r & 127;
    switch (t) {
        case 0: return r;
        case 1: case 2: return (hb ? 512 : 256) + (t - 1) * 128 + rr;
        case 3: case 4: return 768 + ((t - 3) * 4 + (rr >> 5)) * 64 + hb * 32 + (rr & 31);
        case 5: { const int blk = rr >> 5; return (blk < 2 ? 1280 + blk * 64 : 1408 + (blk - 2) * 64) + hb * 32 + (rr & 31); }
        default: return (hb ? 1792 : 1536) + (t - 6) * 128 + rr;
    }
}
DI void sincos_d(double a, float& sn, float& cs) {
    const double k = rint(a * 0.6366197723675814); double r = fma(-k, 1.5707963267948966, a); r = fma(-k, 6.123233995736766e-17, r); const double r2 = r * r;
    const double s = r * (1.0 + r2 * (-1.0 / 6 + r2 * (1.0 / 120 + r2 * (-1.0 / 5040 + r2 * (1.0 / 362880 + r2 * (-1.0 / 39916800 + r2 * (1.0 / 6227020800.0)))))));
    const double c = 1.0 + r2 * (-0.5 + r2 * (1.0 / 24 + r2 * (-1.0 / 720 + r2 * (1.0 / 40320 + r2 * (-1.0 / 3628800 + r2 * (1.0 / 479001600 + r2 * (-1.0 / 87178291200.0)))))));
    const int q = (int)((long long)k & 3);
    sn = (float)(q == 0 ? s : q == 1 ? c : q == 2 ? -s : -c); cs = (float)(q == 0 ? c : q == 1 ? -s : q == 2 ? -c : s);
}
DI void prologue(int wv, unsigned char* ws, float* out, LAS unsigned char* lds) {
    unsigned z_ = 0u; asm volatile("" : "+v"(z_)); const int tid_ = wv * 64 + (int)__builtin_amdgcn_mbcnt_hi(~0u, __builtin_amdgcn_mbcnt_lo(~0u, z_)); const int tid = tid_, w = __builtin_amdgcn_readfirstlane(tid >> 6), lane = tid & 63, G = gridDim.x;
    const int gw = blockIdx.x * 8 + w, NGW = G * 8; const int gt = blockIdx.x * NTHR + tid, NGT = G * NTHR;
    { float* rc = (float*)(ws + WS_ROPE); float* rs = rc + (size_t)S * 32;
      for (int i = gt; i < S * 32; i += NGT) { const int pos = i >> 5, j = i & 31; double inv = 1.0; for (int q = 0; q < j; ++q) inv *= 0.74989420933245587; float sn, cs; sincos_d((double)pos * inv, sn, cs); rc[i] = cs; rs[i] = sn; } }
    { bf16* xb = (bf16*)(ws + WS_XB); float* ss0 = (float*)(ws + WS_SS); bf16* mn = (bf16*)(ws + WS_MN);
      for (int m = gw; m < MT + 512; m += NGW) {
          const float* src = m < MP ? IN(I_XP) + (size_t)m * D : m < MT ? IN(I_XS) + (size_t)(m - MP) * D : IN(I_MEM) + (size_t)(m - MT) * D;
          f32x4 v[4]; float s = 0.f;
#pragma unroll
          for (int j = 0; j < 4; ++j) { v[j] = *((const f32x4*)src + lane + 64 * j); }
          if (m < MT) {
              bf16* o = xb + (size_t)m * D;
#pragma unroll
              for (int j = 0; j < 4; ++j) { u32x2 wv; wv.x = pk2(v[j][0], v[j][1]); wv.y = pk2(v[j][2], v[j][3]); *((u32x2*)o + lane + 64 * j) = wv; const f32x4 r = unpk4(wv); s += (r[0] * r[0] + r[1] * r[1]) + (r[2] * r[2] + r[3] * r[3]); }
              s = wave_sum(s); if (lane < 16) ss0[(size_t)m * 16 + lane] = lane == 0 ? s : 0.f;
          } else {
#pragma unroll
              for (int j = 0; j < 4; ++j) s += (v[j][0] * v[j][0] + v[j][1] * v[j][1]) + (v[j][2] * v[j][2] + v[j][3] * v[j][3]);
              const float rstd = rsqrtf(wave_sum(s) * (1.f / D) + EPS); bf16* o = mn + (size_t)(m - MT) * D;
#pragma unroll
              for (int j = 0; j < 4; ++j) st4bf(o + 4 * (lane + 64 * j), v[j] * rstd);
          }
      } }
    { LAS float* scr = (LAS float*)(lds + w * 16384);
      constexpr int I1 = 16 * 176, ID = 44 * 32, IIN = 16 * 64, ISQ = 16 * 32, IKV = 16 * 64, IL = 2 * I1 + 2 * ID + IIN + 3 * ISQ + IKV;
      for (int it = gw; it < NL * IL; it += NGW) {
          const int l = it / IL; int r = it % IL; unsigned char* wl = ws + WS_W + (size_t)l * LW;
          if (r < 2 * I1) { const int second = r >= I1; if (second) r -= I1; const int nb = r % 176, kb = r / 176, n0 = nb * 32, pn = n0 >> 8, rr = n0 & 255;
              const float* W = (second ? (rr >= 128 ? IN(I_F2U) : IN(I_F2G)) : (rr >= 128 ? IN(I_F1U) : IN(I_F1G))) + (size_t)l * D * FF;
              tr_item(W, FF, pn * 128 + (rr & 127), (second ? IN(I_F2N) : IN(I_F1N)) + l * D, (bf16*)(wl + (second ? W_2 : W_1)), D, n0, kb * 64, scr, lane); continue; }
          r -= 2 * I1;
          if (r < 2 * ID) { const int second = r >= ID; if (second) r -= ID; const int nb = r % 32, kb = r / 32;
              tr_item((second ? IN(I_F2D) : IN(I_F1D)) + (size_t)l * FF * D, D, nb * 32, nullptr, (bf16*)(wl + (second ? W_D2 : W_D1)), FF, nb * 32, kb * 64, scr, lane); continue; }
          r -= 2 * ID;
          if (r < IIN) { const int nb = r % 64, kb = r / 64; tr_item(IN(I_WIN) + (size_t)l * D * 2048, 2048, map_win(nb * 32), IN(I_MIXN) + l * D, (bf16*)(wl + W_IN), D, nb * 32, kb * 64, scr, lane); continue; }
          r -= IIN;
          if (r < 3 * ISQ) { const int which = r / ISQ; r -= which * ISQ; const int nb = r % 32, kb = r / 32;
              const float* W = (which == 0 ? IN(I_WOUT) : which == 1 ? IN(I_WQ) : IN(I_WO)) + (size_t)l * D * D; const float* g = which == 0 ? IN(I_MON) + l * D : which == 1 ? IN(I_XAN) + l * D : nullptr;
              tr_item(W, D, nb * 32, g, (bf16*)(wl + (which == 0 ? W_OUT : which == 1 ? W_Q : W_O)), D, nb * 32, kb * 64, scr, lane); continue; }
          r -= 3 * ISQ;
          { const int nb = r % 64, kb = r / 64, n0 = nb * 32; tr_item((n0 < 1024 ? IN(I_WK) : IN(I_WV)) + (size_t)l * D * D, D, n0 & 1023, IN(I_MEMN) + l * D, (bf16*)(wl + W_KV), D, n0, kb * 64, scr, lane); }
      } }
}

DI f32x16 mfma32(bf16x8 a, bf16x8 b, f32x16 c) { return __builtin_amdgcn_mfma_f32_32x32x16_bf16(a, b, c, 0, 0, 0); }
constexpr int MX_KSZ = 192 * 144, MX_VOFF = 2 * MX_KSZ, MX_VP = 392, MX_SSB = MX_VOFF + 128 * MX_VP, MX_WC = MX_SSB + 2048, MX_END = MX_WC + 48 * 256 * 4;
static_assert(MX_END <= LDS_TAB, "mixer LDS");

template <int TW, class LA, class LC, class LCP, class LG> DI void conv_tokens(int l, LAS unsigned char* lds, int lane, LA ldA, LC ldC, LCP ldCp, LG ldG, bf16* ymix_row0  ) {
    const int ch = 4 * lane;
    const float* caw = IN(I_CAW) + (size_t)l * 3 * 256 + ch; const f32x4 wa0 = *(const f32x4*)caw, wa1 = *(const f32x4*)(caw + 256), wa2 = *(const f32x4*)(caw + 512);
    const LAS float* wc = (const LAS float*)(lds + MX_WC) + ch;
    f32x4 accA[TW], accC[TW];
    const f32x4 bias = *(const f32x4*)(IN(I_CCB) + l * 256 + ch);
#pragma unroll
    for (int t = 0; t < TW; ++t) { accA[t] = (f32x4){0.f, 0.f, 0.f, 0.f}; accC[t] = bias; }
#pragma unroll
    for (int i = 0; i < TW + 2; ++i) { const f32x4 x = ldA(i);
#pragma unroll
        for (int t = 0; t < TW; ++t) { const int j = i - t; if (j == 0) accA[t] += wa0 * x; else if (j == 1) accA[t] += wa1 * x; else if (j == 2) accA[t] += wa2 * x; } }
    constexpr int NWIN = TW + 30;
    {
#pragma unroll 1
        for (int ib = 0; ib < NWIN; ib += 16) {
            f32x4 x[16];
#pragma unroll
            for (int ii = 0; ii < 16; ++ii) x[ii] = ldC(ib + ii);
#pragma unroll
            for (int ii = 0; ii < 16; ++ii)
#pragma unroll
                for (int t = 0; t < TW; ++t) accC[t] += *(const LAS f32x4*)(wc + (ib + ii - t + 8) * 256) * x[ii];
        }
    }
    const f32x4 lng = *(const f32x4*)(IN(I_LNG) + l * 256 + ch), lnb = *(const f32x4*)(IN(I_LNB) + l * 256 + ch);
#pragma unroll
    for (int t = 0; t < TW; ++t) {
        const f32x4 ya = ldG(t) * accA[t];
        const float ssa = wave_sum((ya[0] * ya[0] + ya[1] * ya[1]) + (ya[2] * ya[2] + ya[3] * ya[3]));
        st4bf(ymix_row0 + (size_t)t * D + ch, ya * rsqrtf(ssa * (1.f / 256) + EPS));
        const f32x4 cc = accC[t];
        const float mean = wave_sum((cc[0] + cc[1]) + (cc[2] + cc[3])) * (1.f / 256); const f32x4 dc = cc - mean;
        const float var = wave_sum((dc[0] * dc[0] + dc[1] * dc[1]) + (dc[2] * dc[2] + dc[3] * dc[3])) * (1.f / 256);
        const f32x4 ln = dc * rsqrtf(var + EPS) * lng + lnb; f32x4 yc;
#pragma unroll
        for (int e = 0; e < 4; ++e) yc[e] = ln[e] * sigmoidf_(ln[e]);
        const float ssc = wave_sum((yc[0] * yc[0] + yc[1] * yc[1]) + (yc[2] * yc[2] + yc[3] * yc[3]));
        st4bf(ymix_row0 + (size_t)t * D + 768 + ch, yc * rsqrtf(ssc * (1.f / 256) + EPS));
    }
}

template <bool SMP> DI void attn_qb(const LAS unsigned char* Kl, const LAS unsigned char* Vl, const bf16* qp, float sink2, int kb0, f32x16 (&o)[2]) {
    bf16x8 qf[4];
#pragma unroll
    for (int ks = 0; ks < 4; ++ks) qf[ks] = *(const bf16x8*)(qp + ks * 16);
    f32x16 s[6];
#pragma unroll
    for (int kb = 0; kb < 6; ++kb)
#pragma unroll
        for (int i = 0; i < 16; ++i) s[kb][i] = 0.f;
#pragma unroll
    for (int ks = 0; ks < 4; ++ks)
#pragma unroll
        for (int kb = 0; kb < 6; ++kb) { const bf16x8 a = *(const LAS bf16x8*)(Kl + kb * 32 * 144 + ks * 32); s[kb] = mfma32(a, qf[ks], s[kb]); }
#pragma unroll
    for (int kb = 0; kb < 6; ++kb) { if (SMP ? kb == 5 : kb < kb0) {
#pragma unroll
            for (int i = 0; i < 16; ++i) s[kb][i] = -3.0e38f; }
        if (SMP && kb == 4) {
#pragma unroll
            for (int i = 8; i < 16; ++i) s[kb][i] = -3.0e38f; } }
    float m4[4] = {sink2, sink2, sink2, sink2};
#pragma unroll
    for (int kb = 0; kb < 6; ++kb)
#pragma unroll
        for (int i = 0; i < 16; ++i) m4[i & 3] = fmaxf(m4[i & 3], s[kb][i]);
    float mx = fmaxf(fmaxf(m4[0], m4[1]), fmaxf(m4[2], m4[3]));
    mx = fmaxf(mx, __shfl_xor(mx, 32));
    float s4[4] = {0.f, 0.f, 0.f, 0.f};
#pragma unroll
    for (int kb = 0; kb < 6; ++kb)
#pragma unroll
        for (int i = 0; i < 16; ++i) { s[kb][i] = __builtin_amdgcn_exp2f(s[kb][i] - mx); s4[i & 3] += s[kb][i]; }
    float sum = (s4[0] + s4[1]) + (s4[2] + s4[3]);
    sum += __shfl_xor(sum, 32);
    const float inv = __builtin_amdgcn_rcpf(sum + __builtin_amdgcn_exp2f(sink2 - mx));
    f32x16 o2[2][2];
#pragma unroll
    for (int hb = 0; hb < 2; ++hb)
#pragma unroll
        for (int t = 0; t < 2; ++t)
#pragma unroll
            for (int i = 0; i < 16; ++i) o2[hb][t][i] = 0.f;
#pragma unroll
    for (int kb = 0; kb < 6; ++kb)
#pragma unroll
        for (int t = 0; t < 2; ++t) {
            u32x4 pw; pw.x = pk2(s[kb][8 * t] * inv, s[kb][8 * t + 1] * inv); pw.y = pk2(s[kb][8 * t + 2] * inv, s[kb][8 * t + 3] * inv);
            pw.z = pk2(s[kb][8 * t + 4] * inv, s[kb][8 * t + 5] * inv); pw.w = pk2(s[kb][8 * t + 6] * inv, s[kb][8 * t + 7] * inv);
            const bf16x8 pf = __builtin_bit_cast(bf16x8, pw);
#pragma unroll
            for (int hb = 0; hb < 2; ++hb) {
                const LAS unsigned char* vp = Vl + hb * 32 * MX_VP + (kb * 32 + t * 16) * 2;
                const u32x2 lo = *(const LAS u32x2*)vp, hi = *(const LAS u32x2*)(vp + 16);
                const bf16x8 vf = __builtin_bit_cast(bf16x8, (u32x4){lo.x, lo.y, hi.x, hi.y});
                o2[hb][t] = mfma32(vf, pf, o2[hb][t]);
            }
        }
#pragma unroll
    for (int hb = 0; hb < 2; ++hb) o[hb] = o2[hb][0] + o2[hb][1];
}

DI void mixer_phase(int wv, unsigned char* ws, float* out, int l, LAS unsigned char* lds, int G, int bx) {
    unsigned z_ = 0u; asm volatile("" : "+v"(z_)); const int tid_ = wv * 64 + (int)__builtin_amdgcn_mbcnt_hi(~0u, __builtin_amdgcn_mbcnt_lo(~0u, z_)); const int tid = tid_, w = __builtin_amdgcn_readfirstlane(tid >> 6), lane = tid & 63, r = lane & 31, hf = lane >> 5;
    unsigned char* R = ws + WS_R;
    const bf16* gb = (const bf16*)(R + R_GB); const bf16* cv = (const bf16*)(R + R_CV); const bf16* qb_ = (const bf16*)(R + R_Q); const bf16* kb_ = (const bf16*)(R + R_K);
    const bf16* vT = (const bf16*)(R + R_VT); const bf16* vS = (const bf16*)(R + R_VS); const bf16* glu = (const bf16*)(R + R_GLU); bf16* ymix = (bf16*)(R + R_YMIX);
    { const float* src = IN(I_CCW) + (size_t)l * 31 * 256; LAS float* dst = (LAS float*)(lds + MX_WC);
#pragma unroll
      for (int it = 0; it < 6; ++it) { const int i4 = tid + it * NTHR, j = (i4 >> 6) - 8; const bool ok = j >= 0 && j <= 30; const f32x4 v = *(const f32x4*)(src + (ok ? j : 0) * 256 + (i4 & 63) * 4);
          *(LAS f32x4*)(dst + i4 * 4) = ok ? v : (f32x4){0.f, 0.f, 0.f, 0.f}; } }
    const float sink2 = IN(I_SINK)[l * 8 + w] * LOG2E;
    LAS float* ssb = (LAS float*)(lds + MX_SSB);
    __syncthreads();
#ifndef PROBE
#define PROBE 0
#endif
    for (int rep_ = 0; rep_ < (PROBE == 12 ? 2 : 1); ++rep_)
    for (int u = bx; u < NB * 256; u += G) {
        const int b = u >> 8, n = u & 255; const size_t row0 = (size_t)b * S + n * 64;
        u32x4 kreg[6], vreg[6];
#pragma unroll
        for (int it = 0; it < 6; ++it) {
            const int p = tid + it * NTHR, key = p >> 4, part = p & 15, pos = n * 64 - 128 + key;
            kreg[it] = *(const u32x4*)(kb_ + ((size_t)b * S + (pos >= 0 ? pos : 0)) * 128 + part * 8);
            const int rr = p / 24, pc = p % 24, pos0 = n * 64 - 128 + pc * 8;
            vreg[it] = *(const u32x4*)(vT + ((size_t)(b * 128 + rr)) * S + (pos0 >= 0 ? pos0 : 0));
        }
        const int t0 = w * 8, p0 = n * 64 + t0; const size_t brow = (size_t)b * S;
        auto ldP = [&](const bf16* base, int p) -> u32x2 { const u32x2 v = *(const u32x2*)(base + (brow + (p >= 0 ? p : 0)) * 256 + 4 * lane); return p >= 0 ? v : (u32x2){0u, 0u}; };
        u32x2 wa_[10], wg_[8], w0_[8], nw_[8];
#pragma unroll
        for (int i = 0; i < 10; ++i) wa_[i] = ldP(cv, p0 - 2 + i);
#pragma unroll
        for (int i = 0; i < 8; ++i) { wg_[i] = ldP(gb, p0 + i); w0_[i] = ldP(glu, p0 - 30 + i); nw_[i] = ldP(glu, p0 - 22 + i); }
#pragma unroll
        for (int it = 0; it < 6; ++it) {
            const int p = tid + it * NTHR, key = p >> 4, part = p & 15, pos = n * 64 - 128 + key;
            *(LAS u32x4*)(lds + (part >> 3) * MX_KSZ + key * 144 + (part & 7) * 16) = pos >= 0 ? kreg[it] : (u32x4){0u, 0u, 0u, 0u};
            const int rr = p / 24, pc = p % 24, pos0 = n * 64 - 128 + pc * 8; const u32x4 v = pos0 >= 0 ? vreg[it] : (u32x4){0u, 0u, 0u, 0u};
            LAS u32x2* d = (LAS u32x2*)(lds + MX_VOFF + rr * MX_VP + pc * 16); d[0] = (u32x2){v.x, v.y}; d[1] = (u32x2){v.z, v.w};
        }
        {
            const int ch = 4 * lane;
            const float* caw = IN(I_CAW) + (size_t)l * 3 * 256 + ch; const f32x4 wa0 = *(const f32x4*)caw, wa1 = *(const f32x4*)(caw + 256), wa2 = *(const f32x4*)(caw + 512);
            const LAS float* wc = (const LAS float*)(lds + MX_WC) + ch;
            const f32x4 bias = *(const f32x4*)(IN(I_CCB) + l * 256 + ch);
            const f32x4 lng = *(const f32x4*)(IN(I_LNG) + l * 256 + ch), lnb = *(const f32x4*)(IN(I_LNB) + l * 256 + ch);
            f32x4 accC[8], Rg[8];
#pragma unroll
            for (int t = 0; t < 8; ++t) { accC[t] = bias; Rg[t] = unpk4(w0_[t]); }
#pragma unroll 1
            for (int jb = 0; jb < 32; jb += 8) {
                u32x2 nx[8];
#pragma unroll
                for (int s = 0; s < 8; ++s) { const int i = jb + 16 + s; nx[s] = (i < 38) ? ldP(glu, p0 - 30 + i) : (u32x2){0u, 0u}; }
#pragma unroll
                for (int s = 0; s < 8; ++s) { const f32x4 wt = *(const LAS f32x4*)(wc + (jb + s + 8) * 256);
#pragma unroll
                    for (int t = 0; t < 8; ++t) accC[t] += wt * Rg[(t + s) & 7];
                    Rg[s] = unpk4(nw_[s]); }
#pragma unroll
                for (int s = 0; s < 8; ++s) nw_[s] = nx[s];
            }
            bf16* yrow = ymix + (brow + p0) * D;
#pragma unroll
            for (int t = 0; t < 8; ++t) {
                const f32x4 ya = unpk4(wg_[t]) * (wa0 * unpk4(wa_[t]) + wa1 * unpk4(wa_[t + 1]) + wa2 * unpk4(wa_[t + 2]));
                const float ssa = wave_sum((ya[0] * ya[0] + ya[1] * ya[1]) + (ya[2] * ya[2] + ya[3] * ya[3]));
                st4bf(yrow + (size_t)t * D + ch, ya * rsqrtf(ssa * (1.f / 256) + EPS));
                const f32x4 cc = accC[t];
                const float mean = wave_sum((cc[0] + cc[1]) + (cc[2] + cc[3])) * (1.f / 256); const f32x4 dc = cc - mean;
                const float var = wave_sum((dc[0] * dc[0] + dc[1] * dc[1]) + (dc[2] * dc[2] + dc[3] * dc[3])) * (1.f / 256);
                const f32x4 ln = dc * rsqrtf(var + EPS) * lng + lnb; f32x4 yc;
#pragma unroll
                for (int e = 0; e < 4; ++e) yc[e] = ln[e] * sigmoidf_(ln[e]);
                const float ssc = wave_sum((yc[0] * yc[0] + yc[1] * yc[1]) + (yc[2] * yc[2] + yc[3] * yc[3]));
                st4bf(yrow + (size_t)t * D + 768 + ch, yc * rsqrtf(ssc * (1.f / 256) + EPS));
            }
        }
        __syncthreads();
        const int kvh = w >> 2, kb0 = n >= 2 ? 0 : (2 - n) * 2;
        const LAS unsigned char* Kl = lds + kvh * MX_KSZ + r * 144 + hf * 16; const LAS unsigned char* Vl = lds + MX_VOFF + (kvh * 64 + r) * MX_VP + hf * 8;
#pragma unroll 1
        for (int qb = 0; qb < (PROBE == 17 ? 4 : 2); ++qb) {
            f32x16 o[2]; attn_qb<false>(Kl, Vl, qb_ + (row0 + (qb & 1) * 32 + r) * 512 + w * 64 + hf * 8, sink2, kb0, o);
            float sq = 0.f;
#pragma unroll
            for (int hb = 0; hb < 2; ++hb)
#pragma unroll
                for (int i = 0; i < 16; ++i) sq += o[hb][i] * o[hb][i];
            sq += __shfl_xor(sq, 32);
            if (hf == 0) ssb[((qb & 1) * 8 + w) * 32 + r] = sq;
            __syncthreads();
            float tot = 0.f;
#pragma unroll
            for (int hh = 0; hh < 8; ++hh) tot += ssb[((qb & 1) * 8 + hh) * 32 + r];
            const float rs = rsqrtf(tot * (1.f / 512) + EPS); bf16* yp = ymix + (row0 + (qb & 1) * 32 + r) * D + 256 + w * 64 + 4 * hf;
#pragma unroll
            for (int hb = 0; hb < 2; ++hb)
#pragma unroll
                for (int g = 0; g < 4; ++g) st4bf(yp + hb * 32 + 8 * g, (f32x4){o[hb][4 * g] * rs, o[hb][4 * g + 1] * rs, o[hb][4 * g + 2] * rs, o[hb][4 * g + 3] * rs});
        }
        __syncthreads();
    }
    for (int rep_ = 0; rep_ < ((PROBE == 13 || PROBE == 14) ? 2 : 1); ++rep_)
    for (int sb = bx - (G - 32); sb >= 0 && sb < 16; sb += G) {
        const size_t srow0 = (size_t)MP + sb * 16;
        const int t0 = w * 2; const float* sa = IN(I_SA) + ((size_t)(l * 16 + sb) * 2) * 256; const float* sc = IN(I_SC) + ((size_t)(l * 16 + sb) * 30) * 256;
        auto ldA = [&](int i) -> f32x4 { const int p = t0 - 2 + i; return p >= 0 ? ld4bf(cv + (srow0 + p) * 256 + 4 * lane) : *(const f32x4*)(sa + (2 + p) * 256 + 4 * lane); };
        auto ldC = [&](int i) -> f32x4 { const int p = t0 - 30 + i; return p >= 0 ? ld4bf(glu + (srow0 + p) * 256 + 4 * lane) : *(const f32x4*)(sc + (30 + p) * 256 + 4 * lane); };
        auto ldG = [&](int t) -> f32x4 { return ld4bf(gb + (srow0 + t0 + t) * 256 + 4 * lane); };
        conv_tokens<2>(l, lds, lane, ldA, ldC, ldC, ldG, ymix + (srow0 + t0) * D);
        float* oc = out + O_CS + ((size_t)(l * 16 + sb) * 30) * 256;
        for (int i = tid; i < 14 * 256; i += NTHR) oc[i] = sc[16 * 256 + i];
    }
    __syncthreads();
    for (int rep_ = 0; rep_ < ((PROBE == 13 || PROBE == 15) ? 2 : 1); ++rep_)
    for (int sb = bx - (G - 16); sb >= 0 && sb < 16; sb += G) {
        const size_t srow0 = (size_t)MP + sb * 16;
        const float* ck = IN(I_CK) + ((size_t)(l * 16 + sb) * 128) * 128; const float* cvv = IN(I_CV) + ((size_t)(l * 16 + sb) * 128) * 128;
        f32x4 kr_[8], vr_[8];
#pragma unroll
        for (int it = 0; it < 8; ++it) { const int i = tid + it * NTHR; kr_[it] = *(const f32x4*)(ck + (size_t)i * 4); vr_[it] = *(const f32x4*)(cvv + (size_t)i * 4); }
        u32x4 kn_ = (u32x4){0u, 0u, 0u, 0u}, vn_ = kn_;
        if (tid < 256) { kn_ = *(const u32x4*)(kb_ + (srow0 + (tid >> 4)) * 128 + (tid & 15) * 8); vn_ = *(const u32x4*)(vS + ((size_t)sb * 16 + (tid >> 4)) * 128 + (tid & 15) * 8); }
        for (int i = tid; i < 128 * 12; i += NTHR) { const int rr = i / 12, pc = i % 12; *(LAS u32x2*)(lds + MX_VOFF + rr * MX_VP + 288 + pc * 8) = (u32x2){0u, 0u}; }
#pragma unroll
        for (int it = 0; it < 8; ++it) {
            const int i = tid + it * NTHR, key = i >> 5, c = (i & 31) * 4;
            *(LAS u32x2*)(lds + (c >> 6) * MX_KSZ + key * 144 + (c & 63) * 2) = (u32x2){pk2(kr_[it][0], kr_[it][1]), pk2(kr_[it][2], kr_[it][3])};
#pragma unroll
            for (int e = 0; e < 4; ++e) *(LAS bf16*)(lds + MX_VOFF + (c + e) * MX_VP + key * 2) = f2bf(vr_[it][e]);
        }
        if (tid < 256) {
            const int key = 128 + (tid >> 4), part = tid & 15;
            *(LAS u32x4*)(lds + (part >> 3) * MX_KSZ + key * 144 + (part & 7) * 16) = kn_;
            const unsigned vw[4] = {vn_.x, vn_.y, vn_.z, vn_.w};
#pragma unroll
            for (int e = 0; e < 8; ++e) *(LAS bf16*)(lds + MX_VOFF + (part * 8 + e) * MX_VP + key * 2) = (bf16)((vw[e >> 1] >> ((e & 1) * 16)) & 0xffffu);
        }
        __syncthreads();
        {
            const int kvh = w >> 2, tq = r & 15;
            const LAS unsigned char* Kl = lds + kvh * MX_KSZ + r * 144 + hf * 16; const LAS unsigned char* Vl = lds + MX_VOFF + (kvh * 64 + r) * MX_VP + hf * 8;
            f32x16 o[2]; attn_qb<true>(Kl, Vl, qb_ + (srow0 + tq) * 512 + w * 64 + hf * 8, sink2, 0, o);
            float sq = 0.f;
#pragma unroll
            for (int hb = 0; hb < 2; ++hb)
#pragma unroll
                for (int i = 0; i < 16; ++i) sq += o[hb][i] * o[hb][i];
            sq += __shfl_xor(sq, 32);
            if (hf == 0) ssb[w * 32 + r] = sq;
            __syncthreads();
            float tot = 0.f;
#pragma unroll
            for (int hh = 0; hh < 8; ++hh) tot += ssb[hh * 32 + r];
            const float rs = rsqrtf(tot * (1.f / 512) + EPS); bf16* yp = ymix + (srow0 + tq) * D + 256 + w * 64 + 4 * hf;
            if (r < 16) {
#pragma unroll
                for (int hb = 0; hb < 2; ++hb)
#pragma unroll
                    for (int g = 0; g < 4; ++g) st4bf(yp + hb * 32 + 8 * g, (f32x4){o[hb][4 * g] * rs, o[hb][4 * g + 1] * rs, o[hb][4 * g + 2] * rs, o[hb][4 * g + 3] * rs});
            }
        }
        __syncthreads();
    }
}

DI void xattn_sample(int wv, unsigned char* ws, float* out, int l, LAS unsigned char* lds, int G, int bx) {
    unsigned z_ = 0u; asm volatile("" : "+v"(z_)); const int tid_ = wv * 64 + (int)__builtin_amdgcn_mbcnt_hi(~0u, __builtin_amdgcn_mbcnt_lo(~0u, z_)); const int tid = tid_, w = __builtin_amdgcn_readfirstlane(tid >> 6), lane = tid & 63, fr = lane & 15, fq = lane >> 4;
    bf16* qx = (bf16*)(ws + WS_R + R_QX);
    LAS float* PS = (LAS float*)lds;
    LAS float* RM = (LAS float*)(lds + 16 * 260 * 4);
    for (int u = bx - (G - 64); u >= 0 && u < 64; u += G) {
        const int sb = u >> 2, h = u & 3; const size_t srow0 = (size_t)MP + sb * 16;
        const float* mk = IN(I_MK) + (((size_t)(l * 16 + sb) * 256) * 4 + h) * 256; const float* mv = IN(I_MV) + (((size_t)(l * 16 + sb) * 256) * 4 + h) * 256;
        f32x4 acc[2] = {(f32x4){0.f, 0.f, 0.f, 0.f}, (f32x4){0.f, 0.f, 0.f, 0.f}};
        const bf16* qp = qx + (srow0 + fr) * D + h * 256 + fq * 8;
#pragma unroll
        for (int ks = 0; ks < 8; ++ks) {
            const bf16x8 qf = *(const bf16x8*)(qp + ks * 32);
#pragma unroll
            for (int kbk = 0; kbk < 2; ++kbk) {
                const float* kp = mk + (size_t)(w * 32 + kbk * 16 + fr) * 1024 + ks * 32 + fq * 8; const f32x4 k0 = *(const f32x4*)kp, k1 = *(const f32x4*)(kp + 4);
                u32x4 kw; kw.x = pk2(k0[0], k0[1]); kw.y = pk2(k0[2], k0[3]); kw.z = pk2(k1[0], k1[1]); kw.w = pk2(k1[2], k1[3]);
                acc[kbk] = __builtin_amdgcn_mfma_f32_16x16x32_bf16(__builtin_bit_cast(bf16x8, kw), qf, acc[kbk], 0, 0, 0);
            }
        }
#pragma unroll
        for (int kbk = 0; kbk < 2; ++kbk)
#pragma unroll
            for (int i = 0; i < 4; ++i) PS[fr * 260 + w * 32 + kbk * 16 + 4 * fq + i] = acc[kbk][i];
        __syncthreads();
#pragma unroll
        for (int tt = 0; tt < 2; ++tt) { LAS float* sp = PS + (2 * w + tt) * 260; const f32x4 x = *(LAS f32x4*)(sp + 4 * lane);
            const float mx = wave_max(fmaxf(fmaxf(x[0], x[1]), fmaxf(x[2], x[3])));
            f32x4 e; for (int i = 0; i < 4; ++i) e[i] = __builtin_amdgcn_exp2f(x[i] - mx);
            const float inv = 1.f / wave_sum((e[0] + e[1]) + (e[2] + e[3]));
            for (int i = 0; i < 4; ++i) e[i] = bf2f(f2bf(e[i] * inv));
            *(LAS f32x4*)(sp + 4 * lane) = e; }
        __syncthreads();
        {
            f32x4 acc[16];
#pragma unroll
            for (int t = 0; t < 16; ++t) acc[t] = (f32x4){0.f, 0.f, 0.f, 0.f};
#pragma unroll 1
            for (int jb = 0; jb < 32; jb += 8) {
                f32x4 vv[8];
#pragma unroll
                for (int jj = 0; jj < 8; ++jj) vv[jj] = *(const f32x4*)(mv + (size_t)(w + 8 * (jb + jj)) * 1024 + 4 * lane);
#pragma unroll
                for (int jj = 0; jj < 8; ++jj) { const int key = w + 8 * (jb + jj);
#pragma unroll
                    for (int t = 0; t < 16; ++t) acc[t] += PS[t * 260 + key] * vv[jj]; }
            }
            LAS float* OP = (LAS float*)(lds + 32768);
#pragma unroll
            for (int half = 0; half < 2; ++half) {
#pragma unroll
                for (int tt = 0; tt < 8; ++tt) *(LAS f32x4*)(OP + (w * 8 + tt) * 256 + 4 * lane) = acc[half * 8 + tt];
                __syncthreads();
                f32x4 sum = (f32x4){0.f, 0.f, 0.f, 0.f};
#pragma unroll
                for (int ww = 0; ww < 8; ++ww) sum += *(LAS f32x4*)(OP + (ww * 8 + w) * 256 + 4 * lane);
                st4bf(qx + (srow0 + half * 8 + w) * D + h * 256 + 4 * lane, sum);
                __syncthreads();
            }
        }
    }
    (void)RM;
}

DI void final_norm(int wv, unsigned char* ws, float* out, LAS unsigned char* lds) {
    unsigned z_ = 0u; asm volatile("" : "+v"(z_)); const int tid_ = wv * 64 + (int)__builtin_amdgcn_mbcnt_hi(~0u, __builtin_amdgcn_mbcnt_lo(~0u, z_)); const int tid = tid_, w = __builtin_amdgcn_readfirstlane(tid >> 6), lane = tid & 63, gw = blockIdx.x * 8 + w, NGW = gridDim.x * 8;
    const bf16* xb = (const bf16*)(ws + WS_XB); const float* ss = (const float*)(ws + WS_SS) + (size_t)8 * MT * 16; const float* g = IN(I_FIN);
    f32x4 gv[4];
#pragma unroll
    for (int j = 0; j < 4; ++j) gv[j] = *((const f32x4*)g + lane + 64 * j);
    for (int m = gw; m < MT; m += NGW) {
        const float rs = rsqrtf(ss_row(ss, m) * (1.f / D) + EPS); float* o = out + (m < MP ? O_YP + (size_t)m * D : O_YS + (size_t)(m - MP) * D);
#pragma unroll
        for (int j = 0; j < 4; ++j) { const f32x4 x = ld4bf(xb + (size_t)m * D + 4 * (lane + 64 * j)); *((f32x4*)o + lane + 64 * j) = x * rs * gv[j]; }
    }
}

#ifndef EN
#define EN 0xFFFFF
#endif
#ifndef ONE_LAUNCH
#define ONE_LAUNCH 1
#endif
constexpr int N_PHASES = 24;

template <int NM, int NN, size_t A_M, size_t A_N, size_t B_B, size_t B_N, int BSHIFT, class F>
DI void run_gemm(int wv, LAS unsigned char* lds, int G, int bx, const bf16* A_, int lda, const bf16* Bt, int ldb, int K, const F& f) {
    pg8::Gemm g{A_, Bt, lda, ldb, K, wv}; pg8::Sched<NM, NN, A_M, A_N, B_B, B_N, BSHIFT> Sc; Sc.G = G; Sc.c = bx;
    EpiA<F> E{f};
    pg8::gemm_phase<EpiA<F>, pg8::Sched<NM, NN, A_M, A_N, B_B, B_N, BSHIFT>, true, true>(lds, g, Sc, E);
}
template <int K, int N, class F> DI void prompt_gemm(int wv, LAS unsigned char* lds, int G, int bx, const bf16* A_, const bf16* Bt, const F& f) {
    run_gemm<MP / 256, N / 256, (size_t)256 * K * 2, 0, 0, (size_t)256 * K * 2, 31>(wv, lds, G, bx, A_, K, Bt, K, K, f);
}


#define XB_TMO      128
#define XB_XCNT(j)  (256  + 64 * (j))
#define XB_XSUB(j)  (1280 + 64 * (j))
#define XB_XGEN(j)  (2304 + 64 * (j))
#define XB_TOP      3328
#define XB_TOPGEN   3392
#define XCD_BAR_WORDS 3456
#define XB_SPIN_CAP (1u << 18)
DI unsigned xb_ld(unsigned* p)              { return __hip_atomic_load(p, __ATOMIC_RELAXED, __HIP_MEMORY_SCOPE_AGENT); }
DI unsigned xb_add(unsigned* p, unsigned v) { return __hip_atomic_fetch_add(p, v, __ATOMIC_RELAXED, __HIP_MEMORY_SCOPE_AGENT); }
DI unsigned xb_xcc_id() { return (unsigned)__builtin_amdgcn_s_getreg((3 << 11) | 20) & 0xFu; }
#define XB_SPIN(cond, bar) do { unsigned _sp = 0; while (cond) { __builtin_amdgcn_s_sleep(1); \
    if ((++_sp & 255u) == 0u) { if (xb_ld(&(bar)[XB_TMO])) break; if (_sp > XB_SPIN_CAP) { atomicAdd(&(bar)[XB_TMO], 1u); break; } } } } while (0)
DI void xcd_barrier_complete(unsigned* bar, unsigned x, unsigned G, unsigned& nloc, unsigned& nx) {
    unsigned sum, cnt, mine, sp = 0u;
    for (;;) {
        sum = 0u; cnt = 0u; mine = 0u;
#pragma unroll
        for (unsigned j = 0; j < 16; ++j) { const unsigned c = xb_ld(&bar[XB_XCNT(j)]); sum += c; cnt += (c > 0u) ? 1u : 0u; mine = (j == x) ? c : mine; }
        if (sum == G) break;
        __builtin_amdgcn_s_sleep(1);
        if ((++sp & 255u) == 0u) { if (xb_ld(&bar[XB_TMO])) break; if (sp > XB_SPIN_CAP) { atomicAdd(&bar[XB_TMO], 1u); break; } }
    }
    nloc = mine > 0u ? mine : 1u; nx = cnt > 0u ? cnt : 1u;
}
DI void xcd_barrier(unsigned* bar, volatile LAS unsigned* st, bool first_thread, unsigned G) {
    asm volatile("s_waitcnt vmcnt(0)" ::: "memory");
    __syncthreads();
    if (first_thread) {
        const unsigned x = xb_xcc_id();
        __builtin_amdgcn_s_waitcnt(0);
        unsigned nloc = st[0], nx = st[1];
        if (nloc == 0u) { xcd_barrier_complete(bar, x, G, nloc, nx); st[0] = nloc; st[1] = nx; }
        const unsigned old = xb_add(&bar[XB_XSUB(x)], 1u);
        const unsigned gen = old / nloc;
        if (old + 1u == (gen + 1u) * nloc) {
            __builtin_amdgcn_fence(__ATOMIC_RELEASE, "agent");
            asm volatile("s_waitcnt vmcnt(0)" ::: "memory");
            const unsigned og = xb_add(&bar[XB_TOP], 1u);
            const unsigned tg = og / nx;
            if (og + 1u == (tg + 1u) * nx) xb_add(&bar[XB_TOPGEN], 1u);
            else XB_SPIN(xb_ld(&bar[XB_TOPGEN]) == tg, bar);
            __builtin_amdgcn_fence(__ATOMIC_ACQUIRE, "agent");
            xb_add(&bar[XB_XGEN(x)], 1u);
            asm volatile("s_waitcnt vmcnt(0)" ::: "memory");
        } else {
            XB_SPIN(xb_ld(&bar[XB_XGEN(x)]) == gen, bar);
            __builtin_amdgcn_fence(__ATOMIC_ACQUIRE, "agent");
            asm volatile("s_waitcnt vmcnt(0)" ::: "memory");
        }
    }
    __syncthreads();
}

__global__ void __launch_bounds__(NTHR, 2) fwd_kernel(Args A) {
    extern __shared__ __attribute__((aligned(16))) unsigned char lds_raw[];
    LAS unsigned char* lds = (LAS unsigned char*)lds_raw;
    const int lo = A.ph_lo, hi = A.ph_hi; const int wv = __builtin_amdgcn_readfirstlane((int)threadIdx.x >> 6);
    unsigned char* ws = A.ws; float* out = A.out;
    if (threadIdx.x == 0) { LAS unsigned long long* T = (LAS unsigned long long*)(lds + LDS_TAB);
        T[0] = (unsigned long long)A.in[0];
        T[1] = (unsigned long long)A.in[1];
        T[2] = (unsigned long long)A.in[2];
        T[3] = (unsigned long long)A.in[3];
        T[4] = (unsigned long long)A.in[4];
        T[5] = (unsigned long long)A.in[5];
        T[6] = (unsigned long long)A.in[6];
        T[7] = (unsigned long long)A.in[7];
        T[8] = (unsigned long long)A.in[8];
        T[9] = (unsigned long long)A.in[9];
        T[10] = (unsigned long long)A.in[10];
        T[11] = (unsigned long long)A.in[11];
        T[12] = (unsigned long long)A.in[12];
        T[13] = (unsigned long long)A.in[13];
        T[14] = (unsigned long long)A.in[14];
        T[15] = (unsigned long long)A.in[15];
        T[16] = (unsigned long long)A.in[16];
        T[17] = (unsigned long long)A.in[17];
        T[18] = (unsigned long long)A.in[18];
        T[19] = (unsigned long long)A.in[19];
        T[20] = (unsigned long long)A.in[20];
        T[21] = (unsigned long long)A.in[21];
        T[22] = (unsigned long long)A.in[22];
        T[23] = (unsigned long long)A.in[23];
        T[24] = (unsigned long long)A.in[24];
        T[25] = (unsigned long long)A.in[25];
        T[26] = (unsigned long long)A.in[26];
        T[27] = (unsigned long long)A.in[27];
        T[28] = (unsigned long long)A.in[28];
        T[29] = (unsigned long long)A.in[29];
        T[30] = (unsigned long long)A.in[30];
        T[31] = (unsigned long long)A.in[31];
        T[32] = (unsigned long long)A.in[32];
        T[33] = (unsigned long long)A.in[33];
        *(LAS unsigned*)(lds + LDS_TAB + 384) = 0u; *(LAS unsigned*)(lds + LDS_TAB + 388) = 0u;
        (void)xb_add(&((unsigned*)ws)[XB_XCNT(xb_xcc_id())], 1u);
    }
    __syncthreads();
#ifndef CG_ALL
#define CG_ALL 0
#endif
#define SYNC(ph) do { if ((ph) + 1 < hi) { if (CG_ALL || (ph) == 0) cg::this_grid().sync(); else for (int rb_ = 0; rb_ < (PROBE == 16 ? 2 : 1); ++rb_) { unsigned z2_ = 0u; asm volatile("" : "+v"(z2_)); const bool ft_ = wv == 0 && __builtin_amdgcn_mbcnt_hi(~0u, __builtin_amdgcn_mbcnt_lo(~0u, z2_)) == 0u; xcd_barrier((unsigned*)ws, (volatile LAS unsigned*)(lds + LDS_TAB + 384), ft_, gridDim.x); } } } while (0)
    if (lo == 0) { if (EN & 0x10000) prologue(wv, ws, out, lds); __syncthreads();
#if PROBE == 3
        prologue(wv, ws, out, lds); __syncthreads();
#endif
        SYNC(0); }
    for (int ph = (lo > 1 ? lo : 1); ph < (hi < N_PHASES - 1 ? hi : N_PHASES - 1); ++ph) {
        int G = gridDim.x, bx = blockIdx.x; asm volatile("" : "+s"(G), "+s"(bx), "+s"(out));
        const int smp_c0 = (bx + G / 2) % G;
        const int l = (ph - 1) / 11, k = (ph - 1) % 11;
        asm volatile("" : "+s"(ws));
        unsigned char* R = ws + WS_R; bf16* xb = (bf16*)(ws + WS_XB); float* ss = (float*)(ws + WS_SS); bf16* hb = (bf16*)(R + R_H);
        unsigned char* wl = ws + WS_W + (size_t)l * LW;
        float* ssl = ss + (size_t)(4 * l) * MT * 16;
        if (!((EN >> k) & 1)) continue;
        switch (k) {
        case 0: case 9: {
            const bool second = k == 9;
            if (!second) {
                FMemKV f{out + O_MK + (size_t)l * 512 * D, out + O_MV + (size_t)l * 512 * D, (bf16*)(ws + WS_MKB) + (size_t)l * 512 * D, (bf16*)(ws + WS_MVT) + (size_t)l * 8 * 65536};
                run_gemm<2, 8, (size_t)256 * D * 2, 0, 0, (size_t)256 * D * 2, 31>(wv, lds, G, bx, (const bf16*)(ws + WS_MN), D, (const bf16*)(wl + W_KV), D, D, f);
                __syncthreads();
            }
            FUp f{ssl + (second ? 3 : 0) * (size_t)MT * 16, hb, (LAS float*)(lds + LDS_EPI)};
#if PROBE == 11
            { FUpCheap f0{hb}; prompt_gemm<D, 2 * FF>(wv, lds, G, bx, xb, (const bf16*)(wl + (second ? W_2 : W_1)), f0); __syncthreads(); }
#endif
            prompt_gemm<D, 2 * FF>(wv, lds, G, bx, xb, (const bf16*)(wl + (second ? W_2 : W_1)), f);
#if PROBE == 1
            __syncthreads(); prompt_gemm<D, 2 * FF>(wv, lds, G, bx, xb, (const bf16*)(wl + (second ? W_2 : W_1)), f);
#endif
            __syncthreads();
            sample_gemm_wide(wv, lds, xb, (const bf16*)(wl + (second ? W_2 : W_1)), 2 * FF / 256, f, G, smp_c0);
        } break;
        case 1: case 10: {
            const bool second = k == 10;
            FRes f{xb, ssl + (second ? 4 : 1) * (size_t)MT * 16, 0.5f};
#if PROBE == 4
            { FRes f0{xb, ssl + (second ? 4 : 1) * (size_t)MT * 16, 0.0f}; prompt_gemm<FF, D>(wv, lds, G, bx, hb, (const bf16*)(wl + (second ? W_D2 : W_D1)), f0); __syncthreads(); }
#endif
            prompt_gemm<FF, D>(wv, lds, G, bx, hb, (const bf16*)(wl + (second ? W_D2 : W_D1)), f);
            __syncthreads();
            sample_gemm<FF>(wv, lds, hb, FF, (const bf16*)(wl + (second ? W_D2 : W_D1)), FF, D / 256, f, G, smp_c0);
        } break;
        case 2: {
            FWin f{ssl + (size_t)MT * 16, ws, out, l, (LAS float*)(lds + LDS_EPI)};
            prompt_gemm<D, 2048>(wv, lds, G, bx, xb, (const bf16*)(wl + W_IN), f);
#if PROBE == 8
            __syncthreads(); prompt_gemm<D, 2048>(wv, lds, G, bx, xb, (const bf16*)(wl + W_IN), f);
#endif
            __syncthreads();
            sample_gemm_wide(wv, lds, xb, (const bf16*)(wl + W_IN), 8, f, G, smp_c0);
        } break;
        case 3: mixer_phase(wv, ws, out, l, lds, G, bx);
#if PROBE == 2
            __syncthreads(); mixer_phase(wv, ws, out, l, lds, G, bx);
#endif
            break;
        case 4: case 8: {
            const bool xo = k == 8;
            FRes f{xb, ssl + (xo ? 3 : 2) * (size_t)MT * 16, 1.0f};
            const bf16* Ain = xo ? (const bf16*)(R + R_QX) : (const bf16*)(R + R_YMIX);
            prompt_gemm<D, D>(wv, lds, G, bx, Ain, (const bf16*)(wl + (xo ? W_O : W_OUT)), f);
            __syncthreads();
            sample_gemm<D>(wv, lds, Ain, D, (const bf16*)(wl + (xo ? W_O : W_OUT)), D, 4, f, G, smp_c0);
        } break;
        case 5: {
            FScale f{ssl + 2 * (size_t)MT * 16, (bf16*)(R + R_QX), 0.0625f * LOG2E, (LAS float*)(lds + LDS_EPI)};
            prompt_gemm<D, D>(wv, lds, G, bx, xb, (const bf16*)(wl + W_Q), f);
#if PROBE == 5
            __syncthreads(); prompt_gemm<D, D>(wv, lds, G, bx, xb, (const bf16*)(wl + W_Q), f);
#endif
            __syncthreads();
            sample_gemm<D>(wv, lds, xb, D, (const bf16*)(wl + W_Q), D, 4, f, G, smp_c0);
#if PROBE == 10
            sample_gemm<D>(wv, lds, xb, D, (const bf16*)(wl + W_Q), D, 4, f, G, smp_c0);
#endif
        } break;
        case 6: {
            pg8::Gemm g{(const bf16*)(R + R_QX), (const bf16*)(ws + WS_MKB) + (size_t)l * 512 * D, D, D, 256, wv};
            typedef pg8::Sched<MP / 256, 4, (size_t)256 * D * 2, 512, (size_t)256 * D * 2, 512, 6> SchS; SchS Sc; Sc.G = G; Sc.c = bx;
            EpiS E{(bf16*)(R + R_P), (float*)(ws + WS_LINV), (LAS float*)(lds + LDS_EPI)};
            pg8::gemm_phase<EpiS, SchS, true, true>(lds, g, Sc, E);
#if PROBE == 9
            __syncthreads(); pg8::gemm_phase<EpiS, SchS, true, true>(lds, g, Sc, E);
#endif
            __syncthreads();
            xattn_sample(wv, ws, out, l, lds, G, bx);
            asm volatile("s_waitcnt vmcnt(0)" ::: "memory"); __syncthreads();
            FPV f{(const float*)(ws + WS_LINV), (bf16*)(R + R_QX)};
            run_gemm<MP / 256, 4, (size_t)256 * D * 2, 512, (size_t)4 * 65536 * 2, (size_t)65536 * 2, 6>(wv, lds, G, bx, (const bf16*)(ws + WS_R + R_P), D, (const bf16*)(ws + WS_MVT) + (size_t)l * 8 * 65536, 256, 256, f);
#if PROBE == 9
            __syncthreads();
            run_gemm<MP / 256, 4, (size_t)256 * D * 2, 512, (size_t)4 * 65536 * 2, (size_t)65536 * 2, 6>(wv, lds, G, bx, (const bf16*)(ws + WS_R + R_P), D, (const bf16*)(ws + WS_MVT) + (size_t)l * 8 * 65536, 256, 256, f);
#endif
        } break;
        case 7: break;
        }
        __syncthreads();
        if (k != 6) SYNC(ph);
    }
    if (hi == N_PHASES) { if (EN & 0x20000) final_norm(wv, ws, out, lds); }
#undef SYNC
}

extern "C" void kernel_launch(void* const* d_in, const int* in_sizes, int n_in, void* d_out, int out_size, void* d_ws, size_t ws_size, hipStream_t stream) {
    static int grid = 0;
    if (grid == 0) {
        if (n_in != 34 || (size_t)out_size != O_END || ws_size < WS_END) { fprintf(stderr, "kernel_launch: unexpected shapes n_in %d out %d ws %zu (need %zu)\n", n_in, out_size, ws_size, (size_t)WS_END); grid = -1; return; }
        int dev = 0, cus = 0, per_cu = 0;
        hipGetDevice(&dev); hipDeviceGetAttribute(&cus, hipDeviceAttributeMultiprocessorCount, dev);
        if (hipFuncSetAttribute((const void*)fwd_kernel, hipFuncAttributeMaxDynamicSharedMemorySize, LDS_BYTES) != hipSuccess) { fprintf(stderr, "kernel_launch: hipFuncSetAttribute failed\n"); grid = -1; return; }
        if (hipOccupancyMaxActiveBlocksPerMultiprocessor(&per_cu, (const void*)fwd_kernel, NTHR, LDS_BYTES) != hipSuccess || per_cu < 1) { fprintf(stderr, "kernel_launch: occupancy query says %d\n", per_cu); per_cu = 1; }
        (void)hipGetLastError();
        grid = cus;
    }
    if (grid < 0) return;
    Args a{};
    for (int i = 0; i < 34; ++i) a.in[i] = (const float*)d_in[i];
    a.out = (float*)d_out; a.ws = (unsigned char*)d_ws;
    if (hipMemsetAsync(d_ws, 0, 16384, stream) != hipSuccess) { fprintf(stderr, "kernel_launch: memset failed\n"); return; }
#if ONE_LAUNCH
    a.ph_lo = 0; a.ph_hi = N_PHASES;
    void* args[] = {&a};
    hipError_t e = hipLaunchCooperativeKernel((const void*)fwd_kernel, dim3(grid), dim3(NTHR), args, LDS_BYTES, stream);
    if (e != hipSuccess) fprintf(stderr, "cooperative launch failed: %s (grid %d)\n", hipGetErrorString(e), grid);
#else
    for (int ph = 0; ph < N_PHASES; ++ph) { a.ph_lo = ph; a.ph_hi = ph + 1; hipLaunchKernelGGL(fwd_kernel, dim3(grid), dim3(NTHR), LDS_BYTES, stream, a); }
#endif
}
```

```cpp
#include <hip/hip_runtime.h>
#include <hip/hip_cooperative_groups.h>
#include <cstdio>
#include <cstdint>
namespace cg = cooperative_groups;
#ifndef PROBE
#define PROBE 0
#endif
namespace pg8 {
#define PG8_LAS __attribute__((address_space(3)))
typedef unsigned short bf16_t;
typedef short bf16x8 __attribute__((ext_vector_type(8)));
typedef float f32x4 __attribute__((ext_vector_type(4)));
typedef unsigned u32x4 __attribute__((ext_vector_type(4)));
constexpr int BM = 256, BK = 64, HALF = 128, HTB = HALF * BK * 2  , STAGE_BYTES = 8 * HTB, NXCD = 8, WGM = 8;

__host__ __device__ __forceinline__ int lds_byte(int r, int c) { const int st = (r >> 4) * 2 + (c >> 5), rr = r & 15, cc = c & 31, ob = rr * 64 + cc * 2; return st * 1024 + (ob ^ (((ob >> 9) & 1) << 5)); }
__host__ __device__ __forceinline__ void stage_rc(int b, int& R, int& C) { const int st = b / 1024, sb = b % 1024, swz = sb ^ (((sb >> 9) & 1) << 5); R = (st >> 1) * 16 + swz / 64; C = (st & 1) * 32 + (swz % 64) / 2; }
__host__ __device__ __forceinline__ int perm32(int rho) { const int n = rho >> 4, i = rho & 15; return 8 * (i >> 2) + 4 * n + (i & 3); }


struct Unit { int pm, pn; size_t aoff, boff; int npm, par; };
struct Gemm { const bf16_t* A; const bf16_t* Bt; int lda, ldb, K, wv; };

template <int NM, int NN, size_t A_M, size_t A_N, size_t B_B, size_t B_N, int BSHIFT> struct Sched {
    int G, c;
    __device__ bool next(int i, Unit& u) const {
        constexpr int nwg = NM * NN;
        const long L = (long)i * G + c; if (L >= nwg) return false;
        int wgid = (int)L; { constexpr int q = nwg / NXCD, r = nwg % NXCD; const int xcd = wgid % NXCD, off = wgid / NXCD; wgid = (xcd < r ? xcd * (q + 1) : r * (q + 1) + (xcd - r) * q) + off; }
        constexpr int nig = WGM * NN; const int gid = wgid / nig, fm = gid * WGM, gsz = (NM - fm) < WGM ? (NM - fm) : WGM;
        u.pm = fm + ((wgid % nig) % gsz); u.pn = (wgid % nig) / gsz;
        u.aoff = (size_t)u.pm * A_M + (size_t)u.pn * A_N; u.boff = (size_t)(u.pm >> BSHIFT) * B_B + (size_t)u.pn * B_N; return true;
    }
    __device__ __forceinline__ void a_ready(const Unit&) const {}
    __device__ __forceinline__ void done(const Unit&) const {}
};
template <class Epi, class Sched, bool ALIGN_EPI = false, bool SP2 = false>
__device__ __forceinline__ void gemm_phase(PG8_LAS unsigned char* lds, const Gemm g, const Sched& S, const Epi& E) {
    unsigned z_ = 0u; asm volatile("" : "+v"(z_)); const int tid_ = g.wv * 64 + (int)__builtin_amdgcn_mbcnt_hi(~0u, __builtin_amdgcn_mbcnt_lo(~0u, z_)); const int tid = tid_, wid = __builtin_amdgcn_readfirstlane(tid >> 6), lane = tid & 63, wr = wid >> 2, wc = wid & 3, fr = lane & 15, fq = lane >> 4;
    const int K = g.K, nt = K / BK;
    unsigned voffA[2], voffB[2];
#pragma unroll
    for (int i = 0; i < 2; ++i) { int R, C; stage_rc(tid * 16 + i * 8192, R, C); const int Rb = Epi::PERM ? ((R & ~31) + perm32(R & 31)) : R;
        voffA[i] = (unsigned)(R * g.lda + C) * 2u; voffB[i] = (unsigned)(Rb * g.ldb + C) * 2u; }
    const size_t kstep = (size_t)(BK * 2);
    const size_t hstepA = (size_t)HALF * g.lda * 2, hstepB = (size_t)HALF * g.ldb * 2;
    const unsigned ldsw = (unsigned)wid * 1024u;
    const int aoff = lds_byte(wr * 64 + fr, fq * 8), boff = lds_byte(wc * 32 + fr, fq * 8);
#define PG8_SA(b, h) (((b) * 2 + (h)) * HTB)
#define PG8_SB(b, h) ((4 + (b) * 2 + (h)) * HTB)
#define PG8_STAGE(bufoff, gbase, voff) do { _Pragma("unroll") for (int _i = 0; _i < 2; ++_i) \
        __builtin_amdgcn_global_load_lds((const unsigned*)((const char*)(gbase) + (voff)[_i]), (PG8_LAS unsigned*)(lds + (bufoff) + ldsw + _i * 8192), 16, 0, 0); } while (0)
#define PG8_LDA(dst, b, h) do { _Pragma("unroll") for (int m = 0; m < 4; ++m) _Pragma("unroll") for (int k = 0; k < 2; ++k) dst[m][k] = *(const PG8_LAS bf16x8*)(lds + PG8_SA(b, h) + aoff + m * 2048 + k * 1024); } while (0)
#define PG8_LDB(dst, b, h) do { _Pragma("unroll") for (int n = 0; n < 2; ++n) _Pragma("unroll") for (int k = 0; k < 2; ++k) dst[n][k] = *(const PG8_LAS bf16x8*)(lds + PG8_SB(b, h) + boff + n * 2048 + k * 1024); } while (0)
#define PG8_MMA(ai, bj, At, Bt) do { __builtin_amdgcn_s_setprio(1); _Pragma("unroll") for (int m = 0; m < 4; ++m) _Pragma("unroll") for (int n = 0; n < 2; ++n) _Pragma("unroll") for (int k = 0; k < 2; ++k) \
        acc[ai][bj][m][n] = __builtin_amdgcn_mfma_f32_16x16x32_bf16(Bt[n][k], At[m][k], acc[ai][bj][m][n], 0, 0, 0); __builtin_amdgcn_s_setprio(0); } while (0)
#define PG8_WAIT_V(n) asm volatile("s_waitcnt vmcnt(" #n ")" ::: "memory")
#define PG8_WAIT_L(n) asm volatile("s_waitcnt lgkmcnt(" #n ")" ::: "memory")
#define PG8_BAR __builtin_amdgcn_s_barrier()
#define PG8_SCHED __builtin_amdgcn_sched_barrier(0)
    Unit cur, nxt; int ui = 0;
    if (!S.next(0, cur)) return;
    f32x4 acc[2][2][4][2];
#pragma unroll
    for (int a = 0; a < 2; ++a)
#pragma unroll
        for (int b = 0; b < 2; ++b)
#pragma unroll
            for (int m = 0; m < 4; ++m)
#pragma unroll
                for (int n = 0; n < 2; ++n) acc[a][b][m][n] = (f32x4){0.f, 0.f, 0.f, 0.f};
    bf16x8 At[4][2], B0[2][2], B1[2][2];
    const char* cA = (const char*)g.A + cur.aoff; const char* cB = (const char*)g.Bt + cur.boff;
    S.a_ready(cur);
    if constexpr (SP2) {
        PG8_STAGE(PG8_SB(0, 0), cB, voffB); PG8_STAGE(PG8_SB(0, 1), cB + hstepB, voffB); PG8_STAGE(PG8_SA(0, 0), cA, voffA); PG8_STAGE(PG8_SA(0, 1), cA + hstepA, voffA);
        if (wr == 1) PG8_BAR;
        PG8_WAIT_V(2); PG8_BAR;
        PG8_STAGE(PG8_SB(1, 0), cB + kstep, voffB); PG8_STAGE(PG8_SA(1, 0), cA + kstep, voffA); PG8_STAGE(PG8_SB(1, 1), cB + hstepB + kstep, voffB);
        PG8_WAIT_V(6); PG8_BAR;
    } else {
        PG8_STAGE(PG8_SB(0, 0), cB, voffB); PG8_STAGE(PG8_SA(0, 0), cA, voffA); PG8_STAGE(PG8_SB(0, 1), cB + hstepB, voffB); PG8_STAGE(PG8_SA(0, 1), cA + hstepA, voffA);
        if (wr == 1) PG8_BAR;
        PG8_WAIT_V(4); PG8_BAR;
        PG8_STAGE(PG8_SB(1, 0), cB + kstep, voffB); PG8_STAGE(PG8_SA(1, 0), cA + kstep, voffA); PG8_STAGE(PG8_SB(1, 1), cB + hstepB + kstep, voffB);
        PG8_WAIT_V(6); PG8_BAR;
    }
    for (;;) {
        const bool has_next = S.next(ui + 1, nxt);
        const char* nA = has_next ? (const char*)g.A + nxt.aoff : cA; const char* nB = has_next ? (const char*)g.Bt + nxt.boff : cB;
#pragma unroll 1
        for (int t = 0; t < nt; t += 2) {
            const bool last = (t == nt - 2);
            const char* a1 = cA + (size_t)(t + 1) * kstep;
            const char* a2 = last ? nA : cA + (size_t)(t + 2) * kstep; const char* b2 = last ? nB : cB + (size_t)(t + 2) * kstep;
            const char* a3 = a2 + kstep; const char* b3 = b2 + kstep;
            if (last && has_next) S.a_ready(nxt);
            if constexpr (SP2) {
            PG8_LDB(B0, 0, 0); PG8_LDB(B1, 0, 1); PG8_SCHED; PG8_LDA(At, 0, 0); PG8_STAGE(PG8_SA(1, 1), a1 + hstepA, voffA);
            PG8_WAIT_V(8); PG8_WAIT_L(0); PG8_BAR; PG8_MMA(0, 0, At, B0); PG8_MMA(0, 1, At, B1); PG8_BAR; PG8_SCHED;
            PG8_LDA(At, 0, 1); PG8_STAGE(PG8_SB(0, 0), b2, voffB); PG8_STAGE(PG8_SB(0, 1), b2 + hstepB, voffB); PG8_STAGE(PG8_SA(0, 0), a2, voffA);
            PG8_WAIT_V(8); PG8_WAIT_L(0); PG8_BAR; PG8_MMA(1, 0, At, B0); PG8_MMA(1, 1, At, B1); PG8_BAR; PG8_SCHED;
            PG8_LDB(B0, 1, 0); PG8_LDB(B1, 1, 1); PG8_SCHED; PG8_LDA(At, 1, 0); PG8_STAGE(PG8_SA(0, 1), a2 + hstepA, voffA);
            PG8_WAIT_V(8); PG8_WAIT_L(0); PG8_BAR; PG8_MMA(0, 0, At, B0); PG8_MMA(0, 1, At, B1); PG8_BAR; PG8_SCHED;
            PG8_LDA(At, 1, 1); PG8_STAGE(PG8_SB(1, 0), b3, voffB); PG8_STAGE(PG8_SB(1, 1), b3 + hstepB, voffB); PG8_STAGE(PG8_SA(1, 0), a3, voffA);
            PG8_WAIT_V(8); PG8_WAIT_L(0); PG8_BAR; PG8_MMA(1, 0, At, B0); PG8_MMA(1, 1, At, B1); PG8_BAR; PG8_SCHED;
            } else {
            PG8_LDB(B0, 0, 0); PG8_SCHED; PG8_LDA(At, 0, 0); PG8_STAGE(PG8_SA(1, 1), a1 + hstepA, voffA);
            PG8_WAIT_L(8); PG8_BAR; PG8_WAIT_L(0); PG8_MMA(0, 0, At, B0); PG8_BAR; PG8_SCHED;
            PG8_LDB(B1, 0, 1); PG8_STAGE(PG8_SB(0, 0), b2, voffB);
            PG8_BAR; PG8_WAIT_L(0); PG8_MMA(0, 1, At, B1); PG8_BAR;
            PG8_LDA(At, 0, 1); PG8_STAGE(PG8_SA(0, 0), a2, voffA);
            PG8_BAR; PG8_WAIT_L(0); PG8_MMA(1, 0, At, B0); PG8_BAR; PG8_SCHED;
            PG8_STAGE(PG8_SB(0, 1), b2 + hstepB, voffB);
            PG8_WAIT_V(6); PG8_BAR; PG8_MMA(1, 1, At, B1); PG8_BAR;
            PG8_LDB(B0, 1, 0); PG8_SCHED; PG8_LDA(At, 1, 0); PG8_STAGE(PG8_SA(0, 1), a2 + hstepA, voffA);
            PG8_WAIT_L(8); PG8_BAR; PG8_WAIT_L(0); PG8_MMA(0, 0, At, B0); PG8_BAR; PG8_SCHED;
            PG8_LDB(B1, 1, 1); PG8_STAGE(PG8_SB(1, 0), b3, voffB);
            PG8_BAR; PG8_WAIT_L(0); PG8_MMA(0, 1, At, B1); PG8_BAR;
            PG8_LDA(At, 1, 1); PG8_STAGE(PG8_SA(1, 0), a3, voffA);
            PG8_BAR; PG8_WAIT_L(0); PG8_MMA(1, 0, At, B0); PG8_BAR; PG8_SCHED;
            PG8_STAGE(PG8_SB(1, 1), b3 + hstepB, voffB);
            PG8_WAIT_V(6); PG8_BAR; PG8_MMA(1, 1, At, B1); PG8_BAR;
            }
        }
        if constexpr (ALIGN_EPI) { if (wr == 0) PG8_BAR; }
        if constexpr (!Epi::AFTER_DRAIN) { E(acc, cur, wr, wc, fr, fq); S.done(cur); }
        if (!has_next) break;
#pragma unroll
        for (int a = 0; a < 2; ++a)
#pragma unroll
            for (int b = 0; b < 2; ++b)
#pragma unroll
                for (int m = 0; m < 4; ++m)
#pragma unroll
                    for (int n = 0; n < 2; ++n) acc[a][b][m][n] = (f32x4){0.f, 0.f, 0.f, 0.f};
        cur = nxt; cA = nA; cB = nB; ++ui;
        if constexpr (ALIGN_EPI) { if (wr == 1) PG8_BAR; }
    }
    PG8_WAIT_V(0);
    if constexpr (!ALIGN_EPI) { if (wr == 0) PG8_BAR; }
    PG8_BAR;
    if constexpr (Epi::AFTER_DRAIN) { E.fused(acc, cur, wr, wc, fr, fq, lds, wid, lane); S.done(cur); }
#undef PG8_SA
#undef PG8_SB
#undef PG8_STAGE
#undef PG8_LDA
#undef PG8_LDB
#undef PG8_MMA
#undef PG8_WAIT_V
#undef PG8_WAIT_L
#undef PG8_BAR
#undef PG8_SCHED
}}

#define DI __device__ __forceinline__
#define LAS __attribute__((address_space(3)))
typedef unsigned short bf16;
typedef short bf16x8 __attribute__((ext_vector_type(8)));
typedef float f32x4 __attribute__((ext_vector_type(4)));
typedef float f32x16 __attribute__((ext_vector_type(16)));
typedef unsigned u32x4 __attribute__((ext_vector_type(4)));
typedef unsigned u32x2 __attribute__((ext_vector_type(2)));
typedef __bf16 bf16x2_t __attribute__((ext_vector_type(2)));
typedef float f32x2_t __attribute__((ext_vector_type(2)));
using pg8::Unit;

constexpr int D = 1024, S = 16384, NB = 2, MP = NB * S, MS = 256, MT = MP + MS, FF = 2816, NL = 2, NTHR = 512;
constexpr float EPS = 1e-6f, LOG2E = 1.4426950408889634f;
constexpr size_t MiB = 1u << 20;
constexpr size_t WS_SS_OLD = 0;
constexpr size_t WS_LINV = 2 * MiB;
constexpr size_t WS_ROPE = 3 * MiB;
constexpr size_t WS_MN = 7 * MiB;
constexpr size_t WS_MKB = 8 * MiB;
constexpr size_t WS_MVT = 10 * MiB;
constexpr size_t WS_W = 12 * MiB, LW = 47 * MiB;
constexpr size_t W_1 = 0, W_D1 = 11 * MiB, W_IN = W_D1 + 11 * MiB / 2, W_OUT = W_IN + 4 * MiB, W_Q = W_OUT + 2 * MiB, W_O = W_Q + 2 * MiB, W_2 = W_O + 2 * MiB, W_D2 = W_2 + 11 * MiB, W_KV = W_D2 + 11 * MiB / 2;
static_assert(W_KV + 4 * MiB == LW, "weights map");
constexpr size_t WS_XB = WS_W + 2 * LW;
constexpr size_t WS_R = WS_XB + 65 * MiB;
constexpr size_t R_H = 0;
constexpr size_t R_GB = 0, R_CV = R_GB + (size_t)MT * 256 * 2, R_Q = R_CV + (size_t)MT * 256 * 2, R_K = R_Q + (size_t)MT * 512 * 2, R_VT = R_K + (size_t)MT * 128 * 2,
                 R_VS = R_VT + (size_t)NB * 128 * S * 2, R_GLU = R_VS + (size_t)MS * 128 * 2, R_YMIX = 101 * MiB;
static_assert(R_GLU + (size_t)MT * 256 * 2 <= R_YMIX, "R map");
constexpr size_t R_QX = 0, R_P = 68 * MiB;
constexpr size_t WS_SS = WS_R + 178 * MiB;
constexpr size_t WS_END = WS_SS + 19 * MiB;
static_assert((size_t)9 * MT * 64 <= 19 * MiB, "ss");
static_assert((size_t)MT * FF * 2 <= 178 * MiB && (size_t)MT * D * 2 <= 65 * MiB, "sizes");
constexpr size_t O_YP = 0, O_YS = O_YP + (size_t)MP * D, O_KP = O_YS + (size_t)MS * D, O_VP = O_KP + 65536, O_AP = O_VP + 65536, O_CP = O_AP + 2048, O_MK = O_CP + 30720,
                 O_MV = O_MK + 1048576, O_KS = O_MV + 1048576, O_VS = O_KS + 65536, O_AS = O_VS + 65536, O_CS = O_AS + 16384, O_END = O_CS + 245760;
constexpr int LDS_BYTES = 162816, LDS_EPI = 131072, LDS_TAB = 162816 - 512;

struct Args { const float* in[34]; float* out; unsigned char* ws; int ph_lo, ph_hi; };
enum { I_XP = 0, I_XS, I_CK, I_CV, I_SA, I_SC, I_MK, I_MV, I_MEM, I_F1N, I_F1G, I_F1U, I_F1D, I_MIXN, I_WIN, I_CAW, I_SINK, I_CCW, I_CCB, I_LNG, I_LNB, I_MON, I_WOUT,
       I_XAN, I_MEMN, I_WQ, I_WK, I_WV, I_WO, I_F2N, I_F2G, I_F2U, I_F2D, I_FIN };

DI const float* tab_ptr(LAS unsigned char* lds, int idx) { const u32x2 v = *((const LAS u32x2*)(lds + LDS_TAB) + idx); const unsigned lo = __builtin_amdgcn_readfirstlane(v.x), hi = __builtin_amdgcn_readfirstlane(v.y); return (const float*)(((unsigned long long)hi << 32) | lo); }
#define IN(idx) tab_ptr(lds, idx)
DI float ss_row(const float* ss, int row) { const f32x4* p = (const f32x4*)(ss + (size_t)row * 16); const f32x4 a = p[0], b = p[1], c = p[2], d = p[3]; return (((a[0] + a[1]) + (a[2] + a[3])) + ((b[0] + b[1]) + (b[2] + b[3]))) + (((c[0] + c[1]) + (c[2] + c[3])) + ((d[0] + d[1]) + (d[2] + d[3]))); }
DI float bf2f(unsigned short b) { return __uint_as_float((unsigned)b << 16); }
DI unsigned pk2(float lo, float hi) { f32x2_t v = {lo, hi}; bf16x2_t b = __builtin_convertvector(v, bf16x2_t); return __builtin_bit_cast(unsigned, b); }
DI bf16 f2bf(float f) { return (bf16)(pk2(f, 0.f) & 0xffffu); }
DI void st4bf(bf16* p, f32x4 v) { u32x2 w; w.x = pk2(v[0], v[1]); w.y = pk2(v[2], v[3]); *(u32x2*)p = w; }
DI f32x4 unpk4(u32x2 w) { return (f32x4){__uint_as_float(w.x << 16), __uint_as_float(w.x & 0xffff0000u), __uint_as_float(w.y << 16), __uint_as_float(w.y & 0xffff0000u)}; }
DI f32x4 ld4bf(const bf16* p) { return unpk4(*(const u32x2*)p); }
DI void st8bf(bf16* p, f32x4 a, f32x4 b) { u32x4 w; w.x = pk2(a[0], a[1]); w.y = pk2(a[2], a[3]); w.z = pk2(b[0], b[1]); w.w = pk2(b[2], b[3]); *(u32x4*)p = w; }
DI float dpp_f(float v, const int ctrl_tag);
template <int CTRL> DI float dppx(float v) { return __builtin_bit_cast(float, __builtin_amdgcn_update_dpp(0, __builtin_bit_cast(int, v), CTRL, 0xf, 0xf, true)); }
DI float wave_sum(float v) {
    v += dppx<0xB1>(v); v += dppx<0x4E>(v); v += dppx<0x141>(v); v += dppx<0x140>(v);
    const float a = __builtin_bit_cast(float, __builtin_amdgcn_readlane(__builtin_bit_cast(int, v), 0)), b = __builtin_bit_cast(float, __builtin_amdgcn_readlane(__builtin_bit_cast(int, v), 16)),
                c = __builtin_bit_cast(float, __builtin_amdgcn_readlane(__builtin_bit_cast(int, v), 32)), d = __builtin_bit_cast(float, __builtin_amdgcn_readlane(__builtin_bit_cast(int, v), 48));
    return (a + b) + (c + d);
}
DI float wave_max(float v) {
#pragma unroll
    for (int o = 1; o < 64; o <<= 1) v = fmaxf(v, __shfl_xor(v, o));
    return v;
}
DI float sigmoidf_(float x) { return __builtin_amdgcn_rcpf(1.f + __builtin_amdgcn_exp2f(-LOG2E * x)); }
#define LDS_WAIT() asm volatile("s_waitcnt lgkmcnt(0)" ::: "memory")
#define EPI_BAR() do { asm volatile("s_waitcnt lgkmcnt(0)" ::: "memory"); __builtin_amdgcn_s_barrier(); asm volatile("" ::: "memory"); } while (0)

template <class F> struct EpiA {
    static constexpr bool PERM = F::PERM, AFTER_DRAIN = false; F f;
    template <int KIND> DI void body(const f32x4 (&acc)[2][2][4][2], const Unit& u, int wr, int wc, int fr, int fq) const {
#pragma unroll
        for (int ai = 0; ai < 2; ++ai)
#pragma unroll
            for (int m = 0; m < 4; ++m) {
                const int lr = ai * 128 + wr * 64 + m * 16 + fr, row = u.pm * 256 + lr; typename F::Row rc; f.row_begin(rc, row, u.pn, lr);
                if constexpr (F::PERM) f.template apply8<KIND>(rc, row, u.pn, wc * 32 + fq * 8, acc[ai][0][m][0], acc[ai][0][m][1], acc[ai][1][m][0], acc[ai][1][m][1]);
                else {
#pragma unroll
                for (int n = 0; n < 2; ++n) f.template apply<KIND>(rc, row, u.pn, wc * 32 + n * 16 + fq * 4, acc[ai][0][m][n], acc[ai][1][m][n]); }
                f.row_end(rc, row, u.pn, fq, wc);
            }
    }
    DI void operator()(const f32x4 (&acc)[2][2][4][2], const Unit& u, int wr, int wc, int fr, int fq) const {
        asm volatile("" : "+v"(fr), "+v"(fq));
        if constexpr (F::USE_SS) {
            const int t = (wr * 4 + wc) * 64 + fq * 16 + fr;
            if (t < 256) f.rsl[t] = rsqrtf(ss_row(f.ss, u.pm * 256 + t) * (1.f / D) + EPS);
            EPI_BAR();
        }
        if constexpr (F::NKIND == 1) body<0>(acc, u, wr, wc, fr, fq);
        else { const int kd = f.kind(u.pn);
            if (kd == 0) body<0>(acc, u, wr, wc, fr, fq); else if (kd == 1) body<1>(acc, u, wr, wc, fr, fq);
            else if constexpr (F::NKIND > 2) { if (kd == 2) body<2>(acc, u, wr, wc, fr, fq); else if (kd == 3) body<3>(acc, u, wr, wc, fr, fq); else body<4>(acc, u, wr, wc, fr, fq); } }    }
};
template <class F> DI void apply_two(const F& f, int row, int pn, int c, const f32x4 (&v0)[2], const f32x4 (&v1)[2], int fq, int sub) {
    typename F::Row rc; f.row_begin(rc, row, pn, -1);
#pragma unroll
    for (int wb = 0; wb < 2; ++wb) {
        if constexpr (F::NKIND == 1) f.template apply<0>(rc, row, pn, c + wb * 16, v0[wb], v1[wb]);
        else { const int kd = f.kind(pn);
            if (kd == 0) f.template apply<0>(rc, row, pn, c + wb * 16, v0[wb], v1[wb]); else if (kd == 1) f.template apply<1>(rc, row, pn, c + wb * 16, v0[wb], v1[wb]);
            else if constexpr (F::NKIND > 2) { if (kd == 2) f.template apply<2>(rc, row, pn, c + wb * 16, v0[wb], v1[wb]); else if (kd == 3) f.template apply<3>(rc, row, pn, c + wb * 16, v0[wb], v1[wb]); else f.template apply<4>(rc, row, pn, c + wb * 16, v0[wb], v1[wb]); } }
    }
    f.row_end(rc, row, pn, fq, sub);
}

struct FUp {
    static constexpr int NKIND = 1; static constexpr bool USE_SS = true, PERM = true; const float* ss; bf16* h; LAS float* rsl;
    struct Row { float rs; };
    DI void row_begin(Row& rc, int row, int, int lr) const { rc.rs = lr >= 0 ? rsl[lr] : rsqrtf(ss_row(ss, row) * (1.f / D) + EPS); }
    template <int> DI void apply(const Row& rc, int row, int pn, int c, f32x4 v0, f32x4 v1) const {
        f32x4 o;
#pragma unroll
        for (int e = 0; e < 4; ++e) { const float g = v0[e] * rc.rs, u = v1[e] * rc.rs; o[e] = g * sigmoidf_(g) * u; }
        st4bf(h + (size_t)row * FF + pn * 128 + c, o);
    }
    template <int> DI void apply8(const Row& rc, int row, int pn, int c, f32x4 g0, f32x4 g1, f32x4 u0, f32x4 u1) const {
        f32x4 o0, o1;
#pragma unroll
        for (int e = 0; e < 4; ++e) { const float ga = g0[e] * rc.rs, gb = g1[e] * rc.rs; o0[e] = ga * sigmoidf_(ga) * (u0[e] * rc.rs); o1[e] = gb * sigmoidf_(gb) * (u1[e] * rc.rs); }
        st8bf(h + (size_t)row * FF + pn * 128 + c, o0, o1);
    }
    DI void row_end(const Row&, int, int, int, int) const {}
};
struct FUpCheap {
    static constexpr int NKIND = 1; static constexpr bool USE_SS = false, PERM = false; bf16* h;
    struct Row { float rs; };
    DI void row_begin(Row&, int, int, int) const {}
    template <int> DI void apply(const Row&, int row, int pn, int c, f32x4 v0, f32x4 v1) const { st4bf(h + (size_t)row * FF + pn * 128 + c, v0 + v1); }
    DI void row_end(const Row&, int, int, int, int) const {}
};
struct FRes {
    static constexpr int NKIND = 1; static constexpr bool USE_SS = false, PERM = true; bf16* xb; float* ssn; float alpha;
    struct Row { float a; };
    DI void row_begin(Row& rc, int, int, int) const { rc.a = 0.f; }
    template <int> DI void apply(Row& rc, int row, int pn, int c, f32x4 v0, f32x4 v1) const {
#pragma unroll
        for (int bj = 0; bj < 2; ++bj) {
            bf16* p = xb + (size_t)row * D + pn * 256 + bj * 128 + c; const f32x4 x = ld4bf(p); const f32x4 v = bj ? v1 : v0;
            u32x2 w; w.x = pk2(x[0] + alpha * v[0], x[1] + alpha * v[1]); w.y = pk2(x[2] + alpha * v[2], x[3] + alpha * v[3]); *(u32x2*)p = w;
            const f32x4 r = unpk4(w); rc.a += (r[0] * r[0] + r[1] * r[1]) + (r[2] * r[2] + r[3] * r[3]);
        }
    }
    template <int> DI void apply8(Row& rc, int row, int pn, int c, f32x4 a0, f32x4 a1, f32x4 b0, f32x4 b1) const {
#pragma unroll
        for (int bj = 0; bj < 2; ++bj) {
            bf16* p = xb + (size_t)row * D + pn * 256 + bj * 128 + c; const u32x4 xw = *(const u32x4*)p; const f32x4 x0 = unpk4((u32x2){xw.x, xw.y}), x1 = unpk4((u32x2){xw.z, xw.w});
            const f32x4 v0 = bj ? b0 : a0, v1 = bj ? b1 : a1;
            u32x4 w; w.x = pk2(x0[0] + alpha * v0[0], x0[1] + alpha * v0[1]); w.y = pk2(x0[2] + alpha * v0[2], x0[3] + alpha * v0[3]); w.z = pk2(x1[0] + alpha * v1[0], x1[1] + alpha * v1[1]); w.w = pk2(x1[2] + alpha * v1[2], x1[3] + alpha * v1[3]);
            *(u32x4*)p = w; const f32x4 r0 = unpk4((u32x2){w.x, w.y}), r1 = unpk4((u32x2){w.z, w.w});
            rc.a += ((r0[0] * r0[0] + r0[1] * r0[1]) + (r0[2] * r0[2] + r0[3] * r0[3])) + ((r1[0] * r1[0] + r1[1] * r1[1]) + (r1[2] * r1[2] + r1[3] * r1[3]));
        }
    }
    DI void row_end(const Row& rc, int row, int pn, int fq, int sub) const { float s = rc.a; s += __shfl_xor(s, 16); s += __shfl_xor(s, 32); if (fq == 0) ssn[(size_t)row * 16 + pn * 4 + sub] = s; }
};
struct FScale {
    static constexpr int NKIND = 1; static constexpr bool USE_SS = true, PERM = true; const float* ss; bf16* o; float sc; LAS float* rsl;
    struct Row { float rs; };
    DI void row_begin(Row& rc, int row, int, int lr) const { rc.rs = (lr >= 0 ? rsl[lr] : rsqrtf(ss_row(ss, row) * (1.f / D) + EPS)) * sc; }
    template <int> DI void apply(const Row& rc, int row, int pn, int c, f32x4 v0, f32x4 v1) const {
        st4bf(o + (size_t)row * D + pn * 256 + c, v0 * rc.rs); st4bf(o + (size_t)row * D + pn * 256 + 128 + c, v1 * rc.rs);
    }
    template <int> DI void apply8(const Row& rc, int row, int pn, int c, f32x4 a0, f32x4 a1, f32x4 b0, f32x4 b1) const { st8bf(o + (size_t)row * D + pn * 256 + c, a0 * rc.rs, a1 * rc.rs); st8bf(o + (size_t)row * D + pn * 256 + 128 + c, b0 * rc.rs, b1 * rc.rs); }
    DI void row_end(const Row&, int, int, int, int) const {}
};
struct FPV {
    static constexpr int NKIND = 1; static constexpr bool USE_SS = false, PERM = true; const float* linv; bf16* o;
    struct Row { float s; };
    DI void row_begin(Row& rc, int row, int pn, int) const { rc.s = linv[(size_t)row * 4 + pn]; }
    template <int> DI void apply(const Row& rc, int row, int pn, int c, f32x4 v0, f32x4 v1) const {
        st4bf(o + (size_t)row * D + pn * 256 + c, v0 * rc.s); st4bf(o + (size_t)row * D + pn * 256 + 128 + c, v1 * rc.s);
    }
    template <int> DI void apply8(const Row& rc, int row, int pn, int c, f32x4 a0, f32x4 a1, f32x4 b0, f32x4 b1) const { st8bf(o + (size_t)row * D + pn * 256 + c, a0 * rc.s, a1 * rc.s); st8bf(o + (size_t)row * D + pn * 256 + 128 + c, b0 * rc.s, b1 * rc.s); }
    DI void row_end(const Row&, int, int, int, int) const {}
};
struct FMemKV {
    static constexpr int NKIND = 2; static constexpr bool USE_SS = false, PERM = false; float* ok; float* ov; bf16* mkb; bf16* mvt;
    struct Row { int d; };
    DI int kind(int pn) const { return pn < 4 ? 0 : 1; }
    DI void row_begin(Row&, int, int, int) const {}
    template <int KIND> DI void apply(const Row&, int row, int pn, int c, f32x4 v0, f32x4 v1) const {
        if constexpr (KIND == 0) {
#pragma unroll
            for (int bj = 0; bj < 2; ++bj) { const int col = pn * 256 + bj * 128 + c; const f32x4 v = bj ? v1 : v0; *(f32x4*)(ok + (size_t)row * D + col) = v; st4bf(mkb + (size_t)row * D + col, v); }
        } else {
            const int h = pn - 4, b = row >> 8, mem = row & 255;
#pragma unroll
            for (int bj = 0; bj < 2; ++bj) { const int dd = bj * 128 + c; const f32x4 v = bj ? v1 : v0; *(f32x4*)(ov + (size_t)row * D + h * 256 + dd) = v;
#pragma unroll
                for (int e = 0; e < 4; ++e) mvt[((size_t)(b * 4 + h) * 256 + dd + e) * 256 + mem] = f2bf(v[e]); }
        }
    }
    DI void row_end(const Row&, int, int, int, int) const {}
};
struct FWin {
    static constexpr int NKIND = 5; static constexpr bool USE_SS = true, PERM = true; const float* ss; unsigned char* ws; float* out; int l; LAS float* rsl;
    struct Row { float rs; int pos, b, t; bool smp; };
    DI int kind(int pn) const { return pn == 0 ? 0 : pn <= 2 ? 1 : pn <= 4 ? 2 : pn == 5 ? 3 : 4; }
    DI void row_begin(Row& rc, int row, int, int lr) const {
        rc.rs = lr >= 0 ? rsl[lr] : rsqrtf(ss_row(ss, row) * (1.f / D) + EPS);
        if (row < MP) { rc.smp = false; rc.b = row >> 14; rc.pos = row & (S - 1); rc.t = 0; } else { const int sr = row - MP; rc.smp = true; rc.b = sr >> 4; rc.t = sr & 15; rc.pos = 1024 + rc.t; }
    }
    template <int KIND> DI void apply(const Row& rc, int row, int pn, int c, f32x4 v0, f32x4 v1) const {
        unsigned char* R = ws + WS_R; const f32x4 a0 = v0 * rc.rs, a1 = v1 * rc.rs;
        if constexpr (KIND == 0) { bf16* gb = (bf16*)(R + R_GB) + (size_t)row * 256 + c; st4bf(gb, a0); st4bf(gb + 128, a1); }
        else if constexpr (KIND == 1) {
            const int ch = (pn - 1) * 128 + c; const f32x4 p = a0 * a1; st4bf((bf16*)(R + R_CV) + (size_t)row * 256 + ch, p);
            if (!rc.smp) { if (rc.pos >= S - 2) *(f32x4*)(out + O_AP + (size_t)l * 1024 + (size_t)(rc.b * 2 + rc.pos - (S - 2)) * 256 + ch) = p; }
            else if (rc.t >= 14) *(f32x4*)(out + O_AS + (size_t)l * 8192 + (size_t)(rc.b * 2 + rc.t - 14) * 256 + ch) = p;
        } else if constexpr (KIND == 2 || KIND == 3) {
            const int blk = c >> 5, i = c & 31;
            if (KIND == 3 && blk >= 2) {
                const int kvh = blk - 2;
                if (!rc.smp) {
                    bf16* vT = (bf16*)(R + R_VT) + ((size_t)(rc.b * 2 + kvh) * 64 + i) * S + rc.pos;
#pragma unroll
                    for (int e = 0; e < 4; ++e) { vT[(size_t)e * S] = f2bf(a0[e]); vT[(size_t)(32 + e) * S] = f2bf(a1[e]); }
                    if (rc.pos >= S - 128) { float* o = out + O_VP + (size_t)l * 32768 + ((size_t)(rc.b * 128 + rc.pos - (S - 128)) * 2 + kvh) * 64 + i; *(f32x4*)o = a0; *(f32x4*)(o + 32) = a1; }
                } else {
                    bf16* p = (bf16*)(R + R_VS) + (size_t)(row - MP) * 128 + kvh * 64 + i; st4bf(p, a0); st4bf(p + 32, a1);
                    float* o = out + O_VS + (size_t)l * 32768 + ((size_t)(rc.b * 16 + rc.t) * 2 + kvh) * 64 + i; *(f32x4*)o = a0; *(f32x4*)(o + 32) = a1;
                }
            } else {
                const float* rcos = (const float*)(ws + WS_ROPE) + (size_t)rc.pos * 32 + i;
                const f32x4 cs = *(const f32x4*)rcos, sn = *(const f32x4*)(rcos + (size_t)S * 32);
                const f32x4 o1 = a0 * cs - a1 * sn, o2 = a1 * cs + a0 * sn;
                if constexpr (KIND == 2) { const int head = (pn - 3) * 4 + blk; const float QS = 0.125f * LOG2E; bf16* p = (bf16*)(R + R_Q) + (size_t)row * 512 + head * 64 + i; st4bf(p, o1 * QS); st4bf(p + 32, o2 * QS); }
                else {
                    bf16* p = (bf16*)(R + R_K) + (size_t)row * 128 + blk * 64 + i; st4bf(p, o1); st4bf(p + 32, o2);
                    if (!rc.smp) { if (rc.pos >= S - 128) { float* o = out + O_KP + (size_t)l * 32768 + ((size_t)(rc.b * 128 + rc.pos - (S - 128)) * 2 + blk) * 64 + i; *(f32x4*)o = o1; *(f32x4*)(o + 32) = o2; } }
                    else { float* o = out + O_KS + (size_t)l * 32768 + ((size_t)(rc.b * 16 + rc.t) * 2 + blk) * 64 + i; *(f32x4*)o = o1; *(f32x4*)(o + 32) = o2; }
                }
            }
        } else {
            const int ch = (pn - 6) * 128 + c; f32x4 g;
#pragma unroll
            for (int e = 0; e < 4; ++e) g[e] = a0[e] * sigmoidf_(a1[e]);
            st4bf((bf16*)(R + R_GLU) + (size_t)row * 256 + ch, g);
            if (!rc.smp) { if (rc.pos >= S - 30) *(f32x4*)(out + O_CP + (size_t)l * 15360 + (size_t)(rc.b * 30 + rc.pos - (S - 30)) * 256 + ch) = g; }
            else *(f32x4*)(out + O_CS + (size_t)l * 122880 + (size_t)(rc.b * 30 + 14 + rc.t) * 256 + ch) = g;
        }
    }
    template <int KIND> DI void apply8(const Row& rc, int row, int pn, int c, f32x4 v0a, f32x4 v0b, f32x4 v1a, f32x4 v1b) const {
        unsigned char* R = ws + WS_R; const f32x4 a0 = v0a * rc.rs, a1 = v0b * rc.rs, b0 = v1a * rc.rs, b1 = v1b * rc.rs;
        if constexpr (KIND == 0) { bf16* gb = (bf16*)(R + R_GB) + (size_t)row * 256 + c; st8bf(gb, a0, a1); st8bf(gb + 128, b0, b1); }
        else if constexpr (KIND == 1) {
            const int ch = (pn - 1) * 128 + c; const f32x4 p0 = a0 * b0, p1 = a1 * b1; st8bf((bf16*)(R + R_CV) + (size_t)row * 256 + ch, p0, p1);
            if (rc.pos >= S - 2) { float* o = out + O_AP + (size_t)l * 1024 + (size_t)(rc.b * 2 + rc.pos - (S - 2)) * 256 + ch; *(f32x4*)o = p0; *(f32x4*)(o + 4) = p1; }
        } else if constexpr (KIND == 2 || KIND == 3) {
            const int blk = c >> 5, i = c & 31;
            if (KIND == 3 && blk >= 2) { apply<3>(rc, row, pn, c, v0a, v1a); apply<3>(rc, row, pn, c + 4, v0b, v1b); }
            else {
                const float* rcos = (const float*)(ws + WS_ROPE) + (size_t)rc.pos * 32 + i; const float* rsin = rcos + (size_t)S * 32;
                const f32x4 c0 = *(const f32x4*)rcos, c1 = *(const f32x4*)(rcos + 4), s0 = *(const f32x4*)rsin, s1 = *(const f32x4*)(rsin + 4);
                const f32x4 o1a = a0 * c0 - b0 * s0, o1b = a1 * c1 - b1 * s1, o2a = b0 * c0 + a0 * s0, o2b = b1 * c1 + a1 * s1;
                if constexpr (KIND == 2) { const int head = (pn - 3) * 4 + blk; const float QS = 0.125f * LOG2E; bf16* p = (bf16*)(R + R_Q) + (size_t)row * 512 + head * 64 + i; st8bf(p, o1a * QS, o1b * QS); st8bf(p + 32, o2a * QS, o2b * QS); }
                else {
                    bf16* p = (bf16*)(R + R_K) + (size_t)row * 128 + blk * 64 + i; st8bf(p, o1a, o1b); st8bf(p + 32, o2a, o2b);
                    if (rc.pos >= S - 128) { float* o = out + O_KP + (size_t)l * 32768 + ((size_t)(rc.b * 128 + rc.pos - (S - 128)) * 2 + blk) * 64 + i; *(f32x4*)o = o1a; *(f32x4*)(o + 4) = o1b; *(f32x4*)(o + 32) = o2a; *(f32x4*)(o + 36) = o2b; }
                }
            }
        } else {
            const int ch = (pn - 6) * 128 + c; f32x4 g0, g1;
#pragma unroll
            for (int e = 0; e < 4; ++e) { g0[e] = a0[e] * sigmoidf_(b0[e]); g1[e] = a1[e] * sigmoidf_(b1[e]); }
            st8bf((bf16*)(R + R_GLU) + (size_t)row * 256 + ch, g0, g1);
            if (rc.pos >= S - 30) { float* o = out + O_CP + (size_t)l * 15360 + (size_t)(rc.b * 30 + rc.pos - (S - 30)) * 256 + ch; *(f32x4*)o = g0; *(f32x4*)(o + 4) = g1; }
        }
    }
    DI void row_end(const Row&, int, int, int, int) const {}
};
struct EpiS {
    static constexpr bool PERM = true, AFTER_DRAIN = false;
    bf16* P; float* linv; LAS float* sc;
    DI void operator()(const f32x4 (&acc)[2][2][4][2], const Unit& u, int wr, int wc, int fr, int fq) const {
        LAS float* Pm = sc; LAS float* Ps = sc + 1024;
#pragma unroll
        for (int ai = 0; ai < 2; ++ai)
#pragma unroll
            for (int m = 0; m < 4; ++m) {
                float mx = -3.0e38f;
#pragma unroll
                for (int bj = 0; bj < 2; ++bj)
#pragma unroll
                    for (int n = 0; n < 2; ++n) { const f32x4 x = acc[ai][bj][m][n]; mx = fmaxf(mx, fmaxf(fmaxf(x[0], x[1]), fmaxf(x[2], x[3]))); }
                mx = fmaxf(mx, __shfl_xor(mx, 16)); mx = fmaxf(mx, __shfl_xor(mx, 32));
                if (fq == 0) Pm[(ai * 128 + wr * 64 + m * 16 + fr) * 4 + wc] = mx;
            }
        EPI_BAR();
#pragma unroll
        for (int ai = 0; ai < 2; ++ai)
#pragma unroll
            for (int m = 0; m < 4; ++m) {
                const int r = ai * 128 + wr * 64 + m * 16 + fr; const f32x4 m4 = *(LAS f32x4*)(Pm + r * 4);
                const float mx = fmaxf(fmaxf(m4[0], m4[1]), fmaxf(m4[2], m4[3])); float sum = 0.f;
                bf16* prow = P + (size_t)(u.pm * 256 + r) * D + u.pn * 256 + wc * 32 + fq * 8;
#pragma unroll
                for (int bj = 0; bj < 2; ++bj) {
                    const f32x4 x = acc[ai][bj][m][0], y = acc[ai][bj][m][1]; u32x4 w;
                    w.x = pk2(__builtin_amdgcn_exp2f(x[0] - mx), __builtin_amdgcn_exp2f(x[1] - mx)); w.y = pk2(__builtin_amdgcn_exp2f(x[2] - mx), __builtin_amdgcn_exp2f(x[3] - mx));
                    w.z = pk2(__builtin_amdgcn_exp2f(y[0] - mx), __builtin_amdgcn_exp2f(y[1] - mx)); w.w = pk2(__builtin_amdgcn_exp2f(y[2] - mx), __builtin_amdgcn_exp2f(y[3] - mx));
                    *(u32x4*)(prow + bj * 128) = w; const f32x4 p0 = unpk4((u32x2){w.x, w.y}), p1 = unpk4((u32x2){w.z, w.w}); sum += ((p0[0] + p0[1]) + (p0[2] + p0[3])) + ((p1[0] + p1[1]) + (p1[2] + p1[3]));
                }
                sum += __shfl_xor(sum, 16); sum += __shfl_xor(sum, 32);
                if (fq == 0) Ps[r * 4 + wc] = sum;
            }
        EPI_BAR();
        const int tid = (wr * 4 + wc) * 64 + fq * 16 + fr;
        if (tid < 256) { const f32x4 s4 = *(LAS f32x4*)(Ps + tid * 4); linv[(size_t)(u.pm * 256 + tid) * 4 + u.pn] = 1.f / ((s4[0] + s4[1]) + (s4[2] + s4[3])); }
    }
};

template <int K, class F> DI void sample_gemm(int wv, LAS unsigned char* lds, const bf16* A, int lda, const bf16* Bt, int ldb, int nN, const F& f, int G, int c0) {
    unsigned z_ = 0u; asm volatile("" : "+v"(z_)); const int tid_ = wv * 64 + (int)__builtin_amdgcn_mbcnt_hi(~0u, __builtin_amdgcn_mbcnt_lo(~0u, z_)); const int tid = tid_, w = __builtin_amdgcn_readfirstlane(tid >> 6), lane = tid & 63, fr = lane & 15, fq = lane >> 4;
    LAS float* red = (LAS float*)lds;
    constexpr int kw = K / 8, NKS = kw / 32, KB = 4;
    const int n_mu = 16 * nN * 4;
    for (int mu = c0; mu < n_mu; mu += G) {
        const int rb = mu & 15, t = mu >> 4, pn = t >> 2, s = t & 3, row0 = MP + rb * 16;
        f32x4 acc[4];
#pragma unroll
        for (int j = 0; j < 4; ++j) acc[j] = (f32x4){0.f, 0.f, 0.f, 0.f};
        const bf16* ap = A + (size_t)(row0 + fr) * lda + w * kw + fq * 8;
        const bf16* bp = Bt + (size_t)(pn * 256 + s * 32 + fr) * ldb + w * kw + fq * 8;
#pragma unroll
        for (int k0 = 0; k0 < NKS; k0 += KB) {
            bf16x8 a[KB], b[KB][4];
#pragma unroll
            for (int kk = 0; kk < KB; ++kk) if (k0 + kk < NKS) {
                a[kk] = *(const bf16x8*)(ap + (k0 + kk) * 32);
#pragma unroll
                for (int j = 0; j < 4; ++j) b[kk][j] = *(const bf16x8*)(bp + (size_t)((j >> 1) * 128 + (j & 1) * 16) * ldb + (k0 + kk) * 32);
            }
#pragma unroll
            for (int kk = 0; kk < KB; ++kk) if (k0 + kk < NKS) {
#pragma unroll
                for (int j = 0; j < 4; ++j) acc[j] = __builtin_amdgcn_mfma_f32_16x16x32_bf16(b[kk][j], a[kk], acc[j], 0, 0, 0);
            }
        }
#pragma unroll
        for (int j = 0; j < 4; ++j) *(LAS f32x4*)(red + ((w * 4 + j) * 64 + lane) * 4) = acc[j];
        __syncthreads();
        if (w == 0) {
            f32x4 v0[2], v1[2];
#pragma unroll
            for (int wb = 0; wb < 2; ++wb) { v0[wb] = (f32x4){0.f, 0.f, 0.f, 0.f}; v1[wb] = v0[wb];
#pragma unroll
                for (int ww = 0; ww < 8; ++ww) { v0[wb] += *(LAS f32x4*)(red + ((ww * 4 + wb) * 64 + lane) * 4); v1[wb] += *(LAS f32x4*)(red + ((ww * 4 + wb + 2) * 64 + lane) * 4); } }
            apply_two(f, row0 + fr, pn, s * 32 + fq * 4, v0, v1, fq, s);
        }
        __syncthreads();
    }
}

template <class F> DI void sample_gemm_wide(int wv, LAS unsigned char* lds, const bf16* A, const bf16* Bt, int nN, const F& f, int G, int c0) {
    unsigned z_ = 0u; asm volatile("" : "+v"(z_)); const int lane = (int)__builtin_amdgcn_mbcnt_hi(~0u, __builtin_amdgcn_mbcnt_lo(~0u, z_)), fr = lane & 15, fq = lane >> 4, w = wv;
    constexpr int K = D;
    LAS float* red = (LAS float*)lds;
    const int n_mu = 4 * nN * 4;
    for (int mu = c0; mu < n_mu; mu += G) {
        const int rg = mu & 3, t = mu >> 2, pn = t >> 2, s = t & 3, row0 = MP + rg * 64;
        f32x4 acc[4][4];
#pragma unroll
        for (int rb = 0; rb < 4; ++rb)
#pragma unroll
            for (int j = 0; j < 4; ++j) acc[rb][j] = (f32x4){0.f, 0.f, 0.f, 0.f};
        const bf16* ap = A + (size_t)(row0 + fr) * K + w * 128 + fq * 8;
        const bf16* bp = Bt + (size_t)(pn * 256 + s * 32 + fr) * K + w * 128 + fq * 8;
        bf16x8 a[4][4], b[4][4];
#pragma unroll
        for (int kk = 0; kk < 4; ++kk)
#pragma unroll
            for (int x = 0; x < 4; ++x) { a[kk][x] = *(const bf16x8*)(ap + (size_t)x * 16 * K + kk * 32); b[kk][x] = *(const bf16x8*)(bp + (size_t)((x >> 1) * 128 + (x & 1) * 16) * K + kk * 32); }
#pragma unroll
        for (int kk = 0; kk < 4; ++kk)
#pragma unroll
            for (int rb = 0; rb < 4; ++rb)
#pragma unroll
                for (int j = 0; j < 4; ++j) acc[rb][j] = __builtin_amdgcn_mfma_f32_16x16x32_bf16(b[kk][j], a[kk][rb], acc[rb][j], 0, 0, 0);
#pragma unroll
        for (int rb = 0; rb < 4; ++rb)
#pragma unroll
            for (int j = 0; j < 4; ++j) *(LAS f32x4*)(red + ((w * 16 + rb * 4 + j) * 64 + lane) * 4) = acc[rb][j];
        __syncthreads();
        {
            const int rb = w >> 1, wb = w & 1; f32x4 v0 = (f32x4){0.f, 0.f, 0.f, 0.f}, v1 = v0;
#pragma unroll
            for (int ww = 0; ww < 8; ++ww) { v0 += *(LAS f32x4*)(red + ((ww * 16 + rb * 4 + wb) * 64 + lane) * 4); v1 += *(LAS f32x4*)(red + ((ww * 16 + rb * 4 + wb + 2) * 64 + lane) * 4); }
            const int row = row0 + rb * 16 + fr, c = s * 32 + wb * 16 + fq * 4; typename F::Row rc; f.row_begin(rc, row, pn, -1);
            if constexpr (F::NKIND == 1) f.template apply<0>(rc, row, pn, c, v0, v1);
            else { const int kd = f.kind(pn);
                if (kd == 0) f.template apply<0>(rc, row, pn, c, v0, v1); else if (kd == 1) f.template apply<1>(rc, row, pn, c, v0, v1);
                else if constexpr (F::NKIND > 2) { if (kd == 2) f.template apply<2>(rc, row, pn, c, v0, v1); else if (kd == 3) f.template apply<3>(rc, row, pn, c, v0, v1); else f.template apply<4>(rc, row, pn, c, v0, v1); } }
        }
        __syncthreads();
    }
}

DI void tr_item(const float* W, int N, int sc0, const float* gain, bf16* WT, int K, int n0, int k0, LAS float* scr, int lane) {
#pragma unroll
    for (int i = 0; i < 8; ++i) { const int kk = 8 * i + (lane >> 3), n4 = (lane & 7) * 4; const float g = gain ? gain[k0 + kk] : 1.f; const f32x4 v = *(const f32x4*)(W + (size_t)(k0 + kk) * N + sc0 + n4);
        LAS float* d = scr + kk * 33 + n4; d[0] = v[0] * g; d[1] = v[1] * g; d[2] = v[2] * g; d[3] = v[3] * g; }
    LDS_WAIT();
    const int c = lane & 7;
#pragma unroll
    for (int j = 0; j < 4; ++j) { const int n = (lane >> 3) + 8 * j; const LAS float* s = scr + (8 * c) * 33 + n;
        u32x4 o; o.x = pk2(s[0 * 33], s[1 * 33]); o.y = pk2(s[2 * 33], s[3 * 33]); o.z = pk2(s[4 * 33], s[5 * 33]); o.w = pk2(s[6 * 33], s[7 * 33]);
        *(u32x4*)(WT + (size_t)(n0 + n) * K + k0 + 8 * c) = o; }
    LDS_WAIT();
}
DI int map_win(int n0) {
    const int t = n0 >> 8, r = n0 & 255, hb = r >> 7, rr = r & 127;
    switch (t) {
        case 0: return r;
        case 1: case 2: return (hb ? 512 : 256) + (t - 1) * 128 + rr;
        case 3: case 4: return 768 + ((t - 3) * 4 + (rr >> 5)) * 64 + hb * 32 + (rr & 31);
        case 5: { const int blk = rr >> 5; return (blk < 2 ? 1280 + blk * 64 : 1408 + (blk - 2) * 64) + hb * 32 + (rr & 31); }
        default: return (hb ? 1792 : 1536) + (t - 6) * 128 + rr;
    }
}
DI void sincos_d(double a, float& sn, float& cs) {
    const double k = rint(a * 0.6366197723675814); double r = fma(-k, 1.5707963267948966, a); r = fma(-k, 6.123233995736766e-17, r); const double r2 = r * r;
    const double s = r * (1.0 + r2 * (-1.0 / 6 + r2 * (1.0 / 120 + r2 * (-1.0 / 5040 + r2 * (1.0 / 362880 + r2 * (-1.0 / 39916800 + r2 * (1.0 / 6227020800.0)))))));
    const double c = 1.0 + r2 * (-0.5 + r2 * (1.0 / 24 + r2 * (-1.0 / 720 + r2 * (1.0 / 40320 + r2 * (-1.0 / 3628800 + r2 * (1.0 / 479001600 + r2 * (-1.0 / 87178291200.0)))))));
    const int q = (int)((long long)k & 3);
    sn = (float)(q == 0 ? s : q == 1 ? c : q == 2 ? -s : -c); cs = (float)(q == 0 ? c : q == 1 ? -s : q == 2 ? -c : s);
}
DI void prologue(int wv, unsigned char* ws, float* out, LAS unsigned char* lds) {
    unsigned z_ = 0u; asm volatile("" : "+v"(z_)); const int tid_ = wv * 64 + (int)__builtin_amdgcn_mbcnt_hi(~0u, __builtin_amdgcn_mbcnt_lo(~0u, z_)); const int tid = tid_, w = __builtin_amdgcn_readfirstlane(tid >> 6), lane = tid & 63, G = gridDim.x;
    const int gw = blockIdx.x * 8 + w, NGW = G * 8; const int gt = blockIdx.x * NTHR + tid, NGT = G * NTHR;
    { float* rc = (float*)(ws + WS_ROPE); float* rs = rc + (size_t)S * 32;
      for (int i = gt; i < S * 32; i += NGT) { const int pos = i >> 5, j = i & 31; double inv = 1.0; for (int q = 0; q < j; ++q) inv *= 0.74989420933245587; float sn, cs; sincos_d((double)pos * inv, sn, cs); rc[i] = cs; rs[i] = sn; } }
    { bf16* xb = (bf16*)(ws + WS_XB); float* ss0 = (float*)(ws + WS_SS); bf16* mn = (bf16*)(ws + WS_MN);
      for (int m = gw; m < MT + 512; m += NGW) {
          const float* src = m < MP ? IN(I_XP) + (size_t)m * D : m < MT ? IN(I_XS) + (size_t)(m - MP) * D : IN(I_MEM) + (size_t)(m - MT) * D;
          f32x4 v[4]; float s = 0.f;
#pragma unroll
          for (int j = 0; j < 4; ++j) { v[j] = *((const f32x4*)src + lane + 64 * j); }
          if (m < MT) {
              bf16* o = xb + (size_t)m * D;
#pragma unroll
              for (int j = 0; j < 4; ++j) { u32x2 wv; wv.x = pk2(v[j][0], v[j][1]); wv.y = pk2(v[j][2], v[j][3]); *((u32x2*)o + lane + 64 * j) = wv; const f32x4 r = unpk4(wv); s += (r[0] * r[0] + r[1] * r[1]) + (r[2] * r[2] + r[3] * r[3]); }
              s = wave_sum(s); if (lane < 16) ss0[(size_t)m * 16 + lane] = lane == 0 ? s : 0.f;
          } else {
#pragma unroll
              for (int j = 0; j < 4; ++j) s += (v[j][0] * v[j][0] + v[j][1] * v[j][1]) + (v[j][2] * v[j][2] + v[j][3] * v[j][3]);
              const float rstd = rsqrtf(wave_sum(s) * (1.f / D) + EPS); bf16* o = mn + (size_t)(m - MT) * D;
#pragma unroll
              for (int j = 0; j < 4; ++j) st4bf(o + 4 * (lane + 64 * j), v[j] * rstd);
          }
      } }
    { LAS float* scr = (LAS float*)(lds + w * 16384);
      constexpr int I1 = 16 * 176, ID = 44 * 32, IIN = 16 * 64, ISQ = 16 * 32, IKV = 16 * 64, IL = 2 * I1 + 2 * ID + IIN + 3 * ISQ + IKV;
      for (int it = gw; it < NL * IL; it += NGW) {
          const int l = it / IL; int r = it % IL; unsigned char* wl = ws + WS_W + (size_t)l * LW;
          if (r < 2 * I1) { const int second = r >= I1; if (second) r -= I1; const int nb = r % 176, kb = r / 176, n0 = nb * 32, pn = n0 >> 8, rr = n0 & 255;
              const float* W = (second ? (rr >= 128 ? IN(I_F2U) : IN(I_F2G)) : (rr >= 128 ? IN(I_F1U) : IN(I_F1G))) + (size_t)l * D * FF;
              tr_item(W, FF, pn * 128 + (rr & 127), (second ? IN(I_F2N) : IN(I_F1N)) + l * D, (bf16*)(wl + (second ? W_2 : W_1)), D, n0, kb * 64, scr, lane); continue; }
          r -= 2 * I1;
          if (r < 2 * ID) { const int second = r >= ID; if (second) r -= ID; const int nb = r % 32, kb = r / 32;
              tr_item((second ? IN(I_F2D) : IN(I_F1D)) + (size_t)l * FF * D, D, nb * 32, nullptr, (bf16*)(wl + (second ? W_D2 : W_D1)), FF, nb * 32, kb * 64, scr, lane); continue; }
          r -= 2 * ID;
          if (r < IIN) { const int nb = r % 64, kb = r / 64; tr_item(IN(I_WIN) + (size_t)l * D * 2048, 2048, map_win(nb * 32), IN(I_MIXN) + l * D, (bf16*)(wl + W_IN), D, nb * 32, kb * 64, scr, lane); continue; }
          r -= IIN;
          if (r < 3 * ISQ) { const int which = r / ISQ; r -= which * ISQ; const int nb = r % 32, kb = r / 32;
              const float* W = (which == 0 ? IN(I_WOUT) : which == 1 ? IN(I_WQ) : IN(I_WO)) + (size_t)l * D * D; const float* g = which == 0 ? IN(I_MON) + l * D : which == 1 ? IN(I_XAN) + l * D : nullptr;
              tr_item(W, D, nb * 32, g, (bf16*)(wl + (which == 0 ? W_OUT : which == 1 ? W_Q : W_O)), D, nb * 32, kb * 64, scr, lane); continue; }
          r -= 3 * ISQ;
          { const int nb = r % 64, kb = r / 64, n0 = nb * 32; tr_item((n0 < 1024 ? IN(I_WK) : IN(I_WV)) + (size_t)l * D * D, D, n0 & 1023, IN(I_MEMN) + l * D, (bf16*)(wl + W_KV), D, n0, kb * 64, scr, lane); }
      } }
}

DI f32x16 mfma32(bf16x8 a, bf16x8 b, f32x16 c) { return __builtin_amdgcn_mfma_f32_32x32x16_bf16(a, b, c, 0, 0, 0); }
constexpr int MX_KSZ = 192 * 144, MX_VOFF = 2 * MX_KSZ, MX_VP = 392, MX_SSB = MX_VOFF + 128 * MX_VP, MX_WC = MX_SSB + 2048, MX_END = MX_WC + 48 * 256 * 4;
static_assert(MX_END <= LDS_TAB, "mixer LDS");

template <int TW, class LA, class LC, class LCP, class LG> DI void conv_tokens(int l, LAS unsigned char* lds, int lane, LA ldA, LC ldC, LCP ldCp, LG ldG, bf16* ymix_row0  ) {
    const int ch = 4 * lane;
    const float* caw = IN(I_CAW) + (size_t)l * 3 * 256 + ch; const f32x4 wa0 = *(const f32x4*)caw, wa1 = *(const f32x4*)(caw + 256), wa2 = *(const f32x4*)(caw + 512);
    const LAS float* wc = (const LAS float*)(lds + MX_WC) + ch;
    f32x4 accA[TW], accC[TW];
    const f32x4 bias = *(const f32x4*)(IN(I_CCB) + l * 256 + ch);
#pragma unroll
    for (int t = 0; t < TW; ++t) { accA[t] = (f32x4){0.f, 0.f, 0.f, 0.f}; accC[t] = bias; }
#pragma unroll
    for (int i = 0; i < TW + 2; ++i) { const f32x4 x = ldA(i);
#pragma unroll
        for (int t = 0; t < TW; ++t) { const int j = i - t; if (j == 0) accA[t] += wa0 * x; else if (j == 1) accA[t] += wa1 * x; else if (j == 2) accA[t] += wa2 * x; } }
    constexpr int NWIN = TW + 30;
    {
#pragma unroll 1
        for (int ib = 0; ib < NWIN; ib += 16) {
            f32x4 x[16];
#pragma unroll
            for (int ii = 0; ii < 16; ++ii) x[ii] = ldC(ib + ii);
#pragma unroll
            for (int ii = 0; ii < 16; ++ii)
#pragma unroll
                for (int t = 0; t < TW; ++t) accC[t] += *(const LAS f32x4*)(wc + (ib + ii - t + 8) * 256) * x[ii];
        }
    }
    const f32x4 lng = *(const f32x4*)(IN(I_LNG) + l * 256 + ch), lnb = *(const f32x4*)(IN(I_LNB) + l * 256 + ch);
#pragma unroll
    for (int t = 0; t < TW; ++t) {
        const f32x4 ya = ldG(t) * accA[t];
        const float ssa = wave_sum((ya[0] * ya[0] + ya[1] * ya[1]) + (ya[2] * ya[2] + ya[3] * ya[3]));
        st4bf(ymix_row0 + (size_t)t * D + ch, ya * rsqrtf(ssa * (1.f / 256) + EPS));
        const f32x4 cc = accC[t];
        const float mean = wave_sum((cc[0] + cc[1]) + (cc[2] + cc[3])) * (1.f / 256); const f32x4 dc = cc - mean;
        const float var = wave_sum((dc[0] * dc[0] + dc[1] * dc[1]) + (dc[2] * dc[2] + dc[3] * dc[3])) * (1.f / 256);
        const f32x4 ln = dc * rsqrtf(var + EPS) * lng + lnb; f32x4 yc;
#pragma unroll
        for (int e = 0; e < 4; ++e) yc[e] = ln[e] * sigmoidf_(ln[e]);
        const float ssc = wave_sum((yc[0] * yc[0] + yc[1] * yc[1]) + (yc[2] * yc[2] + yc[3] * yc[3]));
        st4bf(ymix_row0 + (size_t)t * D + 768 + ch, yc * rsqrtf(ssc * (1.f / 256) + EPS));
    }
}

template <bool SMP> DI void attn_qb(const LAS unsigned char* Kl, const LAS unsigned char* Vl, const bf16* qp, float sink2, int kb0, f32x16 (&o)[2]) {
    bf16x8 qf[4];
#pragma unroll
    for (int ks = 0; ks < 4; ++ks) qf[ks] = *(const bf16x8*)(qp + ks * 16);
    f32x16 s[6];
#pragma unroll
    for (int kb = 0; kb < 6; ++kb)
#pragma unroll
        for (int i = 0; i < 16; ++i) s[kb][i] = 0.f;
#pragma unroll
    for (int ks = 0; ks < 4; ++ks)
#pragma unroll
        for (int kb = 0; kb < 6; ++kb) { const bf16x8 a = *(const LAS bf16x8*)(Kl + kb * 32 * 144 + ks * 32); s[kb] = mfma32(a, qf[ks], s[kb]); }
#pragma unroll
    for (int kb = 0; kb < 6; ++kb) { if (SMP ? kb == 5 : kb < kb0) {
#pragma unroll
            for (int i = 0; i < 16; ++i) s[kb][i] = -3.0e38f; }
        if (SMP && kb == 4) {
#pragma unroll
            for (int i = 8; i < 16; ++i) s[kb][i] = -3.0e38f; } }
    float m4[4] = {sink2, sink2, sink2, sink2};
#pragma unroll
    for (int kb = 0; kb < 6; ++kb)
#pragma unroll
        for (int i = 0; i < 16; ++i) m4[i & 3] = fmaxf(m4[i & 3], s[kb][i]);
    float mx = fmaxf(fmaxf(m4[0], m4[1]), fmaxf(m4[2], m4[3]));
    mx = fmaxf(mx, __shfl_xor(mx, 32));
    float s4[4] = {0.f, 0.f, 0.f, 0.f};
#pragma unroll
    for (int kb = 0; kb < 6; ++kb)
#pragma unroll
        for (int i = 0; i < 16; ++i) { s[kb][i] = __builtin_amdgcn_exp2f(s[kb][i] - mx); s4[i & 3] += s[kb][i]; }
    float sum = (s4[0] + s4[1]) + (s4[2] + s4[3]);
    sum += __shfl_xor(sum, 32);
    const float inv = __builtin_amdgcn_rcpf(sum + __builtin_amdgcn_exp2f(sink2 - mx));
    f32x16 o2[2][2];
#pragma unroll
    for (int hb = 0; hb < 2; ++hb)
#pragma unroll
        for (int t = 0; t < 2; ++t)
#pragma unroll
            for (int i = 0; i < 16; ++i) o2[hb][t][i] = 0.f;
#pragma unroll
    for (int kb = 0; kb < 6; ++kb)
#pragma unroll
        for (int t = 0; t < 2; ++t) {
            u32x4 pw; pw.x = pk2(s[kb][8 * t] * inv, s[kb][8 * t + 1] * inv); pw.y = pk2(s[kb][8 * t + 2] * inv, s[kb][8 * t + 3] * inv);
            pw.z = pk2(s[kb][8 * t + 4] * inv, s[kb][8 * t + 5] * inv); pw.w = pk2(s[kb][8 * t + 6] * inv, s[kb][8 * t + 7] * inv);
            const bf16x8 pf = __builtin_bit_cast(bf16x8, pw);
#pragma unroll
            for (int hb = 0; hb < 2; ++hb) {
                const LAS unsigned char* vp = Vl + hb * 32 * MX_VP + (kb * 32 + t * 16) * 2;
                const u32x2 lo = *(const LAS u32x2*)vp, hi = *(const LAS u32x2*)(vp + 16);
                const bf16x8 vf = __builtin_bit_cast(bf16x8, (u32x4){lo.x, lo.y, hi.x, hi.y});
                o2[hb][t] = mfma32(vf, pf, o2[hb][t]);
            }
        }
#pragma unroll
    for (int hb = 0; hb < 2; ++hb) o[hb] = o2[hb][0] + o2[hb][1];
}

DI void mixer_phase(int wv, unsigned char* ws, float* out, int l, LAS unsigned char* lds, int G, int bx) {
    unsigned z_ = 0u; asm volatile("" : "+v"(z_)); const int tid_ = wv * 64 + (int)__builtin_amdgcn_mbcnt_hi(~0u, __builtin_amdgcn_mbcnt_lo(~0u, z_)); const int tid = tid_, w = __builtin_amdgcn_readfirstlane(tid >> 6), lane = tid & 63, r = lane & 31, hf = lane >> 5;
    unsigned char* R = ws + WS_R;
    const bf16* gb = (const bf16*)(R + R_GB); const bf16* cv = (const bf16*)(R + R_CV); const bf16* qb_ = (const bf16*)(R + R_Q); const bf16* kb_ = (const bf16*)(R + R_K);
    const bf16* vT = (const bf16*)(R + R_VT); const bf16* vS = (const bf16*)(R + R_VS); const bf16* glu = (const bf16*)(R + R_GLU); bf16* ymix = (bf16*)(R + R_YMIX);
    { const float* src = IN(I_CCW) + (size_t)l * 31 * 256; LAS float* dst = (LAS float*)(lds + MX_WC);
#pragma unroll
      for (int it = 0; it < 6; ++it) { const int i4 = tid + it * NTHR, j = (i4 >> 6) - 8; const bool ok = j >= 0 && j <= 30; const f32x4 v = *(const f32x4*)(src + (ok ? j : 0) * 256 + (i4 & 63) * 4);
          *(LAS f32x4*)(dst + i4 * 4) = ok ? v : (f32x4){0.f, 0.f, 0.f, 0.f}; } }
    const float sink2 = IN(I_SINK)[l * 8 + w] * LOG2E;
    LAS float* ssb = (LAS float*)(lds + MX_SSB);
    __syncthreads();
#ifndef PROBE
#define PROBE 0
#endif
    for (int rep_ = 0; rep_ < (PROBE == 12 ? 2 : 1); ++rep_)
    for (int u = bx; u < NB * 256; u += G) {
        const int b = u >> 8, n = u & 255; const size_t row0 = (size_t)b * S + n * 64;
        u32x4 kreg[6], vreg[6];
#pragma unroll
        for (int it = 0; it < 6; ++it) {
            const int p = tid + it * NTHR, key = p >> 4, part = p & 15, pos = n * 64 - 128 + key;
            kreg[it] = *(const u32x4*)(kb_ + ((size_t)b * S + (pos >= 0 ? pos : 0)) * 128 + part * 8);
            const int rr = p / 24, pc = p % 24, pos0 = n * 64 - 128 + pc * 8;
            vreg[it] = *(const u32x4*)(vT + ((size_t)(b * 128 + rr)) * S + (pos0 >= 0 ? pos0 : 0));
        }
        const int t0 = w * 8, p0 = n * 64 + t0; const size_t brow = (size_t)b * S;
        auto ldP = [&](const bf16* base, int p) -> u32x2 { const u32x2 v = *(const u32x2*)(base + (brow + (p >= 0 ? p : 0)) * 256 + 4 * lane); return p >= 0 ? v : (u32x2){0u, 0u}; };
        u32x2 wa_[10], wg_[8], w0_[8], nw_[8];
#pragma unroll
        for (int i = 0; i < 10; ++i) wa_[i] = ldP(cv, p0 - 2 + i);
#pragma unroll
        for (int i = 0; i < 8; ++i) { wg_[i] = ldP(gb, p0 + i); w0_[i] = ldP(glu, p0 - 30 + i); nw_[i] = ldP(glu, p0 - 22 + i); }
#pragma unroll
        for (int it = 0; it < 6; ++it) {
            const int p = tid + it * NTHR, key = p >> 4, part = p & 15, pos = n * 64 - 128 + key;
            *(LAS u32x4*)(lds + (part >> 3) * MX_KSZ + key * 144 + (part & 7) * 16) = pos >= 0 ? kreg[it] : (u32x4){0u, 0u, 0u, 0u};
            const int rr = p / 24, pc = p % 24, pos0 = n * 64 - 128 + pc * 8; const u32x4 v = pos0 >= 0 ? vreg[it] : (u32x4){0u, 0u, 0u, 0u};
            LAS u32x2* d = (LAS u32x2*)(lds + MX_VOFF + rr * MX_VP + pc * 16); d[0] = (u32x2){v.x, v.y}; d[1] = (u32x2){v.z, v.w};
        }
        {
            const int ch = 4 * lane;
            const float* caw = IN(I_CAW) + (size_t)l * 3 * 256 + ch; const f32x4 wa0 = *(const f32x4*)caw, wa1 = *(const f32x4*)(caw + 256), wa2 = *(const f32x4*)(caw + 512);
            const LAS float* wc = (const LAS float*)(lds + MX_WC) + ch;
            const f32x4 bias = *(const f32x4*)(IN(I_CCB) + l * 256 + ch);
            const f32x4 lng = *(const f32x4*)(IN(I_LNG) + l * 256 + ch), lnb = *(const f32x4*)(IN(I_LNB) + l * 256 + ch);
            f32x4 accC[8], Rg[8];
#pragma unroll
            for (int t = 0; t < 8; ++t) { accC[t] = bias; Rg[t] = unpk4(w0_[t]); }
#pragma unroll 1
            for (int jb = 0; jb < 32; jb += 8) {
                u32x2 nx[8];
#pragma unroll
                for (int s = 0; s < 8; ++s) { const int i = jb + 16 + s; nx[s] = (i < 38) ? ldP(glu, p0 - 30 + i) : (u32x2){0u, 0u}; }
#pragma unroll
                for (int s = 0; s < 8; ++s) { const f32x4 wt = *(const LAS f32x4*)(wc + (jb + s + 8) * 256);
#pragma unroll
                    for (int t = 0; t < 8; ++t) accC[t] += wt * Rg[(t + s) & 7];
                    Rg[s] = unpk4(nw_[s]); }
#pragma unroll
                for (int s = 0; s < 8; ++s) nw_[s] = nx[s];
            }
            bf16* yrow = ymix + (brow + p0) * D;
#pragma unroll
            for (int t = 0; t < 8; ++t) {
                const f32x4 ya = unpk4(wg_[t]) * (wa0 * unpk4(wa_[t]) + wa1 * unpk4(wa_[t + 1]) + wa2 * unpk4(wa_[t + 2]));
                const float ssa = wave_sum((ya[0] * ya[0] + ya[1] * ya[1]) + (ya[2] * ya[2] + ya[3] * ya[3]));
                st4bf(yrow + (size_t)t * D + ch, ya * rsqrtf(ssa * (1.f / 256) + EPS));
                const f32x4 cc = accC[t];
                const float mean = wave_sum((cc[0] + cc[1]) + (cc[2] + cc[3])) * (1.f / 256); const f32x4 dc = cc - mean;
                const float var = wave_sum((dc[0] * dc[0] + dc[1] * dc[1]) + (dc[2] * dc[2] + dc[3] * dc[3])) * (1.f / 256);
                const f32x4 ln = dc * rsqrtf(var + EPS) * lng + lnb; f32x4 yc;
#pragma unroll
                for (int e = 0; e < 4; ++e) yc[e] = ln[e] * sigmoidf_(ln[e]);
                const float ssc = wave_sum((yc[0] * yc[0] + yc[1] * yc[1]) + (yc[2] * yc[2] + yc[3] * yc[3]));
                st4bf(yrow + (size_t)t * D + 768 + ch, yc * rsqrtf(ssc * (1.f / 256) + EPS));
            }
        }
        __syncthreads();
        const int kvh = w >> 2, kb0 = n >= 2 ? 0 : (2 - n) * 2;
        const LAS unsigned char* Kl = lds + kvh * MX_KSZ + r * 144 + hf * 16; const LAS unsigned char* Vl = lds + MX_VOFF + (kvh * 64 + r) * MX_VP + hf * 8;
#pragma unroll 1
        for (int qb = 0; qb < (PROBE == 17 ? 4 : 2); ++qb) {
            f32x16 o[2]; attn_qb<false>(Kl, Vl, qb_ + (row0 + (qb & 1) * 32 + r) * 512 + w * 64 + hf * 8, sink2, kb0, o);
            float sq = 0.f;
#pragma unroll
            for (int hb = 0; hb < 2; ++hb)
#pragma unroll
                for (int i = 0; i < 16; ++i) sq += o[hb][i] * o[hb][i];
            sq += __shfl_xor(sq, 32);
            if (hf == 0) ssb[((qb & 1) * 8 + w) * 32 + r] = sq;
            __syncthreads();
            float tot = 0.f;
#pragma unroll
            for (int hh = 0; hh < 8; ++hh) tot += ssb[((qb & 1) * 8 + hh) * 32 + r];
            const float rs = rsqrtf(tot * (1.f / 512) + EPS); bf16* yp = ymix + (row0 + (qb & 1) * 32 + r) * D + 256 + w * 64 + 4 * hf;
#pragma unroll
            for (int hb = 0; hb < 2; ++hb)
#pragma unroll
                for (int g = 0; g < 4; ++g) st4bf(yp + hb * 32 + 8 * g, (f32x4){o[hb][4 * g] * rs, o[hb][4 * g + 1] * rs, o[hb][4 * g + 2] * rs, o[hb][4 * g + 3] * rs});
        }
        __syncthreads();
    }
    for (int rep_ = 0; rep_ < ((PROBE == 13 || PROBE == 14) ? 2 : 1); ++rep_)
    for (int sb = bx - (G - 32); sb >= 0 && sb < 16; sb += G) {
        const size_t srow0 = (size_t)MP + sb * 16;
        const int t0 = w * 2; const float* sa = IN(I_SA) + ((size_t)(l * 16 + sb) * 2) * 256; const float* sc = IN(I_SC) + ((size_t)(l * 16 + sb) * 30) * 256;
        auto ldA = [&](int i) -> f32x4 { const int p = t0 - 2 + i; return p >= 0 ? ld4bf(cv + (srow0 + p) * 256 + 4 * lane) : *(const f32x4*)(sa + (2 + p) * 256 + 4 * lane); };
        auto ldC = [&](int i) -> f32x4 { const int p = t0 - 30 + i; return p >= 0 ? ld4bf(glu + (srow0 + p) * 256 + 4 * lane) : *(const f32x4*)(sc + (30 + p) * 256 + 4 * lane); };
        auto ldG = [&](int t) -> f32x4 { return ld4bf(gb + (srow0 + t0 + t) * 256 + 4 * lane); };
        conv_tokens<2>(l, lds, lane, ldA, ldC, ldC, ldG, ymix + (srow0 + t0) * D);
        float* oc = out + O_CS + ((size_t)(l * 16 + sb) * 30) * 256;
        for (int i = tid; i < 14 * 256; i += NTHR) oc[i] = sc[16 * 256 + i];
    }
    __syncthreads();
    for (int rep_ = 0; rep_ < ((PROBE == 13 || PROBE == 15) ? 2 : 1); ++rep_)
    for (int sb = bx - (G - 16); sb >= 0 && sb < 16; sb += G) {
        const size_t srow0 = (size_t)MP + sb * 16;
        const float* ck = IN(I_CK) + ((size_t)(l * 16 + sb) * 128) * 128; const float* cvv = IN(I_CV) + ((size_t)(l * 16 + sb) * 128) * 128;
        f32x4 kr_[8], vr_[8];
#pragma unroll
        for (int it = 0; it < 8; ++it) { const int i = tid + it * NTHR; kr_[it] = *(const f32x4*)(ck + (size_t)i * 4); vr_[it] = *(const f32x4*)(cvv + (size_t)i * 4); }
        u32x4 kn_ = (u32x4){0u, 0u, 0u, 0u}, vn_ = kn_;
        if (tid < 256) { kn_ = *(const u32x4*)(kb_ + (srow0 + (tid >> 4)) * 128 + (tid & 15) * 8); vn_ = *(const u32x4*)(vS + ((size_t)sb * 16 + (tid >> 4)) * 128 + (tid & 15) * 8); }
        for (int i = tid; i < 128 * 12; i += NTHR) { const int rr = i / 12, pc = i % 12; *(LAS u32x2*)(lds + MX_VOFF + rr * MX_VP + 288 + pc * 8) = (u32x2){0u, 0u}; }
#pragma unroll
        for (int it = 0; it < 8; ++it) {
            const int i = tid + it * NTHR, key = i >> 5, c = (i & 31) * 4;
            *(LAS u32x2*)(lds + (c >> 6) * MX_KSZ + key * 144 + (c & 63) * 2) = (u32x2){pk2(kr_[it][0], kr_[it][1]), pk2(kr_[it][2], kr_[it][3])};
#pragma unroll
            for (int e = 0; e < 4; ++e) *(LAS bf16*)(lds + MX_VOFF + (c + e) * MX_VP + key * 2) = f2bf(vr_[it][e]);
        }
        if (tid < 256) {
            const int key = 128 + (tid >> 4), part = tid & 15;
            *(LAS u32x4*)(lds + (part >> 3) * MX_KSZ + key * 144 + (part & 7) * 16) = kn_;
            const unsigned vw[4] = {vn_.x, vn_.y, vn_.z, vn_.w};
#pragma unroll
            for (int e = 0; e < 8; ++e) *(LAS bf16*)(lds + MX_VOFF + (part * 8 + e) * MX_VP + key * 2) = (bf16)((vw[e >> 1] >> ((e & 1) * 16)) & 0xffffu);
        }
        __syncthreads();
        {
            const int kvh = w >> 2, tq = r & 15;
            const LAS unsigned char* Kl = lds + kvh * MX_KSZ + r * 144 + hf * 16; const LAS unsigned char* Vl = lds + MX_VOFF + (kvh * 64 + r) * MX_VP + hf * 8;
            f32x16 o[2]; attn_qb<true>(Kl, Vl, qb_ + (srow0 + tq) * 512 + w * 64 + hf * 8, sink2, 0, o);
            float sq = 0.f;
#pragma unroll
            for (int hb = 0; hb < 2; ++hb)
#pragma unroll
                for (int i = 0; i < 16; ++i) sq += o[hb][i] * o[hb][i];
            sq += __shfl_xor(sq, 32);
            if (hf == 0) ssb[w * 32 + r] = sq;
            __syncthreads();
            float tot = 0.f;
#pragma unroll
            for (int hh = 0; hh < 8; ++hh) tot += ssb[hh * 32 + r];
            const float rs = rsqrtf(tot * (1.f / 512) + EPS); bf16* yp = ymix + (srow0 + tq) * D + 256 + w * 64 + 4 * hf;
            if (r < 16) {
#pragma unroll
                for (int hb = 0; hb < 2; ++hb)
#pragma unroll
                    for (int g = 0; g < 4; ++g) st4bf(yp + hb * 32 + 8 * g, (f32x4){o[hb][4 * g] * rs, o[hb][4 * g + 1] * rs, o[hb][4 * g + 2] * rs, o[hb][4 * g + 3] * rs});
            }
        }
        __syncthreads();
    }
}

DI void xattn_sample(int wv, unsigned char* ws, float* out, int l, LAS unsigned char* lds, int G, int bx) {
    unsigned z_ = 0u; asm volatile("" : "+v"(z_)); const int tid_ = wv * 64 + (int)__builtin_amdgcn_mbcnt_hi(~0u, __builtin_amdgcn_mbcnt_lo(~0u, z_)); const int tid = tid_, w = __builtin_amdgcn_readfirstlane(tid >> 6), lane = tid & 63, fr = lane & 15, fq = lane >> 4;
    bf16* qx = (bf16*)(ws + WS_R + R_QX);
    LAS float* PS = (LAS float*)lds;
    LAS float* RM = (LAS float*)(lds + 16 * 260 * 4);
    for (int u = bx - (G - 64); u >= 0 && u < 64; u += G) {
        const int sb = u >> 2, h = u & 3; const size_t srow0 = (size_t)MP + sb * 16;
        const float* mk = IN(I_MK) + (((size_t)(l * 16 + sb) * 256) * 4 + h) * 256; const float* mv = IN(I_MV) + (((size_t)(l * 16 + sb) * 256) * 4 + h) * 256;
        f32x4 acc[2] = {(f32x4){0.f, 0.f, 0.f, 0.f}, (f32x4){0.f, 0.f, 0.f, 0.f}};
        const bf16* qp = qx + (srow0 + fr) * D + h * 256 + fq * 8;
#pragma unroll
        for (int ks = 0; ks < 8; ++ks) {
            const bf16x8 qf = *(const bf16x8*)(qp + ks * 32);
#pragma unroll
            for (int kbk = 0; kbk < 2; ++kbk) {
                const float* kp = mk + (size_t)(w * 32 + kbk * 16 + fr) * 1024 + ks * 32 + fq * 8; const f32x4 k0 = *(const f32x4*)kp, k1 = *(const f32x4*)(kp + 4);
                u32x4 kw; kw.x = pk2(k0[0], k0[1]); kw.y = pk2(k0[2], k0[3]); kw.z = pk2(k1[0], k1[1]); kw.w = pk2(k1[2], k1[3]);
                acc[kbk] = __builtin_amdgcn_mfma_f32_16x16x32_bf16(__builtin_bit_cast(bf16x8, kw), qf, acc[kbk], 0, 0, 0);
            }
        }
#pragma unroll
        for (int kbk = 0; kbk < 2; ++kbk)
#pragma unroll
            for (int i = 0; i < 4; ++i) PS[fr * 260 + w * 32 + kbk * 16 + 4 * fq + i] = acc[kbk][i];
        __syncthreads();
#pragma unroll
        for (int tt = 0; tt < 2; ++tt) { LAS float* sp = PS + (2 * w + tt) * 260; const f32x4 x = *(LAS f32x4*)(sp + 4 * lane);
            const float mx = wave_max(fmaxf(fmaxf(x[0], x[1]), fmaxf(x[2], x[3])));
            f32x4 e; for (int i = 0; i < 4; ++i) e[i] = __builtin_amdgcn_exp2f(x[i] - mx);
            const float inv = 1.f / wave_sum((e[0] + e[1]) + (e[2] + e[3]));
            for (int i = 0; i < 4; ++i) e[i] = bf2f(f2bf(e[i] * inv));
            *(LAS f32x4*)(sp + 4 * lane) = e; }
        __syncthreads();
        {
            f32x4 acc[16];
#pragma unroll
            for (int t = 0; t < 16; ++t) acc[t] = (f32x4){0.f, 0.f, 0.f, 0.f};
#pragma unroll 1
            for (int jb = 0; jb < 32; jb += 8) {
                f32x4 vv[8];
#pragma unroll
                for (int jj = 0; jj < 8; ++jj) vv[jj] = *(const f32x4*)(mv + (size_t)(w + 8 * (jb + jj)) * 1024 + 4 * lane);
#pragma unroll
                for (int jj = 0; jj < 8; ++jj) { const int key = w + 8 * (jb + jj);
#pragma unroll
                    for (int t = 0; t < 16; ++t) acc[t] += PS[t * 260 + key] * vv[jj]; }
            }
            LAS float* OP = (LAS float*)(lds + 32768);
#pragma unroll
            for (int half = 0; half < 2; ++half) {
#pragma unroll
                for (int tt = 0; tt < 8; ++tt) *(LAS f32x4*)(OP + (w * 8 + tt) * 256 + 4 * lane) = acc[half * 8 + tt];
                __syncthreads();
                f32x4 sum = (f32x4){0.f, 0.f, 0.f, 0.f};
#pragma unroll
                for (int ww = 0; ww < 8; ++ww) sum += *(LAS f32x4*)(OP + (ww * 8 + w) * 256 + 4 * lane);
                st4bf(qx + (srow0 + half * 8 + w) * D + h * 256 + 4 * lane, sum);
                __syncthreads();
            }
        }
    }
    (void)RM;
}

DI void final_norm(int wv, unsigned char* ws, float* out, LAS unsigned char* lds) {
    unsigned z_ = 0u; asm volatile("" : "+v"(z_)); const int tid_ = wv * 64 + (int)__builtin_amdgcn_mbcnt_hi(~0u, __builtin_amdgcn_mbcnt_lo(~0u, z_)); const int tid = tid_, w = __builtin_amdgcn_readfirstlane(tid >> 6), lane = tid & 63, gw = blockIdx.x * 8 + w, NGW = gridDim.x * 8;
    const bf16* xb = (const bf16*)(ws + WS_XB); const float* ss = (const float*)(ws + WS_SS) + (size_t)8 * MT * 16; const float* g = IN(I_FIN);
    f32x4 gv[4];
#pragma unroll
    for (int j = 0; j < 4; ++j) gv[j] = *((const f32x4*)g + lane + 64 * j);
    for (int m = gw; m < MT; m += NGW) {
        const float rs = rsqrtf(ss_row(ss, m) * (1.f / D) + EPS); float* o = out + (m < MP ? O_YP + (size_t)m * D : O_YS + (size_t)(m - MP) * D);
#pragma unroll
        for (int j = 0; j < 4; ++j) { const f32x4 x = ld4bf(xb + (size_t)m * D + 4 * (lane + 64 * j)); *((f32x4*)o + lane + 64 * j) = x * rs * gv[j]; }
    }
}

#ifndef EN
#define EN 0xFFFFF
#endif
#ifndef ONE_LAUNCH
#define ONE_LAUNCH 1
#endif
constexpr int N_PHASES = 24;

template <int NM, int NN, size_t A_M, size_t A_N, size_t B_B, size_t B_N, int BSHIFT, class F>
DI void run_gemm(int wv, LAS unsigned char* lds, int G, int bx, const bf16* A_, int lda, const bf16* Bt, int ldb, int K, const F& f) {
    pg8::Gemm g{A_, Bt, lda, ldb, K, wv}; pg8::Sched<NM, NN, A_M, A_N, B_B, B_N, BSHIFT> Sc; Sc.G = G; Sc.c = bx;
    EpiA<F> E{f};
    pg8::gemm_phase<EpiA<F>, pg8::Sched<NM, NN, A_M, A_N, B_B, B_N, BSHIFT>, true, true>(lds, g, Sc, E);
}
template <int K, int N, class F> DI void prompt_gemm(int wv, LAS unsigned char* lds, int G, int bx, const bf16* A_, const bf16* Bt, const F& f) {
    run_gemm<MP / 256, N / 256, (size_t)256 * K * 2, 0, 0, (size_t)256 * K * 2, 31>(wv, lds, G, bx, A_, K, Bt, K, K, f);
}


#define XB_TMO      128
#define XB_XCNT(j)  (256  + 64 * (j))
#define XB_XSUB(j)  (1280 + 64 * (j))
#define XB_XGEN(j)  (2304 + 64 * (j))
#define XB_TOP      3328
#define XB_TOPGEN   3392
#define XCD_BAR_WORDS 3456
#define XB_SPIN_CAP (1u << 18)
DI unsigned xb_ld(unsigned* p)              { return __hip_atomic_load(p, __ATOMIC_RELAXED, __HIP_MEMORY_SCOPE_AGENT); }
DI unsigned xb_add(unsigned* p, unsigned v) { return __hip_atomic_fetch_add(p, v, __ATOMIC_RELAXED, __HIP_MEMORY_SCOPE_AGENT); }
DI unsigned xb_xcc_id() { return (unsigned)__builtin_amdgcn_s_getreg((3 << 11) | 20) & 0xFu; }
#define XB_SPIN(cond, bar) do { unsigned _sp = 0; while (cond) { __builtin_amdgcn_s_sleep(1); \
    if ((++_sp & 255u) == 0u) { if (xb_ld(&(bar)[XB_TMO])) break; if (_sp > XB_SPIN_CAP) { atomicAdd(&(bar)[XB_TMO], 1u); break; } } } } while (0)
DI void xcd_barrier_complete(unsigned* bar, unsigned x, unsigned G, unsigned& nloc, unsigned& nx) {
    unsigned sum, cnt, mine, sp = 0u;
    for (;;) {
        sum = 0u; cnt = 0u; mine = 0u;
#pragma unroll
        for (unsigned j = 0; j < 16; ++j) { const unsigned c = xb_ld(&bar[XB_XCNT(j)]); sum += c; cnt += (c > 0u) ? 1u : 0u; mine = (j == x) ? c : mine; }
        if (sum == G) break;
        __builtin_amdgcn_s_sleep(1);
        if ((++sp & 255u) == 0u) { if (xb_ld(&bar[XB_TMO])) break; if (sp > XB_SPIN_CAP) { atomicAdd(&bar[XB_TMO], 1u); break; } }
    }
    nloc = mine > 0u ? mine : 1u; nx = cnt > 0u ? cnt : 1u;
}
DI void xcd_barrier(unsigned* bar, volatile LAS unsigned* st, bool first_thread, unsigned G) {
    asm volatile("s_waitcnt vmcnt(0)" ::: "memory");
    __syncthreads();
    if (first_thread) {
        const unsigned x = xb_xcc_id();
        __builtin_amdgcn_s_waitcnt(0);
        unsigned nloc = st[0], nx = st[1];
        if (nloc == 0u) { xcd_barrier_complete(bar, x, G, nloc, nx); st[0] = nloc; st[1] = nx; }
        const unsigned old = xb_add(&bar[XB_XSUB(x)], 1u);
        const unsigned gen = old / nloc;
        if (old + 1u == (gen + 1u) * nloc) {
            __builtin_amdgcn_fence(__ATOMIC_RELEASE, "agent");
            asm volatile("s_waitcnt vmcnt(0)" ::: "memory");
            const unsigned og = xb_add(&bar[XB_TOP], 1u);
            const unsigned tg = og / nx;
            if (og + 1u == (tg + 1u) * nx) xb_add(&bar[XB_TOPGEN], 1u);
            else XB_SPIN(xb_ld(&bar[XB_TOPGEN]) == tg, bar);
            __builtin_amdgcn_fence(__ATOMIC_ACQUIRE, "agent");
            xb_add(&bar[XB_XGEN(x)], 1u);
            asm volatile("s_waitcnt vmcnt(0)" ::: "memory");
        } else {
            XB_SPIN(xb_ld(&bar[XB_XGEN(x)]) == gen, bar);
            __builtin_amdgcn_fence(__ATOMIC_ACQUIRE, "agent");
            asm volatile("s_waitcnt vmcnt(0)" ::: "memory");
        }
    }
    __syncthreads();
}

__global__ void __launch_bounds__(NTHR, 2) fwd_kernel(Args A) {
    extern __shared__ __attribute__((aligned(16))) unsigned char lds_raw[];
    LAS unsigned char* lds = (LAS unsigned char*)lds_raw;
    const int lo = A.ph_lo, hi = A.ph_hi; const int wv = __builtin_amdgcn_readfirstlane((int)threadIdx.x >> 6);
    unsigned char* ws = A.ws; float* out = A.out;
    if (threadIdx.x == 0) { LAS unsigned long long* T = (LAS unsigned long long*)(lds + LDS_TAB);
        T[0] = (unsigned long long)A.in[0];
        T[1] = (unsigned long long)A.in[1];
        T[2] = (unsigned long long)A.in[2];
        T[3] = (unsigned long long)A.in[3];
        T[4] = (unsigned long long)A.in[4];
        T[5] = (unsigned long long)A.in[5];
        T[6] = (unsigned long long)A.in[6];
        T[7] = (unsigned long long)A.in[7];
        T[8] = (unsigned long long)A.in[8];
        T[9] = (unsigned long long)A.in[9];
        T[10] = (unsigned long long)A.in[10];
        T[11] = (unsigned long long)A.in[11];
        T[12] = (unsigned long long)A.in[12];
        T[13] = (unsigned long long)A.in[13];
        T[14] = (unsigned long long)A.in[14];
        T[15] = (unsigned long long)A.in[15];
        T[16] = (unsigned long long)A.in[16];
        T[17] = (unsigned long long)A.in[17];
        T[18] = (unsigned long long)A.in[18];
        T[19] = (unsigned long long)A.in[19];
        T[20] = (unsigned long long)A.in[20];
        T[21] = (unsigned long long)A.in[21];
        T[22] = (unsigned long long)A.in[22];
        T[23] = (unsigned long long)A.in[23];
        T[24] = (unsigned long long)A.in[24];
        T[25] = (unsigned long long)A.in[25];
        T[26] = (unsigned long long)A.in[26];
        T[27] = (unsigned long long)A.in[27];
        T[28] = (unsigned long long)A.in[28];
        T[29] = (unsigned long long)A.in[29];
        T[30] = (unsigned long long)A.in[30];
        T[31] = (unsigned long long)A.in[31];
        T[32] = (unsigned long long)A.in[32];
        T[33] = (unsigned long long)A.in[33];
        *(LAS unsigned*)(lds + LDS_TAB + 384) = 0u; *(LAS unsigned*)(lds + LDS_TAB + 388) = 0u;
        (void)xb_add(&((unsigned*)ws)[XB_XCNT(xb_xcc_id())], 1u);
    }
    __syncthreads();
#ifndef CG_ALL
#define CG_ALL 0
#endif
#define SYNC(ph) do { if ((ph) + 1 < hi) { if (CG_ALL || (ph) == 0) cg::this_grid().sync(); else for (int rb_ = 0; rb_ < (PROBE == 16 ? 2 : 1); ++rb_) { unsigned z2_ = 0u; asm volatile("" : "+v"(z2_)); const bool ft_ = wv == 0 && __builtin_amdgcn_mbcnt_hi(~0u, __builtin_amdgcn_mbcnt_lo(~0u, z2_)) == 0u; xcd_barrier((unsigned*)ws, (volatile LAS unsigned*)(lds + LDS_TAB + 384), ft_, gridDim.x); } } } while (0)
    if (lo == 0) { if (EN & 0x10000) prologue(wv, ws, out, lds); __syncthreads();
#if PROBE == 3
        prologue(wv, ws, out, lds); __syncthreads();
#endif
        SYNC(0); }
    for (int ph = (lo > 1 ? lo : 1); ph < (hi < N_PHASES - 1 ? hi : N_PHASES - 1); ++ph) {
        int G = gridDim.x, bx = blockIdx.x; asm volatile("" : "+s"(G), "+s"(bx), "+s"(out));
        const int smp_c0 = (bx + G / 2) % G;
        const int l = (ph - 1) / 11, k = (ph - 1) % 11;
        asm volatile("" : "+s"(ws));
        unsigned char* R = ws + WS_R; bf16* xb = (bf16*)(ws + WS_XB); float* ss = (float*)(ws + WS_SS); bf16* hb = (bf16*)(R + R_H);
        unsigned char* wl = ws + WS_W + (size_t)l * LW;
        float* ssl = ss + (size_t)(4 * l) * MT * 16;
        if (!((EN >> k) & 1)) continue;
        switch (k) {
        case 0: case 9: {
            const bool second = k == 9;
            FUp f{ssl + (second ? 3 : 0) * (size_t)MT * 16, hb, (LAS float*)(lds + LDS_EPI)};
#if PROBE == 11
            { FUpCheap f0{hb}; prompt_gemm<D, 2 * FF>(wv, lds, G, bx, xb, (const bf16*)(wl + (second ? W_2 : W_1)), f0); __syncthreads(); }
#endif
            prompt_gemm<D, 2 * FF>(wv, lds, G, bx, xb, (const bf16*)(wl + (second ? W_2 : W_1)), f);
#if PROBE == 1
            __syncthreads(); prompt_gemm<D, 2 * FF>(wv, lds, G, bx, xb, (const bf16*)(wl + (second ? W_2 : W_1)), f);
#endif
            __syncthreads();
            sample_gemm_wide(wv, lds, xb, (const bf16*)(wl + (second ? W_2 : W_1)), 2 * FF / 256, f, G, smp_c0);
        } break;
        case 1: case 10: {
            const bool second = k == 10;
            FRes f{xb, ssl + (second ? 4 : 1) * (size_t)MT * 16, 0.5f};
#if PROBE == 4
            { FRes f0{xb, ssl + (second ? 4 : 1) * (size_t)MT * 16, 0.0f}; prompt_gemm<FF, D>(wv, lds, G, bx, hb, (const bf16*)(wl + (second ? W_D2 : W_D1)), f0); __syncthreads(); }
#endif
            prompt_gemm<FF, D>(wv, lds, G, bx, hb, (const bf16*)(wl + (second ? W_D2 : W_D1)), f);
            __syncthreads();
            sample_gemm<FF>(wv, lds, hb, FF, (const bf16*)(wl + (second ? W_D2 : W_D1)), FF, D / 256, f, G, smp_c0);
        } break;
        case 2: {
            FWin f{ssl + (size_t)MT * 16, ws, out, l, (LAS float*)(lds + LDS_EPI)};
            prompt_gemm<D, 2048>(wv, lds, G, bx, xb, (const bf16*)(wl + W_IN), f);
#if PROBE == 8
            __syncthreads(); prompt_gemm<D, 2048>(wv, lds, G, bx, xb, (const bf16*)(wl + W_IN), f);
#endif
            __syncthreads();
            sample_gemm_wide(wv, lds, xb, (const bf16*)(wl + W_IN), 8, f, G, smp_c0);
        } break;
        case 3: {
            mixer_phase(wv, ws, out, l, lds, G, bx);
            __syncthreads();
            FMemKV f{out + O_MK + (size_t)l * 512 * D, out + O_MV + (size_t)l * 512 * D, (bf16*)(ws + WS_MKB) + (size_t)l * 512 * D, (bf16*)(ws + WS_MVT) + (size_t)l * 8 * 65536};
            run_gemm<2, 8, (size_t)256 * D * 2, 0, 0, (size_t)256 * D * 2, 31>(wv, lds, G, bx, (const bf16*)(ws + WS_MN), D, (const bf16*)(wl + W_KV), D, D, f);
            __syncthreads();
        }
#if PROBE == 2
            __syncthreads(); mixer_phase(wv, ws, out, l, lds, G, bx);
#endif
            break;
        case 4: case 8: {
            const bool xo = k == 8;
            FRes f{xb, ssl + (xo ? 3 : 2) * (size_t)MT * 16, 1.0f};
            const bf16* Ain = xo ? (const bf16*)(R + R_QX) : (const bf16*)(R + R_YMIX);
            prompt_gemm<D, D>(wv, lds, G, bx, Ain, (const bf16*)(wl + (xo ? W_O : W_OUT)), f);
            __syncthreads();
            sample_gemm<D>(wv, lds, Ain, D, (const bf16*)(wl + (xo ? W_O : W_OUT)), D, 4, f, G, smp_c0);
        } break;
        case 5: {
            FScale f{ssl + 2 * (size_t)MT * 16, (bf16*)(R + R_QX), 0.0625f * LOG2E, (LAS float*)(lds + LDS_EPI)};
            prompt_gemm<D, D>(wv, lds, G, bx, xb, (const bf16*)(wl + W_Q), f);
#if PROBE == 5
            __syncthreads(); prompt_gemm<D, D>(wv, lds, G, bx, xb, (const bf16*)(wl + W_Q), f);
#endif
            __syncthreads();
            sample_gemm<D>(wv, lds, xb, D, (const bf16*)(wl + W_Q), D, 4, f, G, smp_c0);
#if PROBE == 10
            sample_gemm<D>(wv, lds, xb, D, (const bf16*)(wl + W_Q), D, 4, f, G, smp_c0);
#endif
        } break;
        case 6: {
            pg8::Gemm g{(const bf16*)(R + R_QX), (const bf16*)(ws + WS_MKB) + (size_t)l * 512 * D, D, D, 256, wv};
            typedef pg8::Sched<MP / 256, 4, (size_t)256 * D * 2, 512, (size_t)256 * D * 2, 512, 6> SchS; SchS Sc; Sc.G = G; Sc.c = bx;
            EpiS E{(bf16*)(R + R_P), (float*)(ws + WS_LINV), (LAS float*)(lds + LDS_EPI)};
            pg8::gemm_phase<EpiS, SchS, true, true>(lds, g, Sc, E);
#if PROBE == 9
            __syncthreads(); pg8::gemm_phase<EpiS, SchS, true, true>(lds, g, Sc, E);
#endif
            __syncthreads();
            xattn_sample(wv, ws, out, l, lds, G, bx);
            asm volatile("s_waitcnt vmcnt(0)" ::: "memory"); __syncthreads();
            FPV f{(const float*)(ws + WS_LINV), (bf16*)(R + R_QX)};
            run_gemm<MP / 256, 4, (size_t)256 * D * 2, 512, (size_t)4 * 65536 * 2, (size_t)65536 * 2, 6>(wv, lds, G, bx, (const bf16*)(ws + WS_R + R_P), D, (const bf16*)(ws + WS_MVT) + (size_t)l * 8 * 65536, 256, 256, f);
#if PROBE == 9
            __syncthreads();
            run_gemm<MP / 256, 4, (size_t)256 * D * 2, 512, (size_t)4 * 65536 * 2, (size_t)65536 * 2, 6>(wv, lds, G, bx, (const bf16*)(ws + WS_R + R_P), D, (const bf16*)(ws + WS_MVT) + (size_t)l * 8 * 65536, 256, 256, f);
#endif
        } break;
        case 7: break;
        }
        __syncthreads();
        if (k != 6) SYNC(ph);
    }
    if (hi == N_PHASES) { if (EN & 0x20000) final_norm(wv, ws, out, lds); }
#undef SYNC
}

extern "C" void kernel_launch(void* const* d_in, const int* in_sizes, int n_in, void* d_out, int out_size, void* d_ws, size_t ws_size, hipStream_t stream) {
    static int grid = 0;
    if (grid == 0) {
        if (n_in != 34 || (size_t)out_size != O_END || ws_size < WS_END) { fprintf(stderr, "kernel_launch: unexpected shapes n_in %d out %d ws %zu (need %zu)\n", n_in, out_size, ws_size, (size_t)WS_END); grid = -1; return; }
        int dev = 0, cus = 0, per_cu = 0;
        hipGetDevice(&dev); hipDeviceGetAttribute(&cus, hipDeviceAttributeMultiprocessorCount, dev);
        if (hipFuncSetAttribute((const void*)fwd_kernel, hipFuncAttributeMaxDynamicSharedMemorySize, LDS_BYTES) != hipSuccess) { fprintf(stderr, "kernel_launch: hipFuncSetAttribute failed\n"); grid = -1; return; }
        if (hipOccupancyMaxActiveBlocksPerMultiprocessor(&per_cu, (const void*)fwd_kernel, NTHR, LDS_BYTES) != hipSuccess || per_cu < 1) { fprintf(stderr, "kernel_launch: occupancy query says %d\n", per_cu); per_cu = 1; }
        (void)hipGetLastError();
        grid = cus;
    }
    if (grid < 0) return;
    Args a{};
    for (int i = 0; i < 34; ++i) a.in[i] = (const float*)d_in[i];
    a.out = (float*)d_out; a.ws = (unsigned char*)d_ws;
    if (hipMemsetAsync(d_ws, 0, 16384, stream) != hipSuccess) { fprintf(stderr, "kernel_launch: memset failed\n"); return; }
#if ONE_LAUNCH
    a.ph_lo = 0; a.ph_hi = N_PHASES;
    void* args[] = {&a};
    hipError_t e = hipLaunchCooperativeKernel((const void*)fwd_kernel, dim3(grid), dim3(NTHR), args, LDS_BYTES, stream);
    if (e != hipSuccess) fprintf(stderr, "cooperative launch failed: %s (grid %d)\n", hipGetErrorString(e), grid);
#else
    for (int ph = 0; ph < N_PHASES; ++ph) { a.ph_lo = ph; a.ph_hi = ph + 1; hipLaunchKernelGGL(fwd_kernel, dim3(grid), dim3(NTHR), LDS_BYTES, stream, a); }
#endif
}
```

```cpp
#include <hip/hip_runtime.h>
#include <hip/hip_cooperative_groups.h>
#include <cstdio>
#include <cstdint>
namespace cg = cooperative_groups;
#ifndef PROBE
#define PROBE 0
#endif
namespace pg8 {
#define PG8_LAS __attribute__((address_space(3)))
typedef unsigned short bf16_t;
typedef short bf16x8 __attribute__((ext_vector_type(8)));
typedef float f32x4 __attribute__((ext_vector_type(4)));
typedef unsigned u32x4 __attribute__((ext_vector_type(4)));
constexpr int BM = 256, BK = 64, HALF = 128, HTB = HALF * BK * 2  , STAGE_BYTES = 8 * HTB, NXCD = 8, WGM = 8;

__host__ __device__ __forceinline__ int lds_byte(int r, int c) { const int st = (r >> 4) * 2 + (c >> 5), rr = r & 15, cc = c & 31, ob = rr * 64 + cc * 2; return st * 1024 + (ob ^ (((ob >> 9) & 1) << 5)); }
__host__ __device__ __forceinline__ void stage_rc(int b, int& R, int& C) { const int st = b / 1024, sb = b % 1024, swz = sb ^ (((sb >> 9) & 1) << 5); R = (st >> 1) * 16 + swz / 64; C = (st & 1) * 32 + (swz % 64) / 2; }
__host__ __device__ __forceinline__ int perm32(int rho) { const int n = rho >> 4, i = rho & 15; return 8 * (i >> 2) + 4 * n + (i & 3); }


struct Unit { int pm, pn; size_t aoff, boff; int npm, par; };
struct Gemm { const bf16_t* A; const bf16_t* Bt; int lda, ldb, K, wv; };

template <int NM, int NN, size_t A_M, size_t A_N, size_t B_B, size_t B_N, int BSHIFT> struct Sched {
    int G, c;
    __device__ bool next(int i, Unit& u) const {
        constexpr int nwg = NM * NN;
        const long L = (long)i * G + c; if (L >= nwg) return false;
        int wgid = (int)L; { constexpr int q = nwg / NXCD, r = nwg % NXCD; const int xcd = wgid % NXCD, off = wgid / NXCD; wgid = (xcd < r ? xcd * (q + 1) : r * (q + 1) + (xcd - r) * q) + off; }
        constexpr int nig = WGM * NN; const int gid = wgid / nig, fm = gid * WGM, gsz = (NM - fm) < WGM ? (NM - fm) : WGM;
        u.pm = fm + ((wgid % nig) % gsz); u.pn = (wgid % nig) / gsz;
        u.aoff = (size_t)u.pm * A_M + (size_t)u.pn * A_N; u.boff = (size_t)(u.pm >> BSHIFT) * B_B + (size_t)u.pn * B_N; return true;
    }
    __device__ __forceinline__ void a_ready(const Unit&) const {}
    __device__ __forceinline__ void done(const Unit&) const {}
};
template <class Epi, class Sched, bool ALIGN_EPI = false, bool SP2 = false>
__device__ __forceinline__ void gemm_phase(PG8_LAS unsigned char* lds, const Gemm g, const Sched& S, const Epi& E) {
    unsigned z_ = 0u; asm volatile("" : "+v"(z_)); const int tid_ = g.wv * 64 + (int)__builtin_amdgcn_mbcnt_hi(~0u, __builtin_amdgcn_mbcnt_lo(~0u, z_)); const int tid = tid_, wid = __builtin_amdgcn_readfirstlane(tid >> 6), lane = tid & 63, wr = wid >> 2, wc = wid & 3, fr = lane & 15, fq = lane >> 4;
    const int K = g.K, nt = K / BK;
    unsigned voffA[2], voffB[2];
#pragma unroll
    for (int i = 0; i < 2; ++i) { int R, C; stage_rc(tid * 16 + i * 8192, R, C); const int Rb = Epi::PERM ? ((R & ~31) + perm32(R & 31)) : R;
        voffA[i] = (unsigned)(R * g.lda + C) * 2u; voffB[i] = (unsigned)(Rb * g.ldb + C) * 2u; }
    const size_t kstep = (size_t)(BK * 2);
    const size_t hstepA = (size_t)HALF * g.lda * 2, hstepB = (size_t)HALF * g.ldb * 2;
    const unsigned ldsw = (unsigned)wid * 1024u;
    const int aoff = lds_byte(wr * 64 + fr, fq * 8), boff = lds_byte(wc * 32 + fr, fq * 8);
#define PG8_SA(b, h) (((b) * 2 + (h)) * HTB)
#define PG8_SB(b, h) ((4 + (b) * 2 + (h)) * HTB)
#define PG8_STAGE(bufoff, gbase, voff) do { _Pragma("unroll") for (int _i = 0; _i < 2; ++_i) \
        __builtin_amdgcn_global_load_lds((const unsigned*)((const char*)(gbase) + (voff)[_i]), (PG8_LAS unsigned*)(lds + (bufoff) + ldsw + _i * 8192), 16, 0, 0); } while (0)
#define PG8_LDA(dst, b, h) do { _Pragma("unroll") for (int m = 0; m < 4; ++m) _Pragma("unroll") for (int k = 0; k < 2; ++k) dst[m][k] = *(const PG8_LAS bf16x8*)(lds + PG8_SA(b, h) + aoff + m * 2048 + k * 1024); } while (0)
#define PG8_LDB(dst, b, h) do { _Pragma("unroll") for (int n = 0; n < 2; ++n) _Pragma("unroll") for (int k = 0; k < 2; ++k) dst[n][k] = *(const PG8_LAS bf16x8*)(lds + PG8_SB(b, h) + boff + n * 2048 + k * 1024); } while (0)
#define PG8_MMA(ai, bj, At, Bt) do { __builtin_amdgcn_s_setprio(1); _Pragma("unroll") for (int m = 0; m < 4; ++m) _Pragma("unroll") for (int n = 0; n < 2; ++n) _Pragma("unroll") for (int k = 0; k < 2; ++k) \
        acc[ai][bj][m][n] = __builtin_amdgcn_mfma_f32_16x16x32_bf16(Bt[n][k], At[m][k], acc[ai][bj][m][n], 0, 0, 0); __builtin_amdgcn_s_setprio(0); } while (0)
#define PG8_WAIT_V(n) asm volatile("s_waitcnt vmcnt(" #n ")" ::: "memory")
#define PG8_WAIT_L(n) asm volatile("s_waitcnt lgkmcnt(" #n ")" ::: "memory")
#define PG8_BAR __builtin_amdgcn_s_barrier()
#define PG8_SCHED __builtin_amdgcn_sched_barrier(0)
    Unit cur, nxt; int ui = 0;
    if (!S.next(0, cur)) return;
    f32x4 acc[2][2][4][2];
#pragma unroll
    for (int a = 0; a < 2; ++a)
#pragma unroll
        for (int b = 0; b < 2; ++b)
#pragma unroll
            for (int m = 0; m < 4; ++m)
#pragma unroll
                for (int n = 0; n < 2; ++n) acc[a][b][m][n] = (f32x4){0.f, 0.f, 0.f, 0.f};
    bf16x8 At[4][2], B0[2][2], B1[2][2];
    const char* cA = (const char*)g.A + cur.aoff; const char* cB = (const char*)g.Bt + cur.boff;
    S.a_ready(cur);
    if constexpr (SP2) {
        PG8_STAGE(PG8_SB(0, 0), cB, voffB); PG8_STAGE(PG8_SB(0, 1), cB + hstepB, voffB); PG8_STAGE(PG8_SA(0, 0), cA, voffA); PG8_STAGE(PG8_SA(0, 1), cA + hstepA, voffA);
        if (wr == 1) PG8_BAR;
        PG8_WAIT_V(2); PG8_BAR;
        PG8_STAGE(PG8_SB(1, 0), cB + kstep, voffB); PG8_STAGE(PG8_SA(1, 0), cA + kstep, voffA); PG8_STAGE(PG8_SB(1, 1), cB + hstepB + kstep, voffB);
        PG8_WAIT_V(6); PG8_BAR;
    } else {
        PG8_STAGE(PG8_SB(0, 0), cB, voffB); PG8_STAGE(PG8_SA(0, 0), cA, voffA); PG8_STAGE(PG8_SB(0, 1), cB + hstepB, voffB); PG8_STAGE(PG8_SA(0, 1), cA + hstepA, voffA);
        if (wr == 1) PG8_BAR;
        PG8_WAIT_V(4); PG8_BAR;
        PG8_STAGE(PG8_SB(1, 0), cB + kstep, voffB); PG8_STAGE(PG8_SA(1, 0), cA + kstep, voffA); PG8_STAGE(PG8_SB(1, 1), cB + hstepB + kstep, voffB);
        PG8_WAIT_V(6); PG8_BAR;
    }
    for (;;) {
        const bool has_next = S.next(ui + 1, nxt);
        const char* nA = has_next ? (const char*)g.A + nxt.aoff : cA; const char* nB = has_next ? (const char*)g.Bt + nxt.boff : cB;
#pragma unroll 1
        for (int t = 0; t < nt; t += 2) {
            const bool last = (t == nt - 2);
            const char* a1 = cA + (size_t)(t + 1) * kstep;
            const char* a2 = last ? nA : cA + (size_t)(t + 2) * kstep; const char* b2 = last ? nB : cB + (size_t)(t + 2) * kstep;
            const char* a3 = a2 + kstep; const char* b3 = b2 + kstep;
            if (last && has_next) S.a_ready(nxt);
            if constexpr (SP2) {
            PG8_LDB(B0, 0, 0); PG8_LDB(B1, 0, 1); PG8_SCHED; PG8_LDA(At, 0, 0); PG8_STAGE(PG8_SA(1, 1), a1 + hstepA, voffA);
            PG8_WAIT_V(8); PG8_WAIT_L(0); PG8_BAR; PG8_MMA(0, 0, At, B0); PG8_MMA(0, 1, At, B1); PG8_BAR; PG8_SCHED;
            PG8_LDA(At, 0, 1); PG8_STAGE(PG8_SB(0, 0), b2, voffB); PG8_STAGE(PG8_SB(0, 1), b2 + hstepB, voffB); PG8_STAGE(PG8_SA(0, 0), a2, voffA);
            PG8_WAIT_V(8); PG8_WAIT_L(0); PG8_BAR; PG8_MMA(1, 0, At, B0); PG8_MMA(1, 1, At, B1); PG8_BAR; PG8_SCHED;
            PG8_LDB(B0, 1, 0); PG8_LDB(B1, 1, 1); PG8_SCHED; PG8_LDA(At, 1, 0); PG8_STAGE(PG8_SA(0, 1), a2 + hstepA, voffA);
            PG8_WAIT_V(8); PG8_WAIT_L(0); PG8_BAR; PG8_MMA(0, 0, At, B0); PG8_MMA(0, 1, At, B1); PG8_BAR; PG8_SCHED;
            PG8_LDA(At, 1, 1); PG8_STAGE(PG8_SB(1, 0), b3, voffB); PG8_STAGE(PG8_SB(1, 1), b3 + hstepB, voffB); PG8_STAGE(PG8_SA(1, 0), a3, voffA);
            PG8_WAIT_V(8); PG8_WAIT_L(0); PG8_BAR; PG8_MMA(1, 0, At, B0); PG8_MMA(1, 1, At, B1); PG8_BAR; PG8_SCHED;
            } else {
            PG8_LDB(B0, 0, 0); PG8_SCHED; PG8_LDA(At, 0, 0); PG8_STAGE(PG8_SA(1, 1), a1 + hstepA, voffA);
            PG8_WAIT_L(8); PG8_BAR; PG8_WAIT_L(0); PG8_MMA(0, 0, At, B0); PG8_BAR; PG8_SCHED;
            PG8_LDB(B1, 0, 1); PG8_STAGE(PG8_SB(0, 0), b2, voffB);
            PG8_BAR; PG8_WAIT_L(0); PG8_MMA(0, 1, At, B1); PG8_BAR;
            PG8_LDA(At, 0, 1); PG8_STAGE(PG8_SA(0, 0), a2, voffA);
            PG8_BAR; PG8_WAIT_L(0); PG8_MMA(1, 0, At, B0); PG8_BAR; PG8_SCHED;
            PG8_STAGE(PG8_SB(0, 1), b2 + hstepB, voffB);
            PG8_WAIT_V(6); PG8_BAR; PG8_MMA(1, 1, At, B1); PG8_BAR;
            PG8_LDB(B0, 1, 0); PG8_SCHED; PG8_LDA(At, 1, 0); PG8_STAGE(PG8_SA(0, 1), a2 + hstepA, voffA);
            PG8_WAIT_L(8); PG8_BAR; PG8_WAIT_L(0); PG8_MMA(0, 0, At, B0); PG8_BAR; PG8_SCHED;
            PG8_LDB(B1, 1, 1); PG8_STAGE(PG8_SB(1, 0), b3, voffB);
            PG8_BAR; PG8_WAIT_L(0); PG8_MMA(0, 1, At, B1); PG8_BAR;
            PG8_LDA(At, 1, 1); PG8_STAGE(PG8_SA(1, 0), a3, voffA);
            PG8_BAR; PG8_WAIT_L(0); PG8_MMA(1, 0, At, B0); PG8_BAR; PG8_SCHED;
            PG8_STAGE(PG8_SB(1, 1), b3 + hstepB, voffB);
            PG8_WAIT_V(6); PG8_BAR; PG8_MMA(1, 1, At, B1); PG8_BAR;
            }
        }
        if constexpr (ALIGN_EPI) { if (wr == 0) PG8_BAR; }
        if constexpr (!Epi::AFTER_DRAIN) { E(acc, cur, wr, wc, fr, fq); S.done(cur); }
        if (!has_next) break;
#pragma unroll
        for (int a = 0; a < 2; ++a)
#pragma unroll
            for (int b = 0; b < 2; ++b)
#pragma unroll
                for (int m = 0; m < 4; ++m)
#pragma unroll
                    for (int n = 0; n < 2; ++n) acc[a][b][m][n] = (f32x4){0.f, 0.f, 0.f, 0.f};
        cur = nxt; cA = nA; cB = nB; ++ui;
        if constexpr (ALIGN_EPI) { if (wr == 1) PG8_BAR; }
    }
    PG8_WAIT_V(0);
    if constexpr (!ALIGN_EPI) { if (wr == 0) PG8_BAR; }
    PG8_BAR;
    if constexpr (Epi::AFTER_DRAIN) { E.fused(acc, cur, wr, wc, fr, fq, lds, wid, lane); S.done(cur); }
#undef PG8_SA
#undef PG8_SB
#undef PG8_STAGE
#undef PG8_LDA
#undef PG8_LDB
#undef PG8_MMA
#undef PG8_WAIT_V
#undef PG8_WAIT_L
#undef PG8_BAR
#undef PG8_SCHED
}}

#define DI __device__ __forceinline__
#define LAS __attribute__((address_space(3)))
typedef unsigned short bf16;
typedef short bf16x8 __attribute__((ext_vector_type(8)));
typedef float f32x4 __attribute__((ext_vector_type(4)));
typedef float f32x16 __attribute__((ext_vector_type(16)));
typedef unsigned u32x4 __attribute__((ext_vector_type(4)));
typedef unsigned u32x2 __attribute__((ext_vector_type(2)));
typedef __bf16 bf16x2_t __attribute__((ext_vector_type(2)));
typedef float f32x2_t __attribute__((ext_vector_type(2)));
using pg8::Unit;

constexpr int D = 1024, S = 16384, NB = 2, MP = NB * S, MS = 256, MT = MP + MS, FF = 2816, NL = 2, NTHR = 512;
constexpr float EPS = 1e-6f, LOG2E = 1.4426950408889634f;
constexpr size_t MiB = 1u << 20;
constexpr size_t WS_SS_OLD = 0;
constexpr size_t WS_LINV = 2 * MiB;
constexpr size_t WS_ROPE = 3 * MiB;
constexpr size_t WS_MN = 7 * MiB;
constexpr size_t WS_MKB = 8 * MiB;
constexpr size_t WS_MVT = 10 * MiB;
constexpr size_t WS_W = 12 * MiB, LW = 47 * MiB;
constexpr size_t W_1 = 0, W_D1 = 11 * MiB, W_IN = W_D1 + 11 * MiB / 2, W_OUT = W_IN + 4 * MiB, W_Q = W_OUT + 2 * MiB, W_O = W_Q + 2 * MiB, W_2 = W_O + 2 * MiB, W_D2 = W_2 + 11 * MiB, W_KV = W_D2 + 11 * MiB / 2;
static_assert(W_KV + 4 * MiB == LW, "weights map");
constexpr size_t WS_XB = WS_W + 2 * LW;
constexpr size_t WS_R = WS_XB + 65 * MiB;
constexpr size_t R_H = 0;
constexpr size_t R_GB = 0, R_CV = R_GB + (size_t)MT * 256 * 2, R_Q = R_CV + (size_t)MT * 256 * 2, R_K = R_Q + (size_t)MT * 512 * 2, R_VT = R_K + (size_t)MT * 128 * 2,
                 R_VS = R_VT + (size_t)NB * 128 * S * 2, R_GLU = R_VS + (size_t)MS * 128 * 2, R_YMIX = 101 * MiB;
static_assert(R_GLU + (size_t)MT * 256 * 2 <= R_YMIX, "R map");
constexpr size_t R_QX = 0, R_P = 68 * MiB;
constexpr size_t WS_SS = WS_R + 178 * MiB;
constexpr size_t WS_END = WS_SS + 19 * MiB;
static_assert((size_t)9 * MT * 64 <= 19 * MiB, "ss");
static_assert((size_t)MT * FF * 2 <= 178 * MiB && (size_t)MT * D * 2 <= 65 * MiB, "sizes");
constexpr size_t O_YP = 0, O_YS = O_YP + (size_t)MP * D, O_KP = O_YS + (size_t)MS * D, O_VP = O_KP + 65536, O_AP = O_VP + 65536, O_CP = O_AP + 2048, O_MK = O_CP + 30720,
                 O_MV = O_MK + 1048576, O_KS = O_MV + 1048576, O_VS = O_KS + 65536, O_AS = O_VS + 65536, O_CS = O_AS + 16384, O_END = O_CS + 245760;
constexpr int LDS_BYTES = 162816, LDS_EPI = 131072, LDS_TAB = 162816 - 512;

struct Args { const float* in[34]; float* out; unsigned char* ws; int ph_lo, ph_hi; };
enum { I_XP = 0, I_XS, I_CK, I_CV, I_SA, I_SC, I_MK, I_MV, I_MEM, I_F1N, I_F1G, I_F1U, I_F1D, I_MIXN, I_WIN, I_CAW, I_SINK, I_CCW, I_CCB, I_LNG, I_LNB, I_MON, I_WOUT,
       I_XAN, I_MEMN, I_WQ, I_WK, I_WV, I_WO, I_F2N, I_F2G, I_F2U, I_F2D, I_FIN };

DI const float* tab_ptr(LAS unsigned char* lds, int idx) { const u32x2 v = *((const LAS u32x2*)(lds + LDS_TAB) + idx); const unsigned lo = __builtin_amdgcn_readfirstlane(v.x), hi = __builtin_amdgcn_readfirstlane(v.y); return (const float*)(((unsigned long long)hi << 32) | lo); }
#define IN(idx) tab_ptr(lds, idx)
DI float ss_row(const float* ss, int row) { const f32x4* p = (const f32x4*)(ss + (size_t)row * 16); const f32x4 a = p[0], b = p[1], c = p[2], d = p[3]; return (((a[0] + a[1]) + (a[2] + a[3])) + ((b[0] + b[1]) + (b[2] + b[3]))) + (((c[0] + c[1]) + (c[2] + c[3])) + ((d[0] + d[1]) + (d[2] + d[3]))); }
DI float bf2f(unsigned short b) { return __uint_as_float((unsigned)b << 16); }
DI unsigned pk2(float lo, float hi) { f32x2_t v = {lo, hi}; bf16x2_t b = __builtin_convertvector(v, bf16x2_t); return __builtin_bit_cast(unsigned, b); }
DI bf16 f2bf(float f) { return (bf16)(pk2(f, 0.f) & 0xffffu); }
DI void st4bf(bf16* p, f32x4 v) { u32x2 w; w.x = pk2(v[0], v[1]); w.y = pk2(v[2], v[3]); *(u32x2*)p = w; }
DI f32x4 unpk4(u32x2 w) { return (f32x4){__uint_as_float(w.x << 16), __uint_as_float(w.x & 0xffff0000u), __uint_as_float(w.y << 16), __uint_as_float(w.y & 0xffff0000u)}; }
DI f32x4 ld4bf(const bf16* p) { return unpk4(*(const u32x2*)p); }
DI void st8bf(bf16* p, f32x4 a, f32x4 b) { u32x4 w; w.x = pk2(a[0], a[1]); w.y = pk2(a[2], a[3]); w.z = pk2(b[0], b[1]); w.w = pk2(b[2], b[3]); *(u32x4*)p = w; }
DI float dpp_f(float v, const int ctrl_tag);
template <int CTRL> DI float dppx(float v) { return __builtin_bit_cast(float, __builtin_amdgcn_update_dpp(0, __builtin_bit_cast(int, v), CTRL, 0xf, 0xf, true)); }
DI float wave_sum(float v) {
    v += dppx<0xB1>(v); v += dppx<0x4E>(v); v += dppx<0x141>(v); v += dppx<0x140>(v);
    const float a = __builtin_bit_cast(float, __builtin_amdgcn_readlane(__builtin_bit_cast(int, v), 0)), b = __builtin_bit_cast(float, __builtin_amdgcn_readlane(__builtin_bit_cast(int, v), 16)),
                c = __builtin_bit_cast(float, __builtin_amdgcn_readlane(__builtin_bit_cast(int, v), 32)), d = __builtin_bit_cast(float, __builtin_amdgcn_readlane(__builtin_bit_cast(int, v), 48));
    return (a + b) + (c + d);
}
DI float wave_max(float v) {
#pragma unroll
    for (int o = 1; o < 64; o <<= 1) v = fmaxf(v, __shfl_xor(v, o));
    return v;
}
DI float sigmoidf_(float x) { return __builtin_amdgcn_rcpf(1.f + __builtin_amdgcn_exp2f(-LOG2E * x)); }
#define LDS_WAIT() asm volatile("s_waitcnt lgkmcnt(0)" ::: "memory")
#define EPI_BAR() do { asm volatile("s_waitcnt lgkmcnt(0)" ::: "memory"); __builtin_amdgcn_s_barrier(); asm volatile("" ::: "memory"); } while (0)

template <class F> struct EpiA {
    static constexpr bool PERM = F::PERM, AFTER_DRAIN = false; F f;
    template <int KIND> DI void body(const f32x4 (&acc)[2][2][4][2], const Unit& u, int wr, int wc, int fr, int fq) const {
#pragma unroll
        for (int ai = 0; ai < 2; ++ai)
#pragma unroll
            for (int m = 0; m < 4; ++m) {
                const int lr = ai * 128 + wr * 64 + m * 16 + fr, row = u.pm * 256 + lr; typename F::Row rc; f.row_begin(rc, row, u.pn, lr);
                if constexpr (F::PERM) f.template apply8<KIND>(rc, row, u.pn, wc * 32 + fq * 8, acc[ai][0][m][0], acc[ai][0][m][1], acc[ai][1][m][0], acc[ai][1][m][1]);
                else {
#pragma unroll
                for (int n = 0; n < 2; ++n) f.template apply<KIND>(rc, row, u.pn, wc * 32 + n * 16 + fq * 4, acc[ai][0][m][n], acc[ai][1][m][n]); }
                f.row_end(rc, row, u.pn, fq, wc);
            }
    }
    DI void operator()(const f32x4 (&acc)[2][2][4][2], const Unit& u, int wr, int wc, int fr, int fq) const {
        asm volatile("" : "+v"(fr), "+v"(fq));
        if constexpr (F::USE_SS) {
            const int t = (wr * 4 + wc) * 64 + fq * 16 + fr;
            if (t < 256) f.rsl[t] = rsqrtf(ss_row(f.ss, u.pm * 256 + t) * (1.f / D) + EPS);
            EPI_BAR();
        }
        if constexpr (F::NKIND == 1) body<0>(acc, u, wr, wc, fr, fq);
        else { const int kd = f.kind(u.pn);
            if (kd == 0) body<0>(acc, u, wr, wc, fr, fq); else if (kd == 1) body<1>(acc, u, wr, wc, fr, fq);
            else if constexpr (F::NKIND > 2) { if (kd == 2) body<2>(acc, u, wr, wc, fr, fq); else if (kd == 3) body<3>(acc, u, wr, wc, fr, fq); else body<4>(acc, u, wr, wc, fr, fq); } }    }
};
template <class F> DI void apply_two(const F& f, int row, int pn, int c, const f32x4 (&v0)[2], const f32x4 (&v1)[2], int fq, int sub) {
    typename F::Row rc; f.row_begin(rc, row, pn, -1);
#pragma unroll
    for (int wb = 0; wb < 2; ++wb) {
        if constexpr (F::NKIND == 1) f.template apply<0>(rc, row, pn, c + wb * 16, v0[wb], v1[wb]);
        else { const int kd = f.kind(pn);
            if (kd == 0) f.template apply<0>(rc, row, pn, c + wb * 16, v0[wb], v1[wb]); else if (kd == 1) f.template apply<1>(rc, row, pn, c + wb * 16, v0[wb], v1[wb]);
            else if constexpr (F::NKIND > 2) { if (kd == 2) f.template apply<2>(rc, row, pn, c + wb * 16, v0[wb], v1[wb]); else if (kd == 3) f.template apply<3>(rc, row, pn, c + wb * 16, v0[wb], v1[wb]); else f.template apply<4>(rc, row, pn, c + wb * 16, v0[wb], v1[wb]); } }
    }
    f.row_end(rc, row, pn, fq, sub);
}

struct FUp {
    static constexpr int NKIND = 1; static constexpr bool USE_SS = true, PERM = true; const float* ss; bf16* h; LAS float* rsl;
    struct Row { float rs; };
    DI void row_begin(Row& rc, int row, int, int lr) const { rc.rs = lr >= 0 ? rsl[lr] : rsqrtf(ss_row(ss, row) * (1.f / D) + EPS); }
    template <int> DI void apply(const Row& rc, int row, int pn, int c, f32x4 v0, f32x4 v1) const {
        f32x4 o;
#pragma unroll
        for (int e = 0; e < 4; ++e) { const float g = v0[e] * rc.rs, u = v1[e] * rc.rs; o[e] = g * sigmoidf_(g) * u; }
        st4bf(h + (size_t)row * FF + pn * 128 + c, o);
    }
    template <int> DI void apply8(const Row& rc, int row, int pn, int c, f32x4 g0, f32x4 g1, f32x4 u0, f32x4 u1) const {
        f32x4 o0, o1;
#pragma unroll
        for (int e = 0; e < 4; ++e) { const float ga = g0[e] * rc.rs, gb = g1[e] * rc.rs; o0[e] = ga * sigmoidf_(ga) * (u0[e] * rc.rs); o1[e] = gb * sigmoidf_(gb) * (u1[e] * rc.rs); }
        st8bf(h + (size_t)row * FF + pn * 128 + c, o0, o1);
    }
    DI void row_end(const Row&, int, int, int, int) const {}
};
struct FUpCheap {
    static constexpr int NKIND = 1; static constexpr bool USE_SS = false, PERM = false; bf16* h;
    struct Row { float rs; };
    DI void row_begin(Row&, int, int, int) const {}
    template <int> DI void apply(const Row&, int row, int pn, int c, f32x4 v0, f32x4 v1) const { st4bf(h + (size_t)row * FF + pn * 128 + c, v0 + v1); }
    DI void row_end(const Row&, int, int, int, int) const {}
};
struct FRes {
    static constexpr int NKIND = 1; static constexpr bool USE_SS = false, PERM = true; bf16* xb; float* ssn; float alpha;
    struct Row { float a; };
    DI void row_begin(Row& rc, int, int, int) const { rc.a = 0.f; }
    template <int> DI void apply(Row& rc, int row, int pn, int c, f32x4 v0, f32x4 v1) const {
#pragma unroll
        for (int bj = 0; bj < 2; ++bj) {
            bf16* p = xb + (size_t)row * D + pn * 256 + bj * 128 + c; const f32x4 x = ld4bf(p); const f32x4 v = bj ? v1 : v0;
            u32x2 w; w.x = pk2(x[0] + alpha * v[0], x[1] + alpha * v[1]); w.y = pk2(x[2] + alpha * v[2], x[3] + alpha * v[3]); *(u32x2*)p = w;
            const f32x4 r = unpk4(w); rc.a += (r[0] * r[0] + r[1] * r[1]) + (r[2] * r[2] + r[3] * r[3]);
        }
    }
    template <int> DI void apply8(Row& rc, int row, int pn, int c, f32x4 a0, f32x4 a1, f32x4 b0, f32x4 b1) const {
#pragma unroll
        for (int bj = 0; bj < 2; ++bj) {
            bf16* p = xb + (size_t)row * D + pn * 256 + bj * 128 + c; const u32x4 xw = *(const u32x4*)p; const f32x4 x0 = unpk4((u32x2){xw.x, xw.y}), x1 = unpk4((u32x2){xw.z, xw.w});
            const f32x4 v0 = bj ? b0 : a0, v1 = bj ? b1 : a1;
            u32x4 w; w.x = pk2(x0[0] + alpha * v0[0], x0[1] + alpha * v0[1]); w.y = pk2(x0[2] + alpha * v0[2], x0[3] + alpha * v0[3]); w.z = pk2(x1[0] + alpha * v1[0], x1[1] + alpha * v1[1]); w.w = pk2(x1[2] + alpha * v1[2], x1[3] + alpha * v1[3]);
            *(u32x4*)p = w; const f32x4 r0 = unpk4((u32x2){w.x, w.y}), r1 = unpk4((u32x2){w.z, w.w});
            rc.a += ((r0[0] * r0[0] + r0[1] * r0[1]) + (r0[2] * r0[2] + r0[3] * r0[3])) + ((r1[0] * r1[0] + r1[1] * r1[1]) + (r1[2] * r1[2] + r1[3] * r1[3]));
        }
    }
    DI void row_end(const Row& rc, int row, int pn, int fq, int sub) const { float s = rc.a; s += __shfl_xor(s, 16); s += __shfl_xor(s, 32); if (fq == 0) ssn[(size_t)row * 16 + pn * 4 + sub] = s; }
};
struct FScale {
    static constexpr int NKIND = 1; static constexpr bool USE_SS = true, PERM = true; const float* ss; bf16* o; float sc; LAS float* rsl;
    struct Row { float rs; };
    DI void row_begin(Row& rc, int row, int, int lr) const { rc.rs = (lr >= 0 ? rsl[lr] : rsqrtf(ss_row(ss, row) * (1.f / D) + EPS)) * sc; }
    template <int> DI void apply(const Row& rc, int row, int pn, int c, f32x4 v0, f32x4 v1) const {
        st4bf(o + (size_t)row * D + pn * 256 + c, v0 * rc.rs); st4bf(o + (size_t)row * D + pn * 256 + 128 + c, v1 * rc.rs);
    }
    template <int> DI void apply8(const Row& rc, int row, int pn, int c, f32x4 a0, f32x4 a1, f32x4 b0, f32x4 b1) const { st8bf(o + (size_t)row * D + pn * 256 + c, a0 * rc.rs, a1 * rc.rs); st8bf(o + (size_t)row * D + pn * 256 + 128 + c, b0 * rc.rs, b1 * rc.rs); }
    DI void row_end(const Row&, int, int, int, int) const {}
};
struct FPV {
    static constexpr int NKIND = 1; static constexpr bool USE_SS = false, PERM = true; const float* linv; bf16* o;
    struct Row { float s; };
    DI void row_begin(Row& rc, int row, int pn, int) const { rc.s = linv[(size_t)row * 4 + pn]; }
    template <int> DI void apply(const Row& rc, int row, int pn, int c, f32x4 v0, f32x4 v1) const {
        st4bf(o + (size_t)row * D + pn * 256 + c, v0 * rc.s); st4bf(o + (size_t)row * D + pn * 256 + 128 + c, v1 * rc.s);
    }
    template <int> DI void apply8(const Row& rc, int row, int pn, int c, f32x4 a0, f32x4 a1, f32x4 b0, f32x4 b1) const { st8bf(o + (size_t)row * D + pn * 256 + c, a0 * rc.s, a1 * rc.s); st8bf(o + (size_t)row * D + pn * 256 + 128 + c, b0 * rc.s, b1 * rc.s); }
    DI void row_end(const Row&, int, int, int, int) const {}
};
struct FMemKV {
    static constexpr int NKIND = 2; static constexpr bool USE_SS = false, PERM = false; float* ok; float* ov; bf16* mkb; bf16* mvt;
    struct Row { int d; };
    DI int kind(int pn) const { return pn < 4 ? 0 : 1; }
    DI void row_begin(Row&, int, int, int) const {}
    template <int KIND> DI void apply(const Row&, int row, int pn, int c, f32x4 v0, f32x4 v1) const {
        if constexpr (KIND == 0) {
#pragma unroll
            for (int bj = 0; bj < 2; ++bj) { const int col = pn * 256 + bj * 128 + c; const f32x4 v = bj ? v1 : v0; *(f32x4*)(ok + (size_t)row * D + col) = v; st4bf(mkb + (size_t)row * D + col, v); }
        } else {
            const int h = pn - 4, b = row >> 8, mem = row & 255;
#pragma unroll
            for (int bj = 0; bj < 2; ++bj) { const int dd = bj * 128 + c; const f32x4 v = bj ? v1 : v0; *(f32x4*)(ov + (size_t)row * D + h * 256 + dd) = v;
#pragma unroll
                for (int e = 0; e < 4; ++e) mvt[((size_t)(b * 4 + h) * 256 + dd + e) * 256 + mem] = f2bf(v[e]); }
        }
    }
    DI void row_end(const Row&, int, int, int, int) const {}
};
struct FWin {
    static constexpr int NKIND = 5; static constexpr bool USE_SS = true, PERM = true; const float* ss; unsigned char* ws; float* out; int l; LAS float* rsl;
    struct Row { float rs; int pos, b, t; bool smp; };
    DI int kind(int pn) const { return pn == 0 ? 0 : pn <= 2 ? 1 : pn <= 4 ? 2 : pn == 5 ? 3 : 4; }
    DI void row_begin(Row& rc, int row, int, int lr) const {
        rc.rs = lr >= 0 ? rsl[lr] : rsqrtf(ss_row(ss, row) * (1.f / D) + EPS);
        if (row < MP) { rc.smp = false; rc.b = row >> 14; rc.pos = row & (S - 1); rc.t = 0; } else { const int sr = row - MP; rc.smp = true; rc.b = sr >> 4; rc.t = sr & 15; rc.pos = 1024 + rc.t; }
    }
    template <int KIND> DI void apply(const Row& rc, int row, int pn, int c, f32x4 v0, f32x4 v1) const {
        unsigned char* R = ws + WS_R; const f32x4 a0 = v0 * rc.rs, a1 = v1 * rc.rs;
        if constexpr (KIND == 0) { bf16* gb = (bf16*)(R + R_GB) + (size_t)row * 256 + c; st4bf(gb, a0); st4bf(gb + 128, a1); }
        else if constexpr (KIND == 1) {
            const int ch = (pn - 1) * 128 + c; const f32x4 p = a0 * a1; st4bf((bf16*)(R + R_CV) + (size_t)row * 256 + ch, p);
            if (!rc.smp) { if (rc.pos >= S - 2) *(f32x4*)(out + O_AP + (size_t)l * 1024 + (size_t)(rc.b * 2 + rc.pos - (S - 2)) * 256 + ch) = p; }
            else if (rc.t >= 14) *(f32x4*)(out + O_AS + (size_t)l * 8192 + (size_t)(rc.b * 2 + rc.t - 14) * 256 + ch) = p;
        } else if constexpr (KIND == 2 || KIND == 3) {
            const int blk = c >> 5, i = c & 31;
            if (KIND == 3 && blk >= 2) {
                const int kvh = blk - 2;
                if (!rc.smp) {
                    bf16* vT = (bf16*)(R + R_VT) + ((size_t)(rc.b * 2 + kvh) * 64 + i) * S + rc.pos;
#pragma unroll
                    for (int e = 0; e < 4; ++e) { vT[(size_t)e * S] = f2bf(a0[e]); vT[(size_t)(32 + e) * S] = f2bf(a1[e]); }
                    if (rc.pos >= S - 128) { float* o = out + O_VP + (size_t)l * 32768 + ((size_t)(rc.b * 128 + rc.pos - (S - 128)) * 2 + kvh) * 64 + i; *(f32x4*)o = a0; *(f32x4*)(o + 32) = a1; }
                } else {
                    bf16* p = (bf16*)(R + R_VS) + (size_t)(row - MP) * 128 + kvh * 64 + i; st4bf(p, a0); st4bf(p + 32, a1);
                    float* o = out + O_VS + (size_t)l * 32768 + ((size_t)(rc.b * 16 + rc.t) * 2 + kvh) * 64 + i; *(f32x4*)o = a0; *(f32x4*)(o + 32) = a1;
                }
            } else {
                const float* rcos = (const float*)(ws + WS_ROPE) + (size_t)rc.pos * 32 + i;
                const f32x4 cs = *(const f32x4*)rcos, sn = *(const f32x4*)(rcos + (size_t)S * 32);
                const f32x4 o1 = a0 * cs - a1 * sn, o2 = a1 * cs + a0 * sn;
                if constexpr (KIND == 2) { const int head = (pn - 3) * 4 + blk; const float QS = 0.125f * LOG2E; bf16* p = (bf16*)(R + R_Q) + (size_t)row * 512 + head * 64 + i; st4bf(p, o1 * QS); st4bf(p + 32, o2 * QS); }
                else {
                    bf16* p = (bf16*)(R + R_K) + (size_t)row * 128 + blk * 64 + i; st4bf(p, o1); st4bf(p + 32, o2);
                    if (!rc.smp) { if (rc.pos >= S - 128) { float* o = out + O_KP + (size_t)l * 32768 + ((size_t)(rc.b * 128 + rc.pos - (S - 128)) * 2 + blk) * 64 + i; *(f32x4*)o = o1; *(f32x4*)(o + 32) = o2; } }
                    else { float* o = out + O_KS + (size_t)l * 32768 + ((size_t)(rc.b * 16 + rc.t) * 2 + blk) * 64 + i; *(f32x4*)o = o1; *(f32x4*)(o + 32) = o2; }
                }
            }
        } else {
            const int ch = (pn - 6) * 128 + c; f32x4 g;
#pragma unroll
            for (int e = 0; e < 4; ++e) g[e] = a0[e] * sigmoidf_(a1[e]);
            st4bf((bf16*)(R + R_GLU) + (size_t)row * 256 + ch, g);
            if (!rc.smp) { if (rc.pos >= S - 30) *(f32x4*)(out + O_CP + (size_t)l * 15360 + (size_t)(rc.b * 30 + rc.pos - (S - 30)) * 256 + ch) = g; }
            else *(f32x4*)(out + O_CS + (size_t)l * 122880 + (size_t)(rc.b * 30 + 14 + rc.t) * 256 + ch) = g;
        }
    }
    template <int KIND> DI void apply8(const Row& rc, int row, int pn, int c, f32x4 v0a, f32x4 v0b, f32x4 v1a, f32x4 v1b) const {
        unsigned char* R = ws + WS_R; const f32x4 a0 = v0a * rc.rs, a1 = v0b * rc.rs, b0 = v1a * rc.rs, b1 = v1b * rc.rs;
        if constexpr (KIND == 0) { bf16* gb = (bf16*)(R + R_GB) + (size_t)row * 256 + c; st8bf(gb, a0, a1); st8bf(gb + 128, b0, b1); }
        else if constexpr (KIND == 1) {
            const int ch = (pn - 1) * 128 + c; const f32x4 p0 = a0 * b0, p1 = a1 * b1; st8bf((bf16*)(R + R_CV) + (size_t)row * 256 + ch, p0, p1);
            if (rc.pos >= S - 2) { float* o = out + O_AP + (size_t)l * 1024 + (size_t)(rc.b * 2 + rc.pos - (S - 2)) * 256 + ch; *(f32x4*)o = p0; *(f32x4*)(o + 4) = p1; }
        } else if constexpr (KIND == 2 || KIND == 3) {
            const int blk = c >> 5, i = c & 31;
            if (KIND == 3 && blk >= 2) { apply<3>(rc, row, pn, c, v0a, v1a); apply<3>(rc, row, pn, c + 4, v0b, v1b); }
            else {
                const float* rcos = (const float*)(ws + WS_ROPE) + (size_t)rc.pos * 32 + i; const float* rsin = rcos + (size_t)S * 32;
                const f32x4 c0 = *(const f32x4*)rcos, c1 = *(const f32x4*)(rcos + 4), s0 = *(const f32x4*)rsin, s1 = *(const f32x4*)(rsin + 4);
                const f32x4 o1a = a0 * c0 - b0 * s0, o1b = a1 * c1 - b1 * s1, o2a = b0 * c0 + a0 * s0, o2b = b1 * c1 + a1 * s1;
                if constexpr (KIND == 2) { const int head = (pn - 3) * 4 + blk; const float QS = 0.125f * LOG2E; bf16* p = (bf16*)(R + R_Q) + (size_t)row * 512 + head * 64 + i; st8bf(p, o1a * QS, o1b * QS); st8bf(p + 32, o2a * QS, o2b * QS); }
                else {
                    bf16* p = (bf16*)(R + R_K) + (size_t)row * 128 + blk * 64 + i; st8bf(p, o1a, o1b); st8bf(p + 32, o2a, o2b);
                    if (rc.pos >= S - 128) { float* o = out + O_KP + (size_t)l * 32768 + ((size_t)(rc.b * 128 + rc.pos - (S - 128)) * 2 + blk) * 64 + i; *(f32x4*)o = o1a; *(f32x4*)(o + 4) = o1b; *(f32x4*)(o + 32) = o2a; *(f32x4*)(o + 36) = o2b; }
                }
            }
        } else {
            const int ch = (pn - 6) * 128 + c; f32x4 g0, g1;
#pragma unroll
            for (int e = 0; e < 4; ++e) { g0[e] = a0[e] * sigmoidf_(b0[e]); g1[e] = a1[e] * sigmoidf_(b1[e]); }
            st8bf((bf16*)(R + R_GLU) + (size_t)row * 256 + ch, g0, g1);
            if (rc.pos >= S - 30) { float* o = out + O_CP + (size_t)l * 15360 + (size_t)(rc.b * 30 + rc.pos - (S - 30)) * 256 + ch; *(f32x4*)o = g0; *(f32x4*)(o + 4) = g1; }
        }
    }
    DI void row_end(const Row&, int, int, int, int) const {}
};
struct EpiS {
    static constexpr bool PERM = true, AFTER_DRAIN = false;
    bf16* P; float* linv; LAS float* sc;
    DI void operator()(const f32x4 (&acc)[2][2][4][2], const Unit& u, int wr, int wc, int fr, int fq) const {
        LAS float* Pm = sc; LAS float* Ps = sc + 1024;
#pragma unroll
        for (int ai = 0; ai < 2; ++ai)
#pragma unroll
            for (int m = 0; m < 4; ++m) {
                float mx = -3.0e38f;
#pragma unroll
                for (int bj = 0; bj < 2; ++bj)
#pragma unroll
                    for (int n = 0; n < 2; ++n) { const f32x4 x = acc[ai][bj][m][n]; mx = fmaxf(mx, fmaxf(fmaxf(x[0], x[1]), fmaxf(x[2], x[3]))); }
                mx = fmaxf(mx, __shfl_xor(mx, 16)); mx = fmaxf(mx, __shfl_xor(mx, 32));
                if (fq == 0) Pm[(ai * 128 + wr * 64 + m * 16 + fr) * 4 + wc] = mx;
            }
        EPI_BAR();
#pragma unroll
        for (int ai = 0; ai < 2; ++ai)
#pragma unroll
            for (int m = 0; m < 4; ++m) {
                const int r = ai * 128 + wr * 64 + m * 16 + fr; const f32x4 m4 = *(LAS f32x4*)(Pm + r * 4);
                const float mx = fmaxf(fmaxf(m4[0], m4[1]), fmaxf(m4[2], m4[3])); float sum = 0.f;
                bf16* prow = P + (size_t)(u.pm * 256 + r) * D + u.pn * 256 + wc * 32 + fq * 8;
#pragma unroll
                for (int bj = 0; bj < 2; ++bj) {
                    const f32x4 x = acc[ai][bj][m][0], y = acc[ai][bj][m][1]; u32x4 w;
                    w.x = pk2(__builtin_amdgcn_exp2f(x[0] - mx), __builtin_amdgcn_exp2f(x[1] - mx)); w.y = pk2(__builtin_amdgcn_exp2f(x[2] - mx), __builtin_amdgcn_exp2f(x[3] - mx));
                    w.z = pk2(__builtin_amdgcn_exp2f(y[0] - mx), __builtin_amdgcn_exp2f(y[1] - mx)); w.w = pk2(__builtin_amdgcn_exp2f(y[2] - mx), __builtin_amdgcn_exp2f(y[3] - mx));
                    *(u32x4*)(prow + bj * 128) = w; const f32x4 p0 = unpk4((u32x2){w.x, w.y}), p1 = unpk4((u32x2){w.z, w.w}); sum += ((p0[0] + p0[1]) + (p0[2] + p0[3])) + ((p1[0] + p1[1]) + (p1[2] + p1[3]));
                }
                sum += __shfl_xor(sum, 16); sum += __shfl_xor(sum, 32);
                if (fq == 0) Ps[r * 4 + wc] = sum;
            }
        EPI_BAR();
        const int tid = (wr * 4 + wc) * 64 + fq * 16 + fr;
        if (tid < 256) { const f32x4 s4 = *(LAS f32x4*)(Ps + tid * 4); linv[(size_t)(u.pm * 256 + tid) * 4 + u.pn] = 1.f / ((s4[0] + s4[1]) + (s4[2] + s4[3])); }
    }
};

template <int K, class F> DI void sample_gemm(int wv, LAS unsigned char* lds, const bf16* A, int lda, const bf16* Bt, int ldb, int nN, const F& f, int G, int c0) {
    unsigned z_ = 0u; asm volatile("" : "+v"(z_)); const int tid_ = wv * 64 + (int)__builtin_amdgcn_mbcnt_hi(~0u, __builtin_amdgcn_mbcnt_lo(~0u, z_)); const int tid = tid_, w = __builtin_amdgcn_readfirstlane(tid >> 6), lane = tid & 63, fr = lane & 15, fq = lane >> 4;
    LAS float* red = (LAS float*)lds;
    constexpr int kw = K / 8, NKS = kw / 32, KB = 4;
    const int n_mu = 16 * nN * 4;
    for (int mu = c0; mu < n_mu; mu += G) {
        const int rb = mu & 15, t = mu >> 4, pn = t >> 2, s = t & 3, row0 = MP + rb * 16;
        f32x4 acc[4];
#pragma unroll
        for (int j = 0; j < 4; ++j) acc[j] = (f32x4){0.f, 0.f, 0.f, 0.f};
        const bf16* ap = A + (size_t)(row0 + fr) * lda + w * kw + fq * 8;
        const bf16* bp = Bt + (size_t)(pn * 256 + s * 32 + fr) * ldb + w * kw + fq * 8;
#pragma unroll
        for (int k0 = 0; k0 < NKS; k0 += KB) {
            bf16x8 a[KB], b[KB][4];
#pragma unroll
            for (int kk = 0; kk < KB; ++kk) if (k0 + kk < NKS) {
                a[kk] = *(const bf16x8*)(ap + (k0 + kk) * 32);
#pragma unroll
                for (int j = 0; j < 4; ++j) b[kk][j] = *(const bf16x8*)(bp + (size_t)((j >> 1) * 128 + (j & 1) * 16) * ldb + (k0 + kk) * 32);
            }
#pragma unroll
            for (int kk = 0; kk < KB; ++kk) if (k0 + kk < NKS) {
#pragma unroll
                for (int j = 0; j < 4; ++j) acc[j] = __builtin_amdgcn_mfma_f32_16x16x32_bf16(b[kk][j], a[kk], acc[j], 0, 0, 0);
            }
        }
#pragma unroll
        for (int j = 0; j < 4; ++j) *(LAS f32x4*)(red + ((w * 4 + j) * 64 + lane) * 4) = acc[j];
        __syncthreads();
        if (w == 0) {
            f32x4 v0[2], v1[2];
#pragma unroll
            for (int wb = 0; wb < 2; ++wb) { v0[wb] = (f32x4){0.f, 0.f, 0.f, 0.f}; v1[wb] = v0[wb];
#pragma unroll
                for (int ww = 0; ww < 8; ++ww) { v0[wb] += *(LAS f32x4*)(red + ((ww * 4 + wb) * 64 + lane) * 4); v1[wb] += *(LAS f32x4*)(red + ((ww * 4 + wb + 2) * 64 + lane) * 4); } }
            apply_two(f, row0 + fr, pn, s * 32 + fq * 4, v0, v1, fq, s);
        }
        __syncthreads();
    }
}

template <class F> DI void sample_gemm_wide(int wv, LAS unsigned char* lds, const bf16* A, const bf16* Bt, int nN, const F& f, int G, int c0) {
    unsigned z_ = 0u; asm volatile("" : "+v"(z_)); const int lane = (int)__builtin_amdgcn_mbcnt_hi(~0u, __builtin_amdgcn_mbcnt_lo(~0u, z_)), fr = lane & 15, fq = lane >> 4, w = wv;
    constexpr int K = D;
    LAS float* red = (LAS float*)lds;
    const int n_mu = 4 * nN * 4;
    for (int mu = c0; mu < n_mu; mu += G) {
        const int rg = mu & 3, t = mu >> 2, pn = t >> 2, s = t & 3, row0 = MP + rg * 64;
        f32x4 acc[4][4];
#pragma unroll
        for (int rb = 0; rb < 4; ++rb)
#pragma unroll
            for (int j = 0; j < 4; ++j) acc[rb][j] = (f32x4){0.f, 0.f, 0.f, 0.f};
        const bf16* ap = A + (size_t)(row0 + fr) * K + w * 128 + fq * 8;
        const bf16* bp = Bt + (size_t)(pn * 256 + s * 32 + fr) * K + w * 128 + fq * 8;
        bf16x8 a[4][4], b[4][4];
#pragma unroll
        for (int kk = 0; kk < 4; ++kk)
#pragma unroll
            for (int x = 0; x < 4; ++x) { a[kk][x] = *(const bf16x8*)(ap + (size_t)x * 16 * K + kk * 32); b[kk][x] = *(const bf16x8*)(bp + (size_t)((x >> 1) * 128 + (x & 1) * 16) * K + kk * 32); }
#pragma unroll
        for (int kk = 0; kk < 4; ++kk)
#pragma unroll
            for (int rb = 0; rb < 4; ++rb)
#pragma unroll
                for (int j = 0; j < 4; ++j) acc[rb][j] = __builtin_amdgcn_mfma_f32_16x16x32_bf16(b[kk][j], a[kk][rb], acc[rb][j], 0, 0, 0);
#pragma unroll
        for (int rb = 0; rb < 4; ++rb)
#pragma unroll
            for (int j = 0; j < 4; ++j) *(LAS f32x4*)(red + ((w * 16 + rb * 4 + j) * 64 + lane) * 4) = acc[rb][j];
        __syncthreads();
        {
            const int rb = w >> 1, wb = w & 1; f32x4 v0 = (f32x4){0.f, 0.f, 0.f, 0.f}, v1 = v0;
#pragma unroll
            for (int ww = 0; ww < 8; ++ww) { v0 += *(LAS f32x4*)(red + ((ww * 16 + rb * 4 + wb) * 64 + lane) * 4); v1 += *(LAS f32x4*)(red + ((ww * 16 + rb * 4 + wb + 2) * 64 + lane) * 4); }
            const int row = row0 + rb * 16 + fr, c = s * 32 + wb * 16 + fq * 4; typename F::Row rc; f.row_begin(rc, row, pn, -1);
            if constexpr (F::NKIND == 1) f.template apply<0>(rc, row, pn, c, v0, v1);
            else { const int kd = f.kind(pn);
                if (kd == 0) f.template apply<0>(rc, row, pn, c, v0, v1); else if (kd == 1) f.template apply<1>(rc, row, pn, c, v0, v1);
                else if constexpr (F::NKIND > 2) { if (kd == 2) f.template apply<2>(rc, row, pn, c, v0, v1); else if (kd == 3) f.template apply<3>(rc, row, pn, c, v0, v1); else f.template apply<4>(rc, row, pn, c, v0, v1); } }
        }
        __syncthreads();
    }
}

DI void tr_item(const float* W, int N, int sc0, const float* gain, bf16* WT, int K, int n0, int k0, LAS float* scr, int lane) {
#pragma unroll
    for (int i = 0; i < 8; ++i) { const int kk = 8 * i + (lane >> 3), n4 = (lane & 7) * 4; const float g = gain ? gain[k0 + kk] : 1.f; const f32x4 v = *(const f32x4*)(W + (size_t)(k0 + kk) * N + sc0 + n4);
        LAS float* d = scr + kk * 33 + n4; d[0] = v[0] * g; d[1] = v[1] * g; d[2] = v[2] * g; d[3] = v[3] * g; }
    LDS_WAIT();
    const int c = lane & 7;
#pragma unroll
    for (int j = 0; j < 4; ++j) { const int n = (lane >> 3) + 8 * j; const LAS float* s = scr + (8 * c) * 33 + n;
        u32x4 o; o.x = pk2(s[0 * 33], s[1 * 33]); o.y = pk2(s[2 * 33], s[3 * 33]); o.z = pk2(s[4 * 33], s[5 * 33]); o.w = pk2(s[6 * 33], s[7 * 33]);
        *(u32x4*)(WT + (size_t)(n0 + n) * K + k0 + 8 * c) = o; }
    LDS_WAIT();
}
DI int map_win(int n0) {
    const int t = n0 >> 8, r = n0 & 255, hb = r >> 7, rr = r & 127;
    switch (t) {
        case 0: return r;
        case 1: case 2: return (hb ? 512 : 256) + (t - 1) * 128 + rr;
        case 3: case 4: return 768 + ((t - 3) * 4 + (rr >> 5)) * 64 + hb * 32 + (rr & 31);
        case 5: { const int blk = rr >> 5; return (blk < 2 ? 1280 + blk * 64 : 1408 + (blk - 2) * 64) + hb * 32 + (rr & 31); }
        default: return (hb ? 1792 : 1536) + (t - 6) * 128 + rr;
    }
}
DI void sincos_d(double a, float& sn, float& cs) {
    const double k = rint(a * 0.6366197723675814); double r = fma(-k, 1.5707963267948966, a); r = fma(-k, 6.123233995736766e-17, r); const double r2 = r * r;
    const double s = r * (1.0 + r2 * (-1.0 / 6 + r2 * (1.0 / 120 + r2 * (-1.0 / 5040 + r2 * (1.0 / 362880 + r2 * (-1.0 / 39916800 + r2 * (1.0 / 6227020800.0)))))));
    const double c = 1.0 + r2 * (-0.5 + r2 * (1.0 / 24 + r2 * (-1.0 / 720 + r2 * (1.0 / 40320 + r2 * (-1.0 / 3628800 + r2 * (1.0 / 479001600 + r2 * (-1.0 / 87178291200.0)))))));
    const int q = (int)((long long)k & 3);
    sn = (float)(q == 0 ? s : q == 1 ? c : q == 2 ? -s : -c); cs = (float)(q == 0 ? c : q == 1 ? -s : q == 2 ? -c : s);
}
DI void prologue(int wv, unsigned char* ws, float* out, LAS unsigned char* lds) {
    unsigned z_ = 0u; asm volatile("" : "+v"(z_)); const int tid_ = wv * 64 + (int)__builtin_amdgcn_mbcnt_hi(~0u, __builtin_amdgcn_mbcnt_lo(~0u, z_)); const int tid = tid_, w = __builtin_amdgcn_readfirstlane(tid >> 6), lane = tid & 63, G = gridDim.x;
    const int gw = blockIdx.x * 8 + w, NGW = G * 8; const int gt = blockIdx.x * NTHR + tid, NGT = G * NTHR;
    { float* rc = (float*)(ws + WS_ROPE); float* rs = rc + (size_t)S * 32;
      for (int i = gt; i < S * 32; i += NGT) { const int pos = i >> 5, j = i & 31; double inv = 1.0; for (int q = 0; q < j; ++q) inv *= 0.74989420933245587; float sn, cs; sincos_d((double)pos * inv, sn, cs); rc[i] = cs; rs[i] = sn; } }
    { bf16* xb = (bf16*)(ws + WS_XB); float* ss0 = (float*)(ws + WS_SS); bf16* mn = (bf16*)(ws + WS_MN);
      for (int m = gw; m < MT + 512; m += NGW) {
          const float* src = m < MP ? IN(I_XP) + (size_t)m * D : m < MT ? IN(I_XS) + (size_t)(m - MP) * D : IN(I_MEM) + (size_t)(m - MT) * D;
          f32x4 v[4]; float s = 0.f;
#pragma unroll
          for (int j = 0; j < 4; ++j) { v[j] = *((const f32x4*)src + lane + 64 * j); }
          if (m < MT) {
              bf16* o = xb + (size_t)m * D;
#pragma unroll
              for (int j = 0; j < 4; ++j) { u32x2 wv; wv.x = pk2(v[j][0], v[j][1]); wv.y = pk2(v[j][2], v[j][3]); *((u32x2*)o + lane + 64 * j) = wv; const f32x4 r = unpk4(wv); s += (r[0] * r[0] + r[1] * r[1]) + (r[2] * r[2] + r[3] * r[3]); }
              s = wave_sum(s); if (lane < 16) ss0[(size_t)m * 16 + lane] = lane == 0 ? s : 0.f;
          } else {
#pragma unroll
              for (int j = 0; j < 4; ++j) s += (v[j][0] * v[j][0] + v[j][1] * v[j][1]) + (v[j][2] * v[j][2] + v[j][3] * v[j][3]);
              const float rstd = rsqrtf(wave_sum(s) * (1.f / D) + EPS); bf16* o = mn + (size_t)(m - MT) * D;
#pragma unroll
              for (int j = 0; j < 4; ++j) st4bf(o + 4 * (lane + 64 * j), v[j] * rstd);
          }
      } }
    { LAS float* scr = (LAS float*)(lds + w * 16384);
      constexpr int I1 = 16 * 176, ID = 44 * 32, IIN = 16 * 64, ISQ = 16 * 32, IKV = 16 * 64, IL = 2 * I1 + 2 * ID + IIN + 3 * ISQ + IKV;
      for (int it = gw; it < NL * IL; it += NGW) {
          const int l = it / IL; int r = it % IL; unsigned char* wl = ws + WS_W + (size_t)l * LW;
          if (r < 2 * I1) { const int second = r >= I1; if (second) r -= I1; const int nb = r % 176, kb = r / 176, n0 = nb * 32, pn = n0 >> 8, rr = n0 & 255;
              const float* W = (second ? (rr >= 128 ? IN(I_F2U) : IN(I_F2G)) : (rr >= 128 ? IN(I_F1U) : IN(I_F1G))) + (size_t)l * D * FF;
              tr_item(W, FF, pn * 128 + (rr & 127), (second ? IN(I_F2N) : IN(I_F1N)) + l * D, (bf16*)(wl + (second ? W_2 : W_1)), D, n0, kb * 64, scr, lane); continue; }
          r -= 2 * I1;
          if (r < 2 * ID) { const int second = r >= ID; if (second) r -= ID; const int nb = r % 32, kb = r / 32;
              tr_item((second ? IN(I_F2D) : IN(I_F1D)) + (size_t)l * FF * D, D, nb * 32, nullptr, (bf16*)(wl + (second ? W_D2 : W_D1)), FF, nb * 32, kb * 64, scr, lane); continue; }
          r -= 2 * ID;
          if (r < IIN) { const int nb = r % 64, kb = r / 64; tr_item(IN(I_WIN) + (size_t)l * D * 2048, 2048, map_win(nb * 32), IN(I_MIXN) + l * D, (bf16*)(wl + W_IN), D, nb * 32, kb * 64, scr, lane); continue; }
          r -= IIN;
          if (r < 3 * ISQ) { const int which = r / ISQ; r -= which * ISQ; const int nb = r % 32, kb = r / 32;
              const float* W = (which == 0 ? IN(I_WOUT) : which == 1 ? IN(I_WQ) : IN(I_WO)) + (size_t)l * D * D; const float* g = which == 0 ? IN(I_MON) + l * D : which == 1 ? IN(I_XAN) + l * D : nullptr;
              tr_item(W, D, nb * 32, g, (bf16*)(wl + (which == 0 ? W_OUT : which == 1 ? W_Q : W_O)), D, nb * 32, kb * 64, scr, lane); continue; }
          r -= 3 * ISQ;
          { const int nb = r % 64, kb = r / 64, n0 = nb * 32; tr_item((n0 < 1024 ? IN(I_WK) : IN(I_WV)) + (size_t)l * D * D, D, n0 & 1023, IN(I_MEMN) + l * D, (bf16*)(wl + W_KV), D, n0, kb * 64, scr, lane); }
      } }
}

DI f32x16 mfma32(bf16x8 a, bf16x8 b, f32x16 c) { return __builtin_amdgcn_mfma_f32_32x32x16_bf16(a, b, c, 0, 0, 0); }
constexpr int MX_KSZ = 192 * 144, MX_VOFF = 2 * MX_KSZ, MX_VP = 392, MX_SSB = MX_VOFF + 128 * MX_VP, MX_WC = MX_SSB + 2048, MX_END = MX_WC + 48 * 256 * 4;
static_assert(MX_END <= LDS_TAB, "mixer LDS");

template <int TW, class LA, class LC, class LCP, class LG> DI void conv_tokens(int l, LAS unsigned char* lds, int lane, LA ldA, LC ldC, LCP ldCp, LG ldG, bf16* ymix_row0  ) {
    const int ch = 4 * lane;
    const float* caw = IN(I_CAW) + (size_t)l * 3 * 256 + ch; const f32x4 wa0 = *(const f32x4*)caw, wa1 = *(const f32x4*)(caw + 256), wa2 = *(const f32x4*)(caw + 512);
    const LAS float* wc = (const LAS float*)(lds + MX_WC) + ch;
    f32x4 accA[TW], accC[TW];
    const f32x4 bias = *(const f32x4*)(IN(I_CCB) + l * 256 + ch);
#pragma unroll
    for (int t = 0; t < TW; ++t) { accA[t] = (f32x4){0.f, 0.f, 0.f, 0.f}; accC[t] = bias; }
#pragma unroll
    for (int i = 0; i < TW + 2; ++i) { const f32x4 x = ldA(i);
#pragma unroll
        for (int t = 0; t < TW; ++t) { const int j = i - t; if (j == 0) accA[t] += wa0 * x; else if (j == 1) accA[t] += wa1 * x; else if (j == 2) accA[t] += wa2 * x; } }
    constexpr int NWIN = TW + 30;
    {
#pragma unroll 1
        for (int ib = 0; ib < NWIN; ib += 16) {
            f32x4 x[16];
#pragma unroll
            for (int ii = 0; ii < 16; ++ii) x[ii] = ldC(ib + ii);
#pragma unroll
            for (int ii = 0; ii < 16; ++ii)
#pragma unroll
                for (int t = 0; t < TW; ++t) accC[t] += *(const LAS f32x4*)(wc + (ib + ii - t + 8) * 256) * x[ii];
        }
    }
    const f32x4 lng = *(const f32x4*)(IN(I_LNG) + l * 256 + ch), lnb = *(const f32x4*)(IN(I_LNB) + l * 256 + ch);
#pragma unroll
    for (int t = 0; t < TW; ++t) {
        const f32x4 ya = ldG(t) * accA[t];
        const float ssa = wave_sum((ya[0] * ya[0] + ya[1] * ya[1]) + (ya[2] * ya[2] + ya[3] * ya[3]));
        st4bf(ymix_row0 + (size_t)t * D + ch, ya * rsqrtf(ssa * (1.f / 256) + EPS));
        const f32x4 cc = accC[t];
        const float mean = wave_sum((cc[0] + cc[1]) + (cc[2] + cc[3])) * (1.f / 256); const f32x4 dc = cc - mean;
        const float var = wave_sum((dc[0] * dc[0] + dc[1] * dc[1]) + (dc[2] * dc[2] + dc[3] * dc[3])) * (1.f / 256);
        const f32x4 ln = dc * rsqrtf(var + EPS) * lng + lnb; f32x4 yc;
#pragma unroll
        for (int e = 0; e < 4; ++e) yc[e] = ln[e] * sigmoidf_(ln[e]);
        const float ssc = wave_sum((yc[0] * yc[0] + yc[1] * yc[1]) + (yc[2] * yc[2] + yc[3] * yc[3]));
        st4bf(ymix_row0 + (size_t)t * D + 768 + ch, yc * rsqrtf(ssc * (1.f / 256) + EPS));
    }
}

template <bool SMP> DI void attn_qb(const LAS unsigned char* Kl, const LAS unsigned char* Vl, const bf16* qp, float sink2, int kb0, f32x16 (&o)[2]) {
    bf16x8 qf[4];
#pragma unroll
    for (int ks = 0; ks < 4; ++ks) qf[ks] = *(const bf16x8*)(qp + ks * 16);
    f32x16 s[6];
#pragma unroll
    for (int kb = 0; kb < 6; ++kb)
#pragma unroll
        for (int i = 0; i < 16; ++i) s[kb][i] = 0.f;
#pragma unroll
    for (int ks = 0; ks < 4; ++ks)
#pragma unroll
        for (int kb = 0; kb < 6; ++kb) { const bf16x8 a = *(const LAS bf16x8*)(Kl + kb * 32 * 144 + ks * 32); s[kb] = mfma32(a, qf[ks], s[kb]); }
#pragma unroll
    for (int kb = 0; kb < 6; ++kb) { if (SMP ? kb == 5 : kb < kb0) {
#pragma unroll
            for (int i = 0; i < 16; ++i) s[kb][i] = -3.0e38f; }
        if (SMP && kb == 4) {
#pragma unroll
            for (int i = 8; i < 16; ++i) s[kb][i] = -3.0e38f; } }
    float m4[4] = {sink2, sink2, sink2, sink2};
#pragma unroll
    for (int kb = 0; kb < 6; ++kb)
#pragma unroll
        for (int i = 0; i < 16; ++i) m4[i & 3] = fmaxf(m4[i & 3], s[kb][i]);
    float mx = fmaxf(fmaxf(m4[0], m4[1]), fmaxf(m4[2], m4[3]));
    mx = fmaxf(mx, __shfl_xor(mx, 32));
    float s4[4] = {0.f, 0.f, 0.f, 0.f};
#pragma unroll
    for (int kb = 0; kb < 6; ++kb)
#pragma unroll
        for (int i = 0; i < 16; ++i) { s[kb][i] = __builtin_amdgcn_exp2f(s[kb][i] - mx); s4[i & 3] += s[kb][i]; }
    float sum = (s4[0] + s4[1]) + (s4[2] + s4[3]);
    sum += __shfl_xor(sum, 32);
    const float inv = __builtin_amdgcn_rcpf(sum + __builtin_amdgcn_exp2f(sink2 - mx));
    f32x16 o2[2][2];
#pragma unroll
    for (int hb = 0; hb < 2; ++hb)
#pragma unroll
        for (int t = 0; t < 2; ++t)
#pragma unroll
            for (int i = 0; i < 16; ++i) o2[hb][t][i] = 0.f;
#pragma unroll
    for (int kb = 0; kb < 6; ++kb)
#pragma unroll
        for (int t = 0; t < 2; ++t) {
            u32x4 pw; pw.x = pk2(s[kb][8 * t] * inv, s[kb][8 * t + 1] * inv); pw.y = pk2(s[kb][8 * t + 2] * inv, s[kb][8 * t + 3] * inv);
            pw.z = pk2(s[kb][8 * t + 4] * inv, s[kb][8 * t + 5] * inv); pw.w = pk2(s[kb][8 * t + 6] * inv, s[kb][8 * t + 7] * inv);
            const bf16x8 pf = __builtin_bit_cast(bf16x8, pw);
#pragma unroll
            for (int hb = 0; hb < 2; ++hb) {
                const LAS unsigned char* vp = Vl + hb * 32 * MX_VP + (kb * 32 + t * 16) * 2;
                const u32x2 lo = *(const LAS u32x2*)vp, hi = *(const LAS u32x2*)(vp + 16);
                const bf16x8 vf = __builtin_bit_cast(bf16x8, (u32x4){lo.x, lo.y, hi.x, hi.y});
                o2[hb][t] = mfma32(vf, pf, o2[hb][t]);
            }
        }
#pragma unroll
    for (int hb = 0; hb < 2; ++hb) o[hb] = o2[hb][0] + o2[hb][1];
}

DI void mixer_phase(int wv, unsigned char* ws, float* out, int l, LAS unsigned char* lds, int G, int bx) {
    unsigned z_ = 0u; asm volatile("" : "+v"(z_)); const int tid_ = wv * 64 + (int)__builtin_amdgcn_mbcnt_hi(~0u, __builtin_amdgcn_mbcnt_lo(~0u, z_)); const int tid = tid_, w = __builtin_amdgcn_readfirstlane(tid >> 6), lane = tid & 63, r = lane & 31, hf = lane >> 5;
    unsigned char* R = ws + WS_R;
    const bf16* gb = (const bf16*)(R + R_GB); const bf16* cv = (const bf16*)(R + R_CV); const bf16* qb_ = (const bf16*)(R + R_Q); const bf16* kb_ = (const bf16*)(R + R_K);
    const bf16* vT = (const bf16*)(R + R_VT); const bf16* vS = (const bf16*)(R + R_VS); const bf16* glu = (const bf16*)(R + R_GLU); bf16* ymix = (bf16*)(R + R_YMIX);
    { const float* src = IN(I_CCW) + (size_t)l * 31 * 256; LAS float* dst = (LAS float*)(lds + MX_WC);
#pragma unroll
      for (int it = 0; it < 6; ++it) { const int i4 = tid + it * NTHR, j = (i4 >> 6) - 8; const bool ok = j >= 0 && j <= 30; const f32x4 v = *(const f32x4*)(src + (ok ? j : 0) * 256 + (i4 & 63) * 4);
          *(LAS f32x4*)(dst + i4 * 4) = ok ? v : (f32x4){0.f, 0.f, 0.f, 0.f}; } }
    const float sink2 = IN(I_SINK)[l * 8 + w] * LOG2E;
    LAS float* ssb = (LAS float*)(lds + MX_SSB);
    __syncthreads();
#ifndef PROBE
#define PROBE 0
#endif
    for (int rep_ = 0; rep_ < (PROBE == 12 ? 2 : 1); ++rep_)
    for (int u = bx; u < NB * 256; u += G) {
        const int b = u >> 8, n = u & 255; const size_t row0 = (size_t)b * S + n * 64;
        u32x4 kreg[6], vreg[6];
#pragma unroll
        for (int it = 0; it < 6; ++it) {
            const int p = tid + it * NTHR, key = p >> 4, part = p & 15, pos = n * 64 - 128 + key;
            kreg[it] = *(const u32x4*)(kb_ + ((size_t)b * S + (pos >= 0 ? pos : 0)) * 128 + part * 8);
            const int rr = p / 24, pc = p % 24, pos0 = n * 64 - 128 + pc * 8;
            vreg[it] = *(const u32x4*)(vT + ((size_t)(b * 128 + rr)) * S + (pos0 >= 0 ? pos0 : 0));
        }
        const int t0 = w * 8, p0 = n * 64 + t0; const size_t brow = (size_t)b * S;
        auto ldP = [&](const bf16* base, int p) -> u32x2 { const u32x2 v = *(const u32x2*)(base + (brow + (p >= 0 ? p : 0)) * 256 + 4 * lane); return p >= 0 ? v : (u32x2){0u, 0u}; };
        u32x2 wa_[10], wg_[8], w0_[8], nw_[8];
#pragma unroll
        for (int i = 0; i < 10; ++i) wa_[i] = ldP(cv, p0 - 2 + i);
#pragma unroll
        for (int i = 0; i < 8; ++i) { wg_[i] = ldP(gb, p0 + i); w0_[i] = ldP(glu, p0 - 30 + i); nw_[i] = ldP(glu, p0 - 22 + i); }
#pragma unroll
        for (int it = 0; it < 6; ++it) {
            const int p = tid + it * NTHR, key = p >> 4, part = p & 15, pos = n * 64 - 128 + key;
            *(LAS u32x4*)(lds + (part >> 3) * MX_KSZ + key * 144 + (part & 7) * 16) = pos >= 0 ? kreg[it] : (u32x4){0u, 0u, 0u, 0u};
            const int rr = p / 24, pc = p % 24, pos0 = n * 64 - 128 + pc * 8; const u32x4 v = pos0 >= 0 ? vreg[it] : (u32x4){0u, 0u, 0u, 0u};
            LAS u32x2* d = (LAS u32x2*)(lds + MX_VOFF + rr * MX_VP + pc * 16); d[0] = (u32x2){v.x, v.y}; d[1] = (u32x2){v.z, v.w};
        }
        {
            const int ch = 4 * lane;
            const float* caw = IN(I_CAW) + (size_t)l * 3 * 256 + ch; const f32x4 wa0 = *(const f32x4*)caw, wa1 = *(const f32x4*)(caw + 256), wa2 = *(const f32x4*)(caw + 512);
            const LAS float* wc = (const LAS float*)(lds + MX_WC) + ch;
            const f32x4 bias = *(const f32x4*)(IN(I_CCB) + l * 256 + ch);
            const f32x4 lng = *(const f32x4*)(IN(I_LNG) + l * 256 + ch), lnb = *(const f32x4*)(IN(I_LNB) + l * 256 + ch);
            f32x4 accC[8], Rg[8];
#pragma unroll
            for (int t = 0; t < 8; ++t) { accC[t] = bias; Rg[t] = unpk4(w0_[t]); }
#pragma unroll 1
            for (int jb = 0; jb < 32; jb += 8) {
                u32x2 nx[8];
#pragma unroll
                for (int s = 0; s < 8; ++s) { const int i = jb + 16 + s; nx[s] = (i < 38) ? ldP(glu, p0 - 30 + i) : (u32x2){0u, 0u}; }
#pragma unroll
                for (int s = 0; s < 8; ++s) { const f32x4 wt = *(const LAS f32x4*)(wc + (jb + s + 8) * 256);
#pragma unroll
                    for (int t = 0; t < 8; ++t) accC[t] += wt * Rg[(t + s) & 7];
                    Rg[s] = unpk4(nw_[s]); }
#pragma unroll
                for (int s = 0; s < 8; ++s) nw_[s] = nx[s];
            }
            bf16* yrow = ymix + (brow + p0) * D;
#pragma unroll
            for (int t = 0; t < 8; ++t) {
                const f32x4 ya = unpk4(wg_[t]) * (wa0 * unpk4(wa_[t]) + wa1 * unpk4(wa_[t + 1]) + wa2 * unpk4(wa_[t + 2]));
                const float ssa = wave_sum((ya[0] * ya[0] + ya[1] * ya[1]) + (ya[2] * ya[2] + ya[3] * ya[3]));
                st4bf(yrow + (size_t)t * D + ch, ya * rsqrtf(ssa * (1.f / 256) + EPS));
                const f32x4 cc = accC[t];
                const float mean = wave_sum((cc[0] + cc[1]) + (cc[2] + cc[3])) * (1.f / 256); const f32x4 dc = cc - mean;
                const float var = wave_sum((dc[0] * dc[0] + dc[1] * dc[1]) + (dc[2] * dc[2] + dc[3] * dc[3])) * (1.f / 256);
                const f32x4 ln = dc * rsqrtf(var + EPS) * lng + lnb; f32x4 yc;
#pragma unroll
                for (int e = 0; e < 4; ++e) yc[e] = ln[e] * sigmoidf_(ln[e]);
                const float ssc = wave_sum((yc[0] * yc[0] + yc[1] * yc[1]) + (yc[2] * yc[2] + yc[3] * yc[3]));
                st4bf(yrow + (size_t)t * D + 768 + ch, yc * rsqrtf(ssc * (1.f / 256) + EPS));
            }
        }
        __syncthreads();
        const int kvh = w >> 2, kb0 = n >= 2 ? 0 : (2 - n) * 2;
        const LAS unsigned char* Kl = lds + kvh * MX_KSZ + r * 144 + hf * 16; const LAS unsigned char* Vl = lds + MX_VOFF + (kvh * 64 + r) * MX_VP + hf * 8;
#pragma unroll 1
        for (int qb = 0; qb < (PROBE == 17 ? 4 : 2); ++qb) {
            f32x16 o[2]; attn_qb<false>(Kl, Vl, qb_ + (row0 + (qb & 1) * 32 + r) * 512 + w * 64 + hf * 8, sink2, kb0, o);
            float sq = 0.f;
#pragma unroll
            for (int hb = 0; hb < 2; ++hb)
#pragma unroll
                for (int i = 0; i < 16; ++i) sq += o[hb][i] * o[hb][i];
            sq += __shfl_xor(sq, 32);
            if (hf == 0) ssb[((qb & 1) * 8 + w) * 32 + r] = sq;
            __syncthreads();
            float tot = 0.f;
#pragma unroll
            for (int hh = 0; hh < 8; ++hh) tot += ssb[((qb & 1) * 8 + hh) * 32 + r];
            const float rs = rsqrtf(tot * (1.f / 512) + EPS); bf16* yp = ymix + (row0 + (qb & 1) * 32 + r) * D + 256 + w * 64;
#pragma unroll
            for (int hb = 0; hb < 2; ++hb)
#pragma unroll
                for (int j = 0; j < 2; ++j) {
                    const int ge = 2 * j, go = 2 * j + 1;
                    const u32x2 pe = (u32x2){pk2(o[hb][4 * ge] * rs, o[hb][4 * ge + 1] * rs), pk2(o[hb][4 * ge + 2] * rs, o[hb][4 * ge + 3] * rs)};
                    const u32x2 po = (u32x2){pk2(o[hb][4 * go] * rs, o[hb][4 * go + 1] * rs), pk2(o[hb][4 * go + 2] * rs, o[hb][4 * go + 3] * rs)};
                    const u32x2 keep = hf ? po : pe, send = hf ? pe : po;
                    const unsigned rx = (unsigned)__shfl_xor((int)send.x, 32), ry = (unsigned)__shfl_xor((int)send.y, 32);
                    const u32x4 wv4 = hf ? (u32x4){rx, ry, keep.x, keep.y} : (u32x4){keep.x, keep.y, rx, ry};
                    *(u32x4*)(yp + hb * 32 + 8 * (2 * j + hf)) = wv4;
                }
        }
        __syncthreads();
    }
    for (int rep_ = 0; rep_ < ((PROBE == 13 || PROBE == 14) ? 2 : 1); ++rep_)
    for (int sb = bx - (G - 32); sb >= 0 && sb < 16; sb += G) {
        const size_t srow0 = (size_t)MP + sb * 16;
        const int t0 = w * 2; const float* sa = IN(I_SA) + ((size_t)(l * 16 + sb) * 2) * 256; const float* sc = IN(I_SC) + ((size_t)(l * 16 + sb) * 30) * 256;
        auto ldA = [&](int i) -> f32x4 { const int p = t0 - 2 + i; return p >= 0 ? ld4bf(cv + (srow0 + p) * 256 + 4 * lane) : *(const f32x4*)(sa + (2 + p) * 256 + 4 * lane); };
        auto ldC = [&](int i) -> f32x4 { const int p = t0 - 30 + i; return p >= 0 ? ld4bf(glu + (srow0 + p) * 256 + 4 * lane) : *(const f32x4*)(sc + (30 + p) * 256 + 4 * lane); };
        auto ldG = [&](int t) -> f32x4 { return ld4bf(gb + (srow0 + t0 + t) * 256 + 4 * lane); };
        conv_tokens<2>(l, lds, lane, ldA, ldC, ldC, ldG, ymix + (srow0 + t0) * D);
        float* oc = out + O_CS + ((size_t)(l * 16 + sb) * 30) * 256;
        for (int i = tid; i < 14 * 256; i += NTHR) oc[i] = sc[16 * 256 + i];
    }
    __syncthreads();
    for (int rep_ = 0; rep_ < ((PROBE == 13 || PROBE == 15) ? 2 : 1); ++rep_)
    for (int sb = bx - (G - 16); sb >= 0 && sb < 16; sb += G) {
        const size_t srow0 = (size_t)MP + sb * 16;
        const float* ck = IN(I_CK) + ((size_t)(l * 16 + sb) * 128) * 128; const float* cvv = IN(I_CV) + ((size_t)(l * 16 + sb) * 128) * 128;
        f32x4 kr_[8], vr_[8];
#pragma unroll
        for (int it = 0; it < 8; ++it) { const int i = tid + it * NTHR; kr_[it] = *(const f32x4*)(ck + (size_t)i * 4); vr_[it] = *(const f32x4*)(cvv + (size_t)i * 4); }
        u32x4 kn_ = (u32x4){0u, 0u, 0u, 0u}, vn_ = kn_;
        if (tid < 256) { kn_ = *(const u32x4*)(kb_ + (srow0 + (tid >> 4)) * 128 + (tid & 15) * 8); vn_ = *(const u32x4*)(vS + ((size_t)sb * 16 + (tid >> 4)) * 128 + (tid & 15) * 8); }
        for (int i = tid; i < 128 * 12; i += NTHR) { const int rr = i / 12, pc = i % 12; *(LAS u32x2*)(lds + MX_VOFF + rr * MX_VP + 288 + pc * 8) = (u32x2){0u, 0u}; }
#pragma unroll
        for (int it = 0; it < 8; ++it) {
            const int i = tid + it * NTHR, key = i >> 5, c = (i & 31) * 4;
            *(LAS u32x2*)(lds + (c >> 6) * MX_KSZ + key * 144 + (c & 63) * 2) = (u32x2){pk2(kr_[it][0], kr_[it][1]), pk2(kr_[it][2], kr_[it][3])};
#pragma unroll
            for (int e = 0; e < 4; ++e) *(LAS bf16*)(lds + MX_VOFF + (c + e) * MX_VP + key * 2) = f2bf(vr_[it][e]);
        }
        if (tid < 256) {
            const int key = 128 + (tid >> 4), part = tid & 15;
            *(LAS u32x4*)(lds + (part >> 3) * MX_KSZ + key * 144 + (part & 7) * 16) = kn_;
            const unsigned vw[4] = {vn_.x, vn_.y, vn_.z, vn_.w};
#pragma unroll
            for (int e = 0; e < 8; ++e) *(LAS bf16*)(lds + MX_VOFF + (part * 8 + e) * MX_VP + key * 2) = (bf16)((vw[e >> 1] >> ((e & 1) * 16)) & 0xffffu);
        }
        __syncthreads();
        {
            const int kvh = w >> 2, tq = r & 15;
            const LAS unsigned char* Kl = lds + kvh * MX_KSZ + r * 144 + hf * 16; const LAS unsigned char* Vl = lds + MX_VOFF + (kvh * 64 + r) * MX_VP + hf * 8;
            f32x16 o[2]; attn_qb<true>(Kl, Vl, qb_ + (srow0 + tq) * 512 + w * 64 + hf * 8, sink2, 0, o);
            float sq = 0.f;
#pragma unroll
            for (int hb = 0; hb < 2; ++hb)
#pragma unroll
                for (int i = 0; i < 16; ++i) sq += o[hb][i] * o[hb][i];
            sq += __shfl_xor(sq, 32);
            if (hf == 0) ssb[w * 32 + r] = sq;
            __syncthreads();
            float tot = 0.f;
#pragma unroll
            for (int hh = 0; hh < 8; ++hh) tot += ssb[hh * 32 + r];
            const float rs = rsqrtf(tot * (1.f / 512) + EPS); bf16* yp = ymix + (srow0 + tq) * D + 256 + w * 64 + 4 * hf;
            if (r < 16) {
#pragma unroll
                for (int hb = 0; hb < 2; ++hb)
#pragma unroll
                    for (int g = 0; g < 4; ++g) st4bf(yp + hb * 32 + 8 * g, (f32x4){o[hb][4 * g] * rs, o[hb][4 * g + 1] * rs, o[hb][4 * g + 2] * rs, o[hb][4 * g + 3] * rs});
            }
        }
        __syncthreads();
    }
}

DI void xattn_sample(int wv, unsigned char* ws, float* out, int l, LAS unsigned char* lds, int G, int bx) {
    unsigned z_ = 0u; asm volatile("" : "+v"(z_)); const int tid_ = wv * 64 + (int)__builtin_amdgcn_mbcnt_hi(~0u, __builtin_amdgcn_mbcnt_lo(~0u, z_)); const int tid = tid_, w = __builtin_amdgcn_readfirstlane(tid >> 6), lane = tid & 63, fr = lane & 15, fq = lane >> 4;
    bf16* qx = (bf16*)(ws + WS_R + R_QX);
    LAS float* PS = (LAS float*)lds;
    LAS float* RM = (LAS float*)(lds + 16 * 260 * 4);
    for (int u = bx - (G - 64); u >= 0 && u < 64; u += G) {
        const int sb = u >> 2, h = u & 3; const size_t srow0 = (size_t)MP + sb * 16;
        const float* mk = IN(I_MK) + (((size_t)(l * 16 + sb) * 256) * 4 + h) * 256; const float* mv = IN(I_MV) + (((size_t)(l * 16 + sb) * 256) * 4 + h) * 256;
        f32x4 acc[2] = {(f32x4){0.f, 0.f, 0.f, 0.f}, (f32x4){0.f, 0.f, 0.f, 0.f}};
        const bf16* qp = qx + (srow0 + fr) * D + h * 256 + fq * 8;
#pragma unroll
        for (int ks = 0; ks < 8; ++ks) {
            const bf16x8 qf = *(const bf16x8*)(qp + ks * 32);
#pragma unroll
            for (int kbk = 0; kbk < 2; ++kbk) {
                const float* kp = mk + (size_t)(w * 32 + kbk * 16 + fr) * 1024 + ks * 32 + fq * 8; const f32x4 k0 = *(const f32x4*)kp, k1 = *(const f32x4*)(kp + 4);
                u32x4 kw; kw.x = pk2(k0[0], k0[1]); kw.y = pk2(k0[2], k0[3]); kw.z = pk2(k1[0], k1[1]); kw.w = pk2(k1[2], k1[3]);
                acc[kbk] = __builtin_amdgcn_mfma_f32_16x16x32_bf16(__builtin_bit_cast(bf16x8, kw), qf, acc[kbk], 0, 0, 0);
            }
        }
#pragma unroll
        for (int kbk = 0; kbk < 2; ++kbk)
#pragma unroll
            for (int i = 0; i < 4; ++i) PS[fr * 260 + w * 32 + kbk * 16 + 4 * fq + i] = acc[kbk][i];
        __syncthreads();
#pragma unroll
        for (int tt = 0; tt < 2; ++tt) { LAS float* sp = PS + (2 * w + tt) * 260; const f32x4 x = *(LAS f32x4*)(sp + 4 * lane);
            const float mx = wave_max(fmaxf(fmaxf(x[0], x[1]), fmaxf(x[2], x[3])));
            f32x4 e; for (int i = 0; i < 4; ++i) e[i] = __builtin_amdgcn_exp2f(x[i] - mx);
            const float inv = 1.f / wave_sum((e[0] + e[1]) + (e[2] + e[3]));
            for (int i = 0; i < 4; ++i) e[i] = bf2f(f2bf(e[i] * inv));
            *(LAS f32x4*)(sp + 4 * lane) = e; }
        __syncthreads();
        {
            f32x4 acc[16];
#pragma unroll
            for (int t = 0; t < 16; ++t) acc[t] = (f32x4){0.f, 0.f, 0.f, 0.f};
#pragma unroll 1
            for (int jb = 0; jb < 32; jb += 8) {
                f32x4 vv[8];
#pragma unroll
                for (int jj = 0; jj < 8; ++jj) vv[jj] = *(const f32x4*)(mv + (size_t)(w + 8 * (jb + jj)) * 1024 + 4 * lane);
#pragma unroll
                for (int jj = 0; jj < 8; ++jj) { const int key = w + 8 * (jb + jj);
#pragma unroll
                    for (int t = 0; t < 16; ++t) acc[t] += PS[t * 260 + key] * vv[jj]; }
            }
            LAS float* OP = (LAS float*)(lds + 32768);
#pragma unroll
            for (int half = 0; half < 2; ++half) {
#pragma unroll
                for (int tt = 0; tt < 8; ++tt) *(LAS f32x4*)(OP + (w * 8 + tt) * 256 + 4 * lane) = acc[half * 8 + tt];
                __syncthreads();
                f32x4 sum = (f32x4){0.f, 0.f, 0.f, 0.f};
#pragma unroll
                for (int ww = 0; ww < 8; ++ww) sum += *(LAS f32x4*)(OP + (ww * 8 + w) * 256 + 4 * lane);
                st4bf(qx + (srow0 + half * 8 + w) * D + h * 256 + 4 * lane, sum);
                __syncthreads();
            }
        }
    }
    (void)RM;
}

DI void final_norm(int wv, unsigned char* ws, float* out, LAS unsigned char* lds) {
    unsigned z_ = 0u; asm volatile("" : "+v"(z_)); const int tid_ = wv * 64 + (int)__builtin_amdgcn_mbcnt_hi(~0u, __builtin_amdgcn_mbcnt_lo(~0u, z_)); const int tid = tid_, w = __builtin_amdgcn_readfirstlane(tid >> 6), lane = tid & 63, gw = blockIdx.x * 8 + w, NGW = gridDim.x * 8;
    const bf16* xb = (const bf16*)(ws + WS_XB); const float* ss = (const float*)(ws + WS_SS) + (size_t)8 * MT * 16; const float* g = IN(I_FIN);
    f32x4 gv[4];
#pragma unroll
    for (int j = 0; j < 4; ++j) gv[j] = *((const f32x4*)g + lane + 64 * j);
    for (int m = gw; m < MT; m += NGW) {
        const float rs = rsqrtf(ss_row(ss, m) * (1.f / D) + EPS); float* o = out + (m < MP ? O_YP + (size_t)m * D : O_YS + (size_t)(m - MP) * D);
#pragma unroll
        for (int j = 0; j < 4; ++j) { const f32x4 x = ld4bf(xb + (size_t)m * D + 4 * (lane + 64 * j)); *((f32x4*)o + lane + 64 * j) = x * rs * gv[j]; }
    }
}

#ifndef EN
#define EN 0xFFFFF
#endif
#ifndef ONE_LAUNCH
#define ONE_LAUNCH 1
#endif
constexpr int N_PHASES = 24;

template <int NM, int NN, size_t A_M, size_t A_N, size_t B_B, size_t B_N, int BSHIFT, class F>
DI void run_gemm(int wv, LAS unsigned char* lds, int G, int bx, const bf16* A_, int lda, const bf16* Bt, int ldb, int K, const F& f) {
    pg8::Gemm g{A_, Bt, lda, ldb, K, wv}; pg8::Sched<NM, NN, A_M, A_N, B_B, B_N, BSHIFT> Sc; Sc.G = G; Sc.c = bx;
    EpiA<F> E{f};
    pg8::gemm_phase<EpiA<F>, pg8::Sched<NM, NN, A_M, A_N, B_B, B_N, BSHIFT>, true, true>(lds, g, Sc, E);
}
template <int K, int N, class F> DI void prompt_gemm(int wv, LAS unsigned char* lds, int G, int bx, const bf16* A_, const bf16* Bt, const F& f) {
    run_gemm<MP / 256, N / 256, (size_t)256 * K * 2, 0, 0, (size_t)256 * K * 2, 31>(wv, lds, G, bx, A_, K, Bt, K, K, f);
}


#define XB_TMO      128
#define XB_XCNT(j)  (256  + 64 * (j))
#define XB_XSUB(j)  (1280 + 64 * (j))
#define XB_XGEN(j)  (2304 + 64 * (j))
#define XB_TOP      3328
#define XB_TOPGEN   3392
#define XCD_BAR_WORDS 3456
#define XB_SPIN_CAP (1u << 18)
DI unsigned xb_ld(unsigned* p)              { return __hip_atomic_load(p, __ATOMIC_RELAXED, __HIP_MEMORY_SCOPE_AGENT); }
DI unsigned xb_add(unsigned* p, unsigned v) { return __hip_atomic_fetch_add(p, v, __ATOMIC_RELAXED, __HIP_MEMORY_SCOPE_AGENT); }
DI unsigned xb_xcc_id() { return (unsigned)__builtin_amdgcn_s_getreg((3 << 11) | 20) & 0xFu; }
#define XB_SPIN(cond, bar) do { unsigned _sp = 0; while (cond) { __builtin_amdgcn_s_sleep(1); \
    if ((++_sp & 255u) == 0u) { if (xb_ld(&(bar)[XB_TMO])) break; if (_sp > XB_SPIN_CAP) { atomicAdd(&(bar)[XB_TMO], 1u); break; } } } } while (0)
DI void xcd_barrier_complete(unsigned* bar, unsigned x, unsigned G, unsigned& nloc, unsigned& nx) {
    unsigned sum, cnt, mine, sp = 0u;
    for (;;) {
        sum = 0u; cnt = 0u; mine = 0u;
#pragma unroll
        for (unsigned j = 0; j < 16; ++j) { const unsigned c = xb_ld(&bar[XB_XCNT(j)]); sum += c; cnt += (c > 0u) ? 1u : 0u; mine = (j == x) ? c : mine; }
        if (sum == G) break;
        __builtin_amdgcn_s_sleep(1);
        if ((++sp & 255u) == 0u) { if (xb_ld(&bar[XB_TMO])) break; if (sp > XB_SPIN_CAP) { atomicAdd(&bar[XB_TMO], 1u); break; } }
    }
    nloc = mine > 0u ? mine : 1u; nx = cnt > 0u ? cnt : 1u;
}
DI void xcd_barrier(unsigned* bar, volatile LAS unsigned* st, bool first_thread, unsigned G) {
    asm volatile("s_waitcnt vmcnt(0)" ::: "memory");
    __syncthreads();
    if (first_thread) {
        const unsigned x = xb_xcc_id();
        __builtin_amdgcn_s_waitcnt(0);
        unsigned nloc = st[0], nx = st[1];
        if (nloc == 0u) { xcd_barrier_complete(bar, x, G, nloc, nx); st[0] = nloc; st[1] = nx; }
        const unsigned old = xb_add(&bar[XB_XSUB(x)], 1u);
        const unsigned gen = old / nloc;
        if (old + 1u == (gen + 1u) * nloc) {
            __builtin_amdgcn_fence(__ATOMIC_RELEASE, "agent");
            asm volatile("s_waitcnt vmcnt(0)" ::: "memory");
            const unsigned og = xb_add(&bar[XB_TOP], 1u);
            const unsigned tg = og / nx;
            if (og + 1u == (tg + 1u) * nx) xb_add(&bar[XB_TOPGEN], 1u);
            else XB_SPIN(xb_ld(&bar[XB_TOPGEN]) == tg, bar);
            __builtin_amdgcn_fence(__ATOMIC_ACQUIRE, "agent");
            xb_add(&bar[XB_XGEN(x)], 1u);
            asm volatile("s_waitcnt vmcnt(0)" ::: "memory");
        } else {
            XB_SPIN(xb_ld(&bar[XB_XGEN(x)]) == gen, bar);
            __builtin_amdgcn_fence(__ATOMIC_ACQUIRE, "agent");
            asm volatile("s_waitcnt vmcnt(0)" ::: "memory");
        }
    }
    __syncthreads();
}

__global__ void __launch_bounds__(NTHR, 2) fwd_kernel(Args A) {
    extern __shared__ __attribute__((aligned(16))) unsigned char lds_raw[];
    LAS unsigned char* lds = (LAS unsigned char*)lds_raw;
    const int lo = A.ph_lo, hi = A.ph_hi; const int wv = __builtin_amdgcn_readfirstlane((int)threadIdx.x >> 6);
    unsigned char* ws = A.ws; float* out = A.out;
    if (threadIdx.x == 0) { LAS unsigned long long* T = (LAS unsigned long long*)(lds + LDS_TAB);
        T[0] = (unsigned long long)A.in[0];
        T[1] = (unsigned long long)A.in[1];
        T[2] = (unsigned long long)A.in[2];
        T[3] = (unsigned long long)A.in[3];
        T[4] = (unsigned long long)A.in[4];
        T[5] = (unsigned long long)A.in[5];
        T[6] = (unsigned long long)A.in[6];
        T[7] = (unsigned long long)A.in[7];
        T[8] = (unsigned long long)A.in[8];
        T[9] = (unsigned long long)A.in[9];
        T[10] = (unsigned long long)A.in[10];
        T[11] = (unsigned long long)A.in[11];
        T[12] = (unsigned long long)A.in[12];
        T[13] = (unsigned long long)A.in[13];
        T[14] = (unsigned long long)A.in[14];
        T[15] = (unsigned long long)A.in[15];
        T[16] = (unsigned long long)A.in[16];
        T[17] = (unsigned long long)A.in[17];
        T[18] = (unsigned long long)A.in[18];
        T[19] = (unsigned long long)A.in[19];
        T[20] = (unsigned long long)A.in[20];
        T[21] = (unsigned long long)A.in[21];
        T[22] = (unsigned long long)A.in[22];
        T[23] = (unsigned long long)A.in[23];
        T[24] = (unsigned long long)A.in[24];
        T[25] = (unsigned long long)A.in[25];
        T[26] = (unsigned long long)A.in[26];
        T[27] = (unsigned long long)A.in[27];
        T[28] = (unsigned long long)A.in[28];
        T[29] = (unsigned long long)A.in[29];
        T[30] = (unsigned long long)A.in[30];
        T[31] = (unsigned long long)A.in[31];
        T[32] = (unsigned long long)A.in[32];
        T[33] = (unsigned long long)A.in[33];
        *(LAS unsigned*)(lds + LDS_TAB + 384) = 0u; *(LAS unsigned*)(lds + LDS_TAB + 388) = 0u;
        (void)xb_add(&((unsigned*)ws)[XB_XCNT(xb_xcc_id())], 1u);
    }
    __syncthreads();
#ifndef CG_ALL
#define CG_ALL 0
#endif
#define SYNC(ph) do { if ((ph) + 1 < hi) { if (CG_ALL || (ph) == 0) cg::this_grid().sync(); else for (int rb_ = 0; rb_ < (PROBE == 16 ? 2 : 1); ++rb_) { unsigned z2_ = 0u; asm volatile("" : "+v"(z2_)); const bool ft_ = wv == 0 && __builtin_amdgcn_mbcnt_hi(~0u, __builtin_amdgcn_mbcnt_lo(~0u, z2_)) == 0u; xcd_barrier((unsigned*)ws, (volatile LAS unsigned*)(lds + LDS_TAB + 384), ft_, gridDim.x); } } } while (0)
    if (lo == 0) { if (EN & 0x10000) prologue(wv, ws, out, lds); __syncthreads();
#if PROBE == 3
        prologue(wv, ws, out, lds); __syncthreads();
#endif
        SYNC(0); }
    for (int ph = (lo > 1 ? lo : 1); ph < (hi < N_PHASES - 1 ? hi : N_PHASES - 1); ++ph) {
        int G = gridDim.x, bx = blockIdx.x; asm volatile("" : "+s"(G), "+s"(bx), "+s"(out));
        const int smp_c0 = (bx + G / 2) % G;
        const int l = (ph - 1) / 11, k = (ph - 1) % 11;
        asm volatile("" : "+s"(ws));
        unsigned char* R = ws + WS_R; bf16* xb = (bf16*)(ws + WS_XB); float* ss = (float*)(ws + WS_SS); bf16* hb = (bf16*)(R + R_H);
        unsigned char* wl = ws + WS_W + (size_t)l * LW;
        float* ssl = ss + (size_t)(4 * l) * MT * 16;
        if (!((EN >> k) & 1)) continue;
        switch (k) {
        case 0: case 9: {
            const bool second = k == 9;
            if (!second) {
                FMemKV f{out + O_MK + (size_t)l * 512 * D, out + O_MV + (size_t)l * 512 * D, (bf16*)(ws + WS_MKB) + (size_t)l * 512 * D, (bf16*)(ws + WS_MVT) + (size_t)l * 8 * 65536};
                run_gemm<2, 8, (size_t)256 * D * 2, 0, 0, (size_t)256 * D * 2, 31>(wv, lds, G, bx, (const bf16*)(ws + WS_MN), D, (const bf16*)(wl + W_KV), D, D, f);
                __syncthreads();
            }
            FUp f{ssl + (second ? 3 : 0) * (size_t)MT * 16, hb, (LAS float*)(lds + LDS_EPI)};
#if PROBE == 11
            { FUpCheap f0{hb}; prompt_gemm<D, 2 * FF>(wv, lds, G, bx, xb, (const bf16*)(wl + (second ? W_2 : W_1)), f0); __syncthreads(); }
#endif
            prompt_gemm<D, 2 * FF>(wv, lds, G, bx, xb, (const bf16*)(wl + (second ? W_2 : W_1)), f);
#if PROBE == 1
            __syncthreads(); prompt_gemm<D, 2 * FF>(wv, lds, G, bx, xb, (const bf16*)(wl + (second ? W_2 : W_1)), f);
#endif
            __syncthreads();
            sample_gemm_wide(wv, lds, xb, (const bf16*)(wl + (second ? W_2 : W_1)), 2 * FF / 256, f, G, smp_c0);
        } break;
        case 1: case 10: {
            const bool second = k == 10;
            FRes f{xb, ssl + (second ? 4 : 1) * (size_t)MT * 16, 0.5f};
#if PROBE == 4
            { FRes f0{xb, ssl + (second ? 4 : 1) * (size_t)MT * 16, 0.0f}; prompt_gemm<FF, D>(wv, lds, G, bx, hb, (const bf16*)(wl + (second ? W_D2 : W_D1)), f0); __syncthreads(); }
#endif
            prompt_gemm<FF, D>(wv, lds, G, bx, hb, (const bf16*)(wl + (second ? W_D2 : W_D1)), f);
            __syncthreads();
            sample_gemm<FF>(wv, lds, hb, FF, (const bf16*)(wl + (second ? W_D2 : W_D1)), FF, D / 256, f, G, smp_c0);
        } break;
        case 2: {
            FWin f{ssl + (size_t)MT * 16, ws, out, l, (LAS float*)(lds + LDS_EPI)};
            prompt_gemm<D, 2048>(wv, lds, G, bx, xb, (const bf16*)(wl + W_IN), f);
#if PROBE == 8
            __syncthreads(); prompt_gemm<D, 2048>(wv, lds, G, bx, xb, (const bf16*)(wl + W_IN), f);
#endif
            __syncthreads();
            sample_gemm_wide(wv, lds, xb, (const bf16*)(wl + W_IN), 8, f, G, smp_c0);
        } break;
        case 3: mixer_phase(wv, ws, out, l, lds, G, bx);
#if PROBE == 2
            __syncthreads(); mixer_phase(wv, ws, out, l, lds, G, bx);
#endif
            break;
        case 4: case 8: {
            const bool xo = k == 8;
            FRes f{xb, ssl + (xo ? 3 : 2) * (size_t)MT * 16, 1.0f};
            const bf16* Ain = xo ? (const bf16*)(R + R_QX) : (const bf16*)(R + R_YMIX);
            prompt_gemm<D, D>(wv, lds, G, bx, Ain, (const bf16*)(wl + (xo ? W_O : W_OUT)), f);
            __syncthreads();
            sample_gemm<D>(wv, lds, Ain, D, (const bf16*)(wl + (xo ? W_O : W_OUT)), D, 4, f, G, smp_c0);
        } break;
        case 5: {
            FScale f{ssl + 2 * (size_t)MT * 16, (bf16*)(R + R_QX), 0.0625f * LOG2E, (LAS float*)(lds + LDS_EPI)};
            prompt_gemm<D, D>(wv, lds, G, bx, xb, (const bf16*)(wl + W_Q), f);
#if PROBE == 5
            __syncthreads(); prompt_gemm<D, D>(wv, lds, G, bx, xb, (const bf16*)(wl + W_Q), f);
#endif
            __syncthreads();
            sample_gemm<D>(wv, lds, xb, D, (const bf16*)(wl + W_Q), D, 4, f, G, smp_c0);
#if PROBE == 10
            sample_gemm<D>(wv, lds, xb, D, (const bf16*)(wl + W_Q), D, 4, f, G, smp_c0);
#endif
        } break;
        case 6: {
            pg8::Gemm g{(const bf16*)(R + R_QX), (const bf16*)(ws + WS_MKB) + (size_t)l * 512 * D, D, D, 256, wv};
            typedef pg8::Sched<MP / 256, 4, (size_t)256 * D * 2, 512, (size_t)256 * D * 2, 512, 6> SchS; SchS Sc; Sc.G = G; Sc.c = bx;
            EpiS E{(bf16*)(R + R_P), (float*)(ws + WS_LINV), (LAS float*)(lds + LDS_EPI)};
            pg8::gemm_phase<EpiS, SchS, true, true>(lds, g, Sc, E);
#if PROBE == 9
            __syncthreads(); pg8::gemm_phase<EpiS, SchS, true, true>(lds, g, Sc, E);
#endif
            __syncthreads();
            xattn_sample(wv, ws, out, l, lds, G, bx);
            asm volatile("s_waitcnt vmcnt(0)" ::: "memory"); __syncthreads();
            FPV f{(const float*)(ws + WS_LINV), (bf16*)(R + R_QX)};
            run_gemm<MP / 256, 4, (size_t)256 * D * 2, 512, (size_t)4 * 65536 * 2, (size_t)65536 * 2, 6>(wv, lds, G, bx, (const bf16*)(ws + WS_R + R_P), D, (const bf16*)(ws + WS_MVT) + (size_t)l * 8 * 65536, 256, 256, f);
#if PROBE == 9
            __syncthreads();
            run_gemm<MP / 256, 4, (size_t)256 * D * 2, 512, (size_t)4 * 65536 * 2, (size_t)65536 * 2, 6>(wv, lds, G, bx, (const bf16*)(ws + WS_R + R_P), D, (const bf16*)(ws + WS_MVT) + (size_t)l * 8 * 65536, 256, 256, f);
#endif
        } break;
        case 7: break;
        }
        __syncthreads();
        if (k != 6) SYNC(ph);
    }
    if (hi == N_PHASES) { if (EN & 0x20000) final_norm(wv, ws, out, lds); }
#undef SYNC
}

extern "C" void kernel_launch(void* const* d_in, const int* in_sizes, int n_in, void* d_out, int out_size, void* d_ws, size_t ws_size, hipStream_t stream) {
    static int grid = 0;
    if (grid == 0) {
        if (n_in != 34 || (size_t)out_size != O_END || ws_size < WS_END) { fprintf(stderr, "kernel_launch: unexpected shapes n_in %d out %d ws %zu (need %zu)\n", n_in, out_size, ws_size, (size_t)WS_END); grid = -1; return; }
        int dev = 0, cus = 0, per_cu = 0;
        hipGetDevice(&dev); hipDeviceGetAttribute(&cus, hipDeviceAttributeMultiprocessorCount, dev);
        if (hipFuncSetAttribute((const void*)fwd_kernel, hipFuncAttributeMaxDynamicSharedMemorySize, LDS_BYTES) != hipSuccess) { fprintf(stderr, "kernel_launch: hipFuncSetAttribute failed\n"); grid = -1; return; }
        if (hipOccupancyMaxActiveBlocksPerMultiprocessor(&per_cu, (const void*)fwd_kernel, NTHR, LDS_BYTES) != hipSuccess || per_cu < 1) { fprintf(stderr, "kernel_launch: occupancy query says %d\n", per_cu); per_cu = 1; }
        (void)hipGetLastError();
        grid = cus;
    }
    if (grid < 0) return;
    Args a{};
    for (int i = 0; i < 34; ++i) a.in[i] = (const float*)d_in[i];
    a.out = (float*)d_out; a.ws = (unsigned char*)d_ws;
    if (hipMemsetAsync(d_ws, 0, 16384, stream) != hipSuccess) { fprintf(stderr, "kernel_launch: memset failed\n"); return; }
#if ONE_LAUNCH
    a.ph_lo = 0; a.ph_hi = N_PHASES;
    void* args[] = {&a};
    hipError_t e = hipLaunchCooperativeKernel((const void*)fwd_kernel, dim3(grid), dim3(NTHR), args, LDS_BYTES, stream);
    if (e != hipSuccess) fprintf(stderr, "cooperative launch failed: %s (grid %d)\n", hipGetErrorString(e), grid);
#else
    for (int ph = 0; ph < N_PHASES; ++ph) { a.ph_lo = ph; a.ph_hi = ph + 1; hipLaunchKernelGGL(fwd_kernel, dim3(grid), dim3(NTHR), LDS_BYTES, stream, a); }
#endif
}
```

```cpp
#include <hip/hip_runtime.h>
#include <hip/hip_cooperative_groups.h>
#include <cstdio>
#include <cstdint>
namespace cg = cooperative_groups;
#ifndef PROBE
#define PROBE 0
#endif
namespace pg8 {
#define PG8_LAS __attribute__((address_space(3)))
typedef unsigned short bf16_t;
typedef short bf16x8 __attribute__((ext_vector_type(8)));
typedef float f32x4 __attribute__((ext_vector_type(4)));
typedef unsigned u32x4 __attribute__((ext_vector_type(4)));
constexpr int BM = 256, BK = 64, HALF = 128, HTB = HALF * BK * 2  , STAGE_BYTES = 8 * HTB, NXCD = 8, WGM = 8;

__host__ __device__ __forceinline__ int lds_byte(int r, int c) { const int st = (r >> 4) * 2 + (c >> 5), rr = r & 15, cc = c & 31, ob = rr * 64 + cc * 2; return st * 1024 + (ob ^ (((ob >> 9) & 1) << 5)); }
__host__ __device__ __forceinline__ void stage_rc(int b, int& R, int& C) { const int st = b / 1024, sb = b % 1024, swz = sb ^ (((sb >> 9) & 1) << 5); R = (st >> 1) * 16 + swz / 64; C = (st & 1) * 32 + (swz % 64) / 2; }
__host__ __device__ __forceinline__ int perm32(int rho) { const int n = rho >> 4, i = rho & 15; return 8 * (i >> 2) + 4 * n + (i & 3); }


struct Unit { int pm, pn; size_t aoff, boff; int npm, par; };
struct Gemm { const bf16_t* A; const bf16_t* Bt; int lda, ldb, K, wv; };

template <int NM, int NN, size_t A_M, size_t A_N, size_t B_B, size_t B_N, int BSHIFT> struct Sched {
    int G, c;
    __device__ bool next(int i, Unit& u) const {
        constexpr int nwg = NM * NN;
        const long L = (long)i * G + c; if (L >= nwg) return false;
        int wgid = (int)L; { constexpr int q = nwg / NXCD, r = nwg % NXCD; const int xcd = wgid % NXCD, off = wgid / NXCD; wgid = (xcd < r ? xcd * (q + 1) : r * (q + 1) + (xcd - r) * q) + off; }
        constexpr int nig = WGM * NN; const int gid = wgid / nig, fm = gid * WGM, gsz = (NM - fm) < WGM ? (NM - fm) : WGM;
        u.pm = fm + ((wgid % nig) % gsz); u.pn = (wgid % nig) / gsz;
        u.aoff = (size_t)u.pm * A_M + (size_t)u.pn * A_N; u.boff = (size_t)(u.pm >> BSHIFT) * B_B + (size_t)u.pn * B_N; return true;
    }
    __device__ __forceinline__ void a_ready(const Unit&) const {}
    __device__ __forceinline__ void done(const Unit&) const {}
};
template <class Epi, class Sched, bool ALIGN_EPI = false, bool SP2 = false>
__device__ __forceinline__ void gemm_phase(PG8_LAS unsigned char* lds, const Gemm g, const Sched& S, const Epi& E) {
    unsigned z_ = 0u; asm volatile("" : "+v"(z_)); const int tid_ = g.wv * 64 + (int)__builtin_amdgcn_mbcnt_hi(~0u, __builtin_amdgcn_mbcnt_lo(~0u, z_)); const int tid = tid_, wid = __builtin_amdgcn_readfirstlane(tid >> 6), lane = tid & 63, wr = wid >> 2, wc = wid & 3, fr = lane & 15, fq = lane >> 4;
    const int K = g.K, nt = K / BK;
    unsigned voffA[2], voffB[2];
#pragma unroll
    for (int i = 0; i < 2; ++i) { int R, C; stage_rc(tid * 16 + i * 8192, R, C); const int Rb = Epi::PERM ? ((R & ~31) + perm32(R & 31)) : R;
        voffA[i] = (unsigned)(R * g.lda + C) * 2u; voffB[i] = (unsigned)(Rb * g.ldb + C) * 2u; }
    const size_t kstep = (size_t)(BK * 2);
    const size_t hstepA = (size_t)HALF * g.lda * 2, hstepB = (size_t)HALF * g.ldb * 2;
    const unsigned ldsw = (unsigned)wid * 1024u;
    const int aoff = lds_byte(wr * 64 + fr, fq * 8), boff = lds_byte(wc * 32 + fr, fq * 8);
#define PG8_SA(b, h) (((b) * 2 + (h)) * HTB)
#define PG8_SB(b, h) ((4 + (b) * 2 + (h)) * HTB)
#define PG8_STAGE(bufoff, gbase, voff) do { _Pragma("unroll") for (int _i = 0; _i < 2; ++_i) \
        __builtin_amdgcn_global_load_lds((const unsigned*)((const char*)(gbase) + (voff)[_i]), (PG8_LAS unsigned*)(lds + (bufoff) + ldsw + _i * 8192), 16, 0, 0); } while (0)
#define PG8_LDA(dst, b, h) do { _Pragma("unroll") for (int m = 0; m < 4; ++m) _Pragma("unroll") for (int k = 0; k < 2; ++k) dst[m][k] = *(const PG8_LAS bf16x8*)(lds + PG8_SA(b, h) + aoff + m * 2048 + k * 1024); } while (0)
#define PG8_LDB(dst, b, h) do { _Pragma("unroll") for (int n = 0; n < 2; ++n) _Pragma("unroll") for (int k = 0; k < 2; ++k) dst[n][k] = *(const PG8_LAS bf16x8*)(lds + PG8_SB(b, h) + boff + n * 2048 + k * 1024); } while (0)
#define PG8_MMA(ai, bj, At, Bt) do { __builtin_amdgcn_s_setprio(1); _Pragma("unroll") for (int m = 0; m < 4; ++m) _Pragma("unroll") for (int n = 0; n < 2; ++n) _Pragma("unroll") for (int k = 0; k < 2; ++k) \
        acc[ai][bj][m][n] = __builtin_amdgcn_mfma_f32_16x16x32_bf16(Bt[n][k], At[m][k], acc[ai][bj][m][n], 0, 0, 0); __builtin_amdgcn_s_setprio(0); } while (0)
#define PG8_WAIT_V(n) asm volatile("s_waitcnt vmcnt(" #n ")" ::: "memory")
#define PG8_WAIT_L(n) asm volatile("s_waitcnt lgkmcnt(" #n ")" ::: "memory")
#define PG8_BAR __builtin_amdgcn_s_barrier()
#define PG8_SCHED __builtin_amdgcn_sched_barrier(0)
    Unit cur, nxt; int ui = 0;
    if (!S.next(0, cur)) return;
    f32x4 acc[2][2][4][2];
#pragma unroll
    for (int a = 0; a < 2; ++a)
#pragma unroll
        for (int b = 0; b < 2; ++b)
#pragma unroll
            for (int m = 0; m < 4; ++m)
#pragma unroll
                for (int n = 0; n < 2; ++n) acc[a][b][m][n] = (f32x4){0.f, 0.f, 0.f, 0.f};
    bf16x8 At[4][2], B0[2][2], B1[2][2];
    const char* cA = (const char*)g.A + cur.aoff; const char* cB = (const char*)g.Bt + cur.boff;
    S.a_ready(cur);
    if constexpr (SP2) {
        PG8_STAGE(PG8_SB(0, 0), cB, voffB); PG8_STAGE(PG8_SB(0, 1), cB + hstepB, voffB); PG8_STAGE(PG8_SA(0, 0), cA, voffA); PG8_STAGE(PG8_SA(0, 1), cA + hstepA, voffA);
        if (wr == 1) PG8_BAR;
        PG8_WAIT_V(2); PG8_BAR;
        PG8_STAGE(PG8_SB(1, 0), cB + kstep, voffB); PG8_STAGE(PG8_SA(1, 0), cA + kstep, voffA); PG8_STAGE(PG8_SB(1, 1), cB + hstepB + kstep, voffB);
        PG8_WAIT_V(6); PG8_BAR;
    } else {
        PG8_STAGE(PG8_SB(0, 0), cB, voffB); PG8_STAGE(PG8_SA(0, 0), cA, voffA); PG8_STAGE(PG8_SB(0, 1), cB + hstepB, voffB); PG8_STAGE(PG8_SA(0, 1), cA + hstepA, voffA);
        if (wr == 1) PG8_BAR;
        PG8_WAIT_V(4); PG8_BAR;
        PG8_STAGE(PG8_SB(1, 0), cB + kstep, voffB); PG8_STAGE(PG8_SA(1, 0), cA + kstep, voffA); PG8_STAGE(PG8_SB(1, 1), cB + hstepB + kstep, voffB);
        PG8_WAIT_V(6); PG8_BAR;
    }
    for (;;) {
        const bool has_next = S.next(ui + 1, nxt);
        const char* nA = has_next ? (const char*)g.A + nxt.aoff : cA; const char* nB = has_next ? (const char*)g.Bt + nxt.boff : cB;
#pragma unroll 1
        for (int t = 0; t < nt; t += 2) {
            const bool last = (t == nt - 2);
            const char* a1 = cA + (size_t)(t + 1) * kstep;
            const char* a2 = last ? nA : cA + (size_t)(t + 2) * kstep; const char* b2 = last ? nB : cB + (size_t)(t + 2) * kstep;
            const char* a3 = a2 + kstep; const char* b3 = b2 + kstep;
            if (last && has_next) S.a_ready(nxt);
            if constexpr (SP2) {
            PG8_LDB(B0, 0, 0); PG8_LDB(B1, 0, 1); PG8_SCHED; PG8_LDA(At, 0, 0); PG8_STAGE(PG8_SA(1, 1), a1 + hstepA, voffA);
            PG8_WAIT_V(8); PG8_WAIT_L(0); PG8_BAR; PG8_MMA(0, 0, At, B0); PG8_MMA(0, 1, At, B1); PG8_BAR; PG8_SCHED;
            PG8_LDA(At, 0, 1); PG8_STAGE(PG8_SB(0, 0), b2, voffB); PG8_STAGE(PG8_SB(0, 1), b2 + hstepB, voffB); PG8_STAGE(PG8_SA(0, 0), a2, voffA);
            PG8_WAIT_V(8); PG8_WAIT_L(0); PG8_BAR; PG8_MMA(1, 0, At, B0); PG8_MMA(1, 1, At, B1); PG8_BAR; PG8_SCHED;
            PG8_LDB(B0, 1, 0); PG8_LDB(B1, 1, 1); PG8_SCHED; PG8_LDA(At, 1, 0); PG8_STAGE(PG8_SA(0, 1), a2 + hstepA, voffA);
            PG8_WAIT_V(8); PG8_WAIT_L(0); PG8_BAR; PG8_MMA(0, 0, At, B0); PG8_MMA(0, 1, At, B1); PG8_BAR; PG8_SCHED;
            PG8_LDA(At, 1, 1); PG8_STAGE(PG8_SB(1, 0), b3, voffB); PG8_STAGE(PG8_SB(1, 1), b3 + hstepB, voffB); PG8_STAGE(PG8_SA(1, 0), a3, voffA);
            PG8_WAIT_V(8); PG8_WAIT_L(0); PG8_BAR; PG8_MMA(1, 0, At, B0); PG8_MMA(1, 1, At, B1); PG8_BAR; PG8_SCHED;
            } else {
            PG8_LDB(B0, 0, 0); PG8_SCHED; PG8_LDA(At, 0, 0); PG8_STAGE(PG8_SA(1, 1), a1 + hstepA, voffA);
            PG8_WAIT_L(8); PG8_BAR; PG8_WAIT_L(0); PG8_MMA(0, 0, At, B0); PG8_BAR; PG8_SCHED;
            PG8_LDB(B1, 0, 1); PG8_STAGE(PG8_SB(0, 0), b2, voffB);
            PG8_BAR; PG8_WAIT_L(0); PG8_MMA(0, 1, At, B1); PG8_BAR;
            PG8_LDA(At, 0, 1); PG8_STAGE(PG8_SA(0, 0), a2, voffA);
            PG8_BAR; PG8_WAIT_L(0); PG8_MMA(1, 0, At, B0); PG8_BAR; PG8_SCHED;
            PG8_STAGE(PG8_SB(0, 1), b2 + hstepB, voffB);
            PG8_WAIT_V(6); PG8_BAR; PG8_MMA(1, 1, At, B1); PG8_BAR;
            PG8_LDB(B0, 1, 0); PG8_SCHED; PG8_LDA(At, 1, 0); PG8_STAGE(PG8_SA(0, 1), a2 + hstepA, voffA);
            PG8_WAIT_L(8); PG8_BAR; PG8_WAIT_L(0); PG8_MMA(0, 0, At, B0); PG8_BAR; PG8_SCHED;
            PG8_LDB(B1, 1, 1); PG8_STAGE(PG8_SB(1, 0), b3, voffB);
            PG8_BAR; PG8_WAIT_L(0); PG8_MMA(0, 1, At, B1); PG8_BAR;
            PG8_LDA(At, 1, 1); PG8_STAGE(PG8_SA(1, 0), a3, voffA);
            PG8_BAR; PG8_WAIT_L(0); PG8_MMA(1, 0, At, B0); PG8_BAR; PG8_SCHED;
            PG8_STAGE(PG8_SB(1, 1), b3 + hstepB, voffB);
            PG8_WAIT_V(6); PG8_BAR; PG8_MMA(1, 1, At, B1); PG8_BAR;
            }
        }
        if constexpr (ALIGN_EPI) { if (wr == 0) PG8_BAR; }
        if constexpr (!Epi::AFTER_DRAIN) { E(acc, cur, wr, wc, fr, fq); S.done(cur); }
        if (!has_next) break;
#pragma unroll
        for (int a = 0; a < 2; ++a)
#pragma unroll
            for (int b = 0; b < 2; ++b)
#pragma unroll
                for (int m = 0; m < 4; ++m)
#pragma unroll
                    for (int n = 0; n < 2; ++n) acc[a][b][m][n] = (f32x4){0.f, 0.f, 0.f, 0.f};
        cur = nxt; cA = nA; cB = nB; ++ui;
        if constexpr (ALIGN_EPI) { if (wr == 1) PG8_BAR; }
    }
    PG8_WAIT_V(0);
    if constexpr (!ALIGN_EPI) { if (wr == 0) PG8_BAR; }
    PG8_BAR;
    if constexpr (Epi::AFTER_DRAIN) { E.fused(acc, cur, wr, wc, fr, fq, lds, wid, lane); S.done(cur); }
#undef PG8_SA
#undef PG8_SB
#undef PG8_STAGE
#undef PG8_LDA
#undef PG8_LDB
#undef PG8_MMA
#undef PG8_WAIT_V
#undef PG8_WAIT_L
#undef PG8_BAR
#undef PG8_SCHED
}}

#define DI __device__ __forceinline__
#define LAS __attribute__((address_space(3)))
typedef unsigned short bf16;
typedef short bf16x8 __attribute__((ext_vector_type(8)));
typedef float f32x4 __attribute__((ext_vector_type(4)));
typedef float f32x16 __attribute__((ext_vector_type(16)));
typedef unsigned u32x4 __attribute__((ext_vector_type(4)));
typedef unsigned u32x2 __attribute__((ext_vector_type(2)));
typedef __bf16 bf16x2_t __attribute__((ext_vector_type(2)));
typedef float f32x2_t __attribute__((ext_vector_type(2)));
using pg8::Unit;

constexpr int D = 1024, S = 16384, NB = 2, MP = NB * S, MS = 256, MT = MP + MS, FF = 2816, NL = 2, NTHR = 512;
constexpr float EPS = 1e-6f, LOG2E = 1.4426950408889634f;
constexpr size_t MiB = 1u << 20;
constexpr size_t WS_SS_OLD = 0;
constexpr size_t WS_LINV = 2 * MiB;
constexpr size_t WS_ROPE = 3 * MiB;
constexpr size_t WS_MN = 7 * MiB;
constexpr size_t WS_MKB = 8 * MiB;
constexpr size_t WS_MVT = 10 * MiB;
constexpr size_t WS_W = 12 * MiB, LW = 47 * MiB;
constexpr size_t W_1 = 0, W_D1 = 11 * MiB, W_IN = W_D1 + 11 * MiB / 2, W_OUT = W_IN + 4 * MiB, W_Q = W_OUT + 2 * MiB, W_O = W_Q + 2 * MiB, W_2 = W_O + 2 * MiB, W_D2 = W_2 + 11 * MiB, W_KV = W_D2 + 11 * MiB / 2;
static_assert(W_KV + 4 * MiB == LW, "weights map");
constexpr size_t WS_XB = WS_W + 2 * LW;
constexpr size_t WS_R = WS_XB + 65 * MiB;
constexpr size_t R_H = 0;
constexpr size_t R_GB = 0, R_CV = R_GB + (size_t)MT * 256 * 2, R_Q = R_CV + (size_t)MT * 256 * 2, R_K = R_Q + (size_t)MT * 512 * 2, R_VT = R_K + (size_t)MT * 128 * 2,
                 R_VS = R_VT + (size_t)NB * 128 * S * 2, R_GLU = R_VS + (size_t)MS * 128 * 2, R_YMIX = 101 * MiB;
static_assert(R_GLU + (size_t)MT * 256 * 2 <= R_YMIX, "R map");
constexpr size_t R_QX = 0, R_P = 68 * MiB;
constexpr size_t WS_SS = WS_R + 178 * MiB;
constexpr size_t WS_END = WS_SS + 19 * MiB;
static_assert((size_t)9 * MT * 64 <= 19 * MiB, "ss");
static_assert((size_t)MT * FF * 2 <= 178 * MiB && (size_t)MT * D * 2 <= 65 * MiB, "sizes");
constexpr size_t O_YP = 0, O_YS = O_YP + (size_t)MP * D, O_KP = O_YS + (size_t)MS * D, O_VP = O_KP + 65536, O_AP = O_VP + 65536, O_CP = O_AP + 2048, O_MK = O_CP + 30720,
                 O_MV = O_MK + 1048576, O_KS = O_MV + 1048576, O_VS = O_KS + 65536, O_AS = O_VS + 65536, O_CS = O_AS + 16384, O_END = O_CS + 245760;
constexpr int LDS_BYTES = 162816, LDS_EPI = 131072, LDS_TAB = 162816 - 512;

struct Args { const float* in[34]; float* out; unsigned char* ws; int ph_lo, ph_hi; };
enum { I_XP = 0, I_XS, I_CK, I_CV, I_SA, I_SC, I_MK, I_MV, I_MEM, I_F1N, I_F1G, I_F1U, I_F1D, I_MIXN, I_WIN, I_CAW, I_SINK, I_CCW, I_CCB, I_LNG, I_LNB, I_MON, I_WOUT,
       I_XAN, I_MEMN, I_WQ, I_WK, I_WV, I_WO, I_F2N, I_F2G, I_F2U, I_F2D, I_FIN };

DI const float* tab_ptr(LAS unsigned char* lds, int idx) { const u32x2 v = *((const LAS u32x2*)(lds + LDS_TAB) + idx); const unsigned lo = __builtin_amdgcn_readfirstlane(v.x), hi = __builtin_amdgcn_readfirstlane(v.y); return (const float*)(((unsigned long long)hi << 32) | lo); }
#define IN(idx) tab_ptr(lds, idx)
DI float ss_row(const float* ss, int row) { const f32x4* p = (const f32x4*)(ss + (size_t)row * 16); const f32x4 a = p[0], b = p[1], c = p[2], d = p[3]; return (((a[0] + a[1]) + (a[2] + a[3])) + ((b[0] + b[1]) + (b[2] + b[3]))) + (((c[0] + c[1]) + (c[2] + c[3])) + ((d[0] + d[1]) + (d[2] + d[3]))); }
DI float bf2f(unsigned short b) { return __uint_as_float((unsigned)b << 16); }
DI unsigned pk2(float lo, float hi) { f32x2_t v = {lo, hi}; bf16x2_t b = __builtin_convertvector(v, bf16x2_t); return __builtin_bit_cast(unsigned, b); }
DI bf16 f2bf(float f) { return (bf16)(pk2(f, 0.f) & 0xffffu); }
DI void st4bf(bf16* p, f32x4 v) { u32x2 w; w.x = pk2(v[0], v[1]); w.y = pk2(v[2], v[3]); *(u32x2*)p = w; }
DI f32x4 unpk4(u32x2 w) { return (f32x4){__uint_as_float(w.x << 16), __uint_as_float(w.x & 0xffff0000u), __uint_as_float(w.y << 16), __uint_as_float(w.y & 0xffff0000u)}; }
DI f32x4 ld4bf(const bf16* p) { return unpk4(*(const u32x2*)p); }
DI void st8bf(bf16* p, f32x4 a, f32x4 b) { u32x4 w; w.x = pk2(a[0], a[1]); w.y = pk2(a[2], a[3]); w.z = pk2(b[0], b[1]); w.w = pk2(b[2], b[3]); *(u32x4*)p = w; }
DI float dpp_f(float v, const int ctrl_tag);
template <int CTRL> DI float dppx(float v) { return __builtin_bit_cast(float, __builtin_amdgcn_update_dpp(0, __builtin_bit_cast(int, v), CTRL, 0xf, 0xf, true)); }
DI float wave_sum(float v) {
    v += dppx<0xB1>(v); v += dppx<0x4E>(v); v += dppx<0x141>(v); v += dppx<0x140>(v);
    const float a = __builtin_bit_cast(float, __builtin_amdgcn_readlane(__builtin_bit_cast(int, v), 0)), b = __builtin_bit_cast(float, __builtin_amdgcn_readlane(__builtin_bit_cast(int, v), 16)),
                c = __builtin_bit_cast(float, __builtin_amdgcn_readlane(__builtin_bit_cast(int, v), 32)), d = __builtin_bit_cast(float, __builtin_amdgcn_readlane(__builtin_bit_cast(int, v), 48));
    return (a + b) + (c + d);
}
DI float wave_max(float v) {
#pragma unroll
    for (int o = 1; o < 64; o <<= 1) v = fmaxf(v, __shfl_xor(v, o));
    return v;
}
DI float sigmoidf_(float x) { return __builtin_amdgcn_rcpf(1.f + __builtin_amdgcn_exp2f(-LOG2E * x)); }
#define LDS_WAIT() asm volatile("s_waitcnt lgkmcnt(0)" ::: "memory")
#define EPI_BAR() do { asm volatile("s_waitcnt lgkmcnt(0)" ::: "memory"); __builtin_amdgcn_s_barrier(); asm volatile("" ::: "memory"); } while (0)

template <class F> struct EpiA {
    static constexpr bool PERM = F::PERM, AFTER_DRAIN = false; F f;
    template <int KIND> DI void body(const f32x4 (&acc)[2][2][4][2], const Unit& u, int wr, int wc, int fr, int fq) const {
#pragma unroll
        for (int ai = 0; ai < 2; ++ai)
#pragma unroll
            for (int m = 0; m < 4; ++m) {
                const int lr = ai * 128 + wr * 64 + m * 16 + fr, row = u.pm * 256 + lr; typename F::Row rc; f.row_begin(rc, row, u.pn, lr);
                if constexpr (F::PERM) f.template apply8<KIND>(rc, row, u.pn, wc * 32 + fq * 8, acc[ai][0][m][0], acc[ai][0][m][1], acc[ai][1][m][0], acc[ai][1][m][1]);
                else {
#pragma unroll
                for (int n = 0; n < 2; ++n) f.template apply<KIND>(rc, row, u.pn, wc * 32 + n * 16 + fq * 4, acc[ai][0][m][n], acc[ai][1][m][n]); }
                f.row_end(rc, row, u.pn, fq, wc);
            }
    }
    DI void operator()(const f32x4 (&acc)[2][2][4][2], const Unit& u, int wr, int wc, int fr, int fq) const {
        asm volatile("" : "+v"(fr), "+v"(fq));
        if constexpr (F::USE_SS) {
            const int t = (wr * 4 + wc) * 64 + fq * 16 + fr;
            if (t < 256) f.rsl[t] = rsqrtf(ss_row(f.ss, u.pm * 256 + t) * (1.f / D) + EPS);
            EPI_BAR();
        }
        if constexpr (F::NKIND == 1) body<0>(acc, u, wr, wc, fr, fq);
        else { const int kd = f.kind(u.pn);
            if (kd == 0) body<0>(acc, u, wr, wc, fr, fq); else if (kd == 1) body<1>(acc, u, wr, wc, fr, fq);
            else if constexpr (F::NKIND > 2) { if (kd == 2) body<2>(acc, u, wr, wc, fr, fq); else if (kd == 3) body<3>(acc, u, wr, wc, fr, fq); else body<4>(acc, u, wr, wc, fr, fq); } }    }
};
template <class F> DI void apply_two(const F& f, int row, int pn, int c, const f32x4 (&v0)[2], const f32x4 (&v1)[2], int fq, int sub) {
    typename F::Row rc; f.row_begin(rc, row, pn, -1);
#pragma unroll
    for (int wb = 0; wb < 2; ++wb) {
        if constexpr (F::NKIND == 1) f.template apply<0>(rc, row, pn, c + wb * 16, v0[wb], v1[wb]);
        else { const int kd = f.kind(pn);
            if (kd == 0) f.template apply<0>(rc, row, pn, c + wb * 16, v0[wb], v1[wb]); else if (kd == 1) f.template apply<1>(rc, row, pn, c + wb * 16, v0[wb], v1[wb]);
            else if constexpr (F::NKIND > 2) { if (kd == 2) f.template apply<2>(rc, row, pn, c + wb * 16, v0[wb], v1[wb]); else if (kd == 3) f.template apply<3>(rc, row, pn, c + wb * 16, v0[wb], v1[wb]); else f.template apply<4>(rc, row, pn, c + wb * 16, v0[wb], v1[wb]); } }
    }
    f.row_end(rc, row, pn, fq, sub);
}

struct FUp {
    static constexpr int NKIND = 1; static constexpr bool USE_SS = true, PERM = true; const float* ss; bf16* h; LAS float* rsl;
    struct Row { float rs; };
    DI void row_begin(Row& rc, int row, int, int lr) const { rc.rs = lr >= 0 ? rsl[lr] : rsqrtf(ss_row(ss, row) * (1.f / D) + EPS); }
    template <int> DI void apply(const Row& rc, int row, int pn, int c, f32x4 v0, f32x4 v1) const {
        f32x4 o;
#pragma unroll
        for (int e = 0; e < 4; ++e) { const float g = v0[e] * rc.rs, u = v1[e] * rc.rs; o[e] = g * sigmoidf_(g) * u; }
        st4bf(h + (size_t)row * FF + pn * 128 + c, o);
    }
    template <int> DI void apply8(const Row& rc, int row, int pn, int c, f32x4 g0, f32x4 g1, f32x4 u0, f32x4 u1) const {
        f32x4 o0, o1;
#pragma unroll
        for (int e = 0; e < 4; ++e) { const float ga = g0[e] * rc.rs, gb = g1[e] * rc.rs; o0[e] = ga * sigmoidf_(ga) * (u0[e] * rc.rs); o1[e] = gb * sigmoidf_(gb) * (u1[e] * rc.rs); }
        st8bf(h + (size_t)row * FF + pn * 128 + c, o0, o1);
    }
    DI void row_end(const Row&, int, int, int, int) const {}
};
struct FUpCheap {
    static constexpr int NKIND = 1; static constexpr bool USE_SS = false, PERM = false; bf16* h;
    struct Row { float rs; };
    DI void row_begin(Row&, int, int, int) const {}
    template <int> DI void apply(const Row&, int row, int pn, int c, f32x4 v0, f32x4 v1) const { st4bf(h + (size_t)row * FF + pn * 128 + c, v0 + v1); }
    DI void row_end(const Row&, int, int, int, int) const {}
};
struct FRes {
    static constexpr int NKIND = 1; static constexpr bool USE_SS = false, PERM = true; bf16* xb; float* ssn; float alpha;
    struct Row { float a; };
    DI void row_begin(Row& rc, int, int, int) const { rc.a = 0.f; }
    template <int> DI void apply(Row& rc, int row, int pn, int c, f32x4 v0, f32x4 v1) const {
#pragma unroll
        for (int bj = 0; bj < 2; ++bj) {
            bf16* p = xb + (size_t)row * D + pn * 256 + bj * 128 + c; const f32x4 x = ld4bf(p); const f32x4 v = bj ? v1 : v0;
            u32x2 w; w.x = pk2(x[0] + alpha * v[0], x[1] + alpha * v[1]); w.y = pk2(x[2] + alpha * v[2], x[3] + alpha * v[3]); *(u32x2*)p = w;
            const f32x4 r = unpk4(w); rc.a += (r[0] * r[0] + r[1] * r[1]) + (r[2] * r[2] + r[3] * r[3]);
        }
    }
    template <int> DI void apply8(Row& rc, int row, int pn, int c, f32x4 a0, f32x4 a1, f32x4 b0, f32x4 b1) const {
#pragma unroll
        for (int bj = 0; bj < 2; ++bj) {
            bf16* p = xb + (size_t)row * D + pn * 256 + bj * 128 + c; const u32x4 xw = *(const u32x4*)p; const f32x4 x0 = unpk4((u32x2){xw.x, xw.y}), x1 = unpk4((u32x2){xw.z, xw.w});
            const f32x4 v0 = bj ? b0 : a0, v1 = bj ? b1 : a1;
            u32x4 w; w.x = pk2(x0[0] + alpha * v0[0], x0[1] + alpha * v0[1]); w.y = pk2(x0[2] + alpha * v0[2], x0[3] + alpha * v0[3]); w.z = pk2(x1[0] + alpha * v1[0], x1[1] + alpha * v1[1]); w.w = pk2(x1[2] + alpha * v1[2], x1[3] + alpha * v1[3]);
            *(u32x4*)p = w; const f32x4 r0 = unpk4((u32x2){w.x, w.y}), r1 = unpk4((u32x2){w.z, w.w});
            rc.a += ((r0[0] * r0[0] + r0[1] * r0[1]) + (r0[2] * r0[2] + r0[3] * r0[3])) + ((r1[0] * r1[0] + r1[1] * r1[1]) + (r1[2] * r1[2] + r1[3] * r1[3]));
        }
    }
    DI void row_end(const Row& rc, int row, int pn, int fq, int sub) const { float s = rc.a; s += __shfl_xor(s, 16); s += __shfl_xor(s, 32); if (fq == 0) ssn[(size_t)row * 16 + pn * 4 + sub] = s; }
};
struct FScale {
    static constexpr int NKIND = 1; static constexpr bool USE_SS = true, PERM = true; const float* ss; bf16* o; float sc; LAS float* rsl;
    struct Row { float rs; };
    DI void row_begin(Row& rc, int row, int, int lr) const { rc.rs = (lr >= 0 ? rsl[lr] : rsqrtf(ss_row(ss, row) * (1.f / D) + EPS)) * sc; }
    template <int> DI void apply(const Row& rc, int row, int pn, int c, f32x4 v0, f32x4 v1) const {
        st4bf(o + (size_t)row * D + pn * 256 + c, v0 * rc.rs); st4bf(o + (size_t)row * D + pn * 256 + 128 + c, v1 * rc.rs);
    }
    template <int> DI void apply8(const Row& rc, int row, int pn, int c, f32x4 a0, f32x4 a1, f32x4 b0, f32x4 b1) const { st8bf(o + (size_t)row * D + pn * 256 + c, a0 * rc.rs, a1 * rc.rs); st8bf(o + (size_t)row * D + pn * 256 + 128 + c, b0 * rc.rs, b1 * rc.rs); }
    DI void row_end(const Row&, int, int, int, int) const {}
};
struct FPV {
    static constexpr int NKIND = 1; static constexpr bool USE_SS = false, PERM = true; const float* linv; bf16* o;
    struct Row { float s; };
    DI void row_begin(Row& rc, int row, int pn, int) const { rc.s = linv[(size_t)row * 4 + pn]; }
    template <int> DI void apply(const Row& rc, int row, int pn, int c, f32x4 v0, f32x4 v1) const {
        st4bf(o + (size_t)row * D + pn * 256 + c, v0 * rc.s); st4bf(o + (size_t)row * D + pn * 256 + 128 + c, v1 * rc.s);
    }
    template <int> DI void apply8(const Row& rc, int row, int pn, int c, f32x4 a0, f32x4 a1, f32x4 b0, f32x4 b1) const { st8bf(o + (size_t)row * D + pn * 256 + c, a0 * rc.s, a1 * rc.s); st8bf(o + (size_t)row * D + pn * 256 + 128 + c, b0 * rc.s, b1 * rc.s); }
    DI void row_end(const Row&, int, int, int, int) const {}
};
struct FMemKV {
    static constexpr int NKIND = 2; static constexpr bool USE_SS = false, PERM = false; float* ok; float* ov; bf16* mkb; bf16* mvt;
    struct Row { int d; };
    DI int kind(int pn) const { return pn < 4 ? 0 : 1; }
    DI void row_begin(Row&, int, int, int) const {}
    template <int KIND> DI void apply(const Row&, int row, int pn, int c, f32x4 v0, f32x4 v1) const {
        if constexpr (KIND == 0) {
#pragma unroll
            for (int bj = 0; bj < 2; ++bj) { const int col = pn * 256 + bj * 128 + c; const f32x4 v = bj ? v1 : v0; *(f32x4*)(ok + (size_t)row * D + col) = v; st4bf(mkb + (size_t)row * D + col, v); }
        } else {
            const int h = pn - 4, b = row >> 8, mem = row & 255;
#pragma unroll
            for (int bj = 0; bj < 2; ++bj) { const int dd = bj * 128 + c; const f32x4 v = bj ? v1 : v0; *(f32x4*)(ov + (size_t)row * D + h * 256 + dd) = v;
#pragma unroll
                for (int e = 0; e < 4; ++e) mvt[((size_t)(b * 4 + h) * 256 + dd + e) * 256 + mem] = f2bf(v[e]); }
        }
    }
    DI void row_end(const Row&, int, int, int, int) const {}
};
struct FWin {
    static constexpr int NKIND = 5; static constexpr bool USE_SS = true, PERM = true; const float* ss; unsigned char* ws; float* out; int l; LAS float* rsl;
    struct Row { float rs; int pos, b, t; bool smp; };
    DI int kind(int pn) const { return pn == 0 ? 0 : pn <= 2 ? 1 : pn <= 4 ? 2 : pn == 5 ? 3 : 4; }
    DI void row_begin(Row& rc, int row, int, int lr) const {
        rc.rs = lr >= 0 ? rsl[lr] : rsqrtf(ss_row(ss, row) * (1.f / D) + EPS);
        if (row < MP) { rc.smp = false; rc.b = row >> 14; rc.pos = row & (S - 1); rc.t = 0; } else { const int sr = row - MP; rc.smp = true; rc.b = sr >> 4; rc.t = sr & 15; rc.pos = 1024 + rc.t; }
    }
    template <int KIND> DI void apply(const Row& rc, int row, int pn, int c, f32x4 v0, f32x4 v1) const {
        unsigned char* R = ws + WS_R; const f32x4 a0 = v0 * rc.rs, a1 = v1 * rc.rs;
        if constexpr (KIND == 0) { bf16* gb = (bf16*)(R + R_GB) + (size_t)row * 256 + c; st4bf(gb, a0); st4bf(gb + 128, a1); }
        else if constexpr (KIND == 1) {
            const int ch = (pn - 1) * 128 + c; const f32x4 p = a0 * a1; st4bf((bf16*)(R + R_CV) + (size_t)row * 256 + ch, p);
            if (!rc.smp) { if (rc.pos >= S - 2) *(f32x4*)(out + O_AP + (size_t)l * 1024 + (size_t)(rc.b * 2 + rc.pos - (S - 2)) * 256 + ch) = p; }
            else if (rc.t >= 14) *(f32x4*)(out + O_AS + (size_t)l * 8192 + (size_t)(rc.b * 2 + rc.t - 14) * 256 + ch) = p;
        } else if constexpr (KIND == 2 || KIND == 3) {
            const int blk = c >> 5, i = c & 31;
            if (KIND == 3 && blk >= 2) {
                const int kvh = blk - 2;
                if (!rc.smp) {
                    bf16* vT = (bf16*)(R + R_VT) + ((size_t)(rc.b * 2 + kvh) * 64 + i) * S + rc.pos;
#pragma unroll
                    for (int e = 0; e < 4; ++e) { vT[(size_t)e * S] = f2bf(a0[e]); vT[(size_t)(32 + e) * S] = f2bf(a1[e]); }
                    if (rc.pos >= S - 128) { float* o = out + O_VP + (size_t)l * 32768 + ((size_t)(rc.b * 128 + rc.pos - (S - 128)) * 2 + kvh) * 64 + i; *(f32x4*)o = a0; *(f32x4*)(o + 32) = a1; }
                } else {
                    bf16* p = (bf16*)(R + R_VS) + (size_t)(row - MP) * 128 + kvh * 64 + i; st4bf(p, a0); st4bf(p + 32, a1);
                    float* o = out + O_VS + (size_t)l * 32768 + ((size_t)(rc.b * 16 + rc.t) * 2 + kvh) * 64 + i; *(f32x4*)o = a0; *(f32x4*)(o + 32) = a1;
                }
            } else {
                const float* rcos = (const float*)(ws + WS_ROPE) + (size_t)rc.pos * 32 + i;
                const f32x4 cs = *(const f32x4*)rcos, sn = *(const f32x4*)(rcos + (size_t)S * 32);
                const f32x4 o1 = a0 * cs - a1 * sn, o2 = a1 * cs + a0 * sn;
                if constexpr (KIND == 2) { const int head = (pn - 3) * 4 + blk; const float QS = 0.125f * LOG2E; bf16* p = (bf16*)(R + R_Q) + (size_t)row * 512 + head * 64 + i; st4bf(p, o1 * QS); st4bf(p + 32, o2 * QS); }
                else {
                    bf16* p = (bf16*)(R + R_K) + (size_t)row * 128 + blk * 64 + i; st4bf(p, o1); st4bf(p + 32, o2);
                    if (!rc.smp) { if (rc.pos >= S - 128) { float* o = out + O_KP + (size_t)l * 32768 + ((size_t)(rc.b * 128 + rc.pos - (S - 128)) * 2 + blk) * 64 + i; *(f32x4*)o = o1; *(f32x4*)(o + 32) = o2; } }
                    else { float* o = out + O_KS + (size_t)l * 32768 + ((size_t)(rc.b * 16 + rc.t) * 2 + blk) * 64 + i; *(f32x4*)o = o1; *(f32x4*)(o + 32) = o2; }
                }
            }
        } else {
            const int ch = (pn - 6) * 128 + c; f32x4 g;
#pragma unroll
            for (int e = 0; e < 4; ++e) g[e] = a0[e] * sigmoidf_(a1[e]);
            st4bf((bf16*)(R + R_GLU) + (size_t)row * 256 + ch, g);
            if (!rc.smp) { if (rc.pos >= S - 30) *(f32x4*)(out + O_CP + (size_t)l * 15360 + (size_t)(rc.b * 30 + rc.pos - (S - 30)) * 256 + ch) = g; }
            else *(f32x4*)(out + O_CS + (size_t)l * 122880 + (size_t)(rc.b * 30 + 14 + rc.t) * 256 + ch) = g;
        }
    }
    template <int KIND> DI void apply8(const Row& rc, int row, int pn, int c, f32x4 v0a, f32x4 v0b, f32x4 v1a, f32x4 v1b) const {
        unsigned char* R = ws + WS_R; const f32x4 a0 = v0a * rc.rs, a1 = v0b * rc.rs, b0 = v1a * rc.rs, b1 = v1b * rc.rs;
        if constexpr (KIND == 0) { bf16* gb = (bf16*)(R + R_GB) + (size_t)row * 256 + c; st8bf(gb, a0, a1); st8bf(gb + 128, b0, b1); }
        else if constexpr (KIND == 1) {
            const int ch = (pn - 1) * 128 + c; const f32x4 p0 = a0 * b0, p1 = a1 * b1; st8bf((bf16*)(R + R_CV) + (size_t)row * 256 + ch, p0, p1);
            if (rc.pos >= S - 2) { float* o = out + O_AP + (size_t)l * 1024 + (size_t)(rc.b * 2 + rc.pos - (S - 2)) * 256 + ch; *(f32x4*)o = p0; *(f32x4*)(o + 4) = p1; }
        } else if constexpr (KIND == 2 || KIND == 3) {
            const int blk = c >> 5, i = c & 31;
            if (KIND == 3 && blk >= 2) { apply<3>(rc, row, pn, c, v0a, v1a); apply<3>(rc, row, pn, c + 4, v0b, v1b); }
            else {
                const float* rcos = (const float*)(ws + WS_ROPE) + (size_t)rc.pos * 32 + i; const float* rsin = rcos + (size_t)S * 32;
                const f32x4 c0 = *(const f32x4*)rcos, c1 = *(const f32x4*)(rcos + 4), s0 = *(const f32x4*)rsin, s1 = *(const f32x4*)(rsin + 4);
                const f32x4 o1a = a0 * c0 - b0 * s0, o1b = a1 * c1 - b1 * s1, o2a = b0 * c0 + a0 * s0, o2b = b1 * c1 + a1 * s1;
                if constexpr (KIND == 2) { const int head = (pn - 3) * 4 + blk; const float QS = 0.125f * LOG2E; bf16* p = (bf16*)(R + R_Q) + (size_t)row * 512 + head * 64 + i; st8bf(p, o1a * QS, o1b * QS); st8bf(p + 32, o2a * QS, o2b * QS); }
                else {
                    bf16* p = (bf16*)(R + R_K) + (size_t)row * 128 + blk * 64 + i; st8bf(p, o1a, o1b); st8bf(p + 32, o2a, o2b);
                    if (rc.pos >= S - 128) { float* o = out + O_KP + (size_t)l * 32768 + ((size_t)(rc.b * 128 + rc.pos - (S - 128)) * 2 + blk) * 64 + i; *(f32x4*)o = o1a; *(f32x4*)(o + 4) = o1b; *(f32x4*)(o + 32) = o2a; *(f32x4*)(o + 36) = o2b; }
                }
            }
        } else {
            const int ch = (pn - 6) * 128 + c; f32x4 g0, g1;
#pragma unroll
            for (int e = 0; e < 4; ++e) { g0[e] = a0[e] * sigmoidf_(b0[e]); g1[e] = a1[e] * sigmoidf_(b1[e]); }
            st8bf((bf16*)(R + R_GLU) + (size_t)row * 256 + ch, g0, g1);
            if (rc.pos >= S - 30) { float* o = out + O_CP + (size_t)l * 15360 + (size_t)(rc.b * 30 + rc.pos - (S - 30)) * 256 + ch; *(f32x4*)o = g0; *(f32x4*)(o + 4) = g1; }
        }
    }
    DI void row_end(const Row&, int, int, int, int) const {}
};
struct EpiS {
    static constexpr bool PERM = true, AFTER_DRAIN = false;
    bf16* P; float* linv; LAS float* sc;
    DI void operator()(const f32x4 (&acc)[2][2][4][2], const Unit& u, int wr, int wc, int fr, int fq) const {
        LAS float* Pm = sc; LAS float* Ps = sc + 1024;
#pragma unroll
        for (int ai = 0; ai < 2; ++ai)
#pragma unroll
            for (int m = 0; m < 4; ++m) {
                float mx = -3.0e38f;
#pragma unroll
                for (int bj = 0; bj < 2; ++bj)
#pragma unroll
                    for (int n = 0; n < 2; ++n) { const f32x4 x = acc[ai][bj][m][n]; mx = fmaxf(mx, fmaxf(fmaxf(x[0], x[1]), fmaxf(x[2], x[3]))); }
                mx = fmaxf(mx, __shfl_xor(mx, 16)); mx = fmaxf(mx, __shfl_xor(mx, 32));
                if (fq == 0) Pm[(ai * 128 + wr * 64 + m * 16 + fr) * 4 + wc] = mx;
            }
        EPI_BAR();
#pragma unroll
        for (int ai = 0; ai < 2; ++ai)
#pragma unroll
            for (int m = 0; m < 4; ++m) {
                const int r = ai * 128 + wr * 64 + m * 16 + fr; const f32x4 m4 = *(LAS f32x4*)(Pm + r * 4);
                const float mx = fmaxf(fmaxf(m4[0], m4[1]), fmaxf(m4[2], m4[3])); float sum = 0.f;
                bf16* prow = P + (size_t)(u.pm * 256 + r) * D + u.pn * 256 + wc * 32 + fq * 8;
#pragma unroll
                for (int bj = 0; bj < 2; ++bj) {
                    const f32x4 x = acc[ai][bj][m][0], y = acc[ai][bj][m][1]; u32x4 w;
                    w.x = pk2(__builtin_amdgcn_exp2f(x[0] - mx), __builtin_amdgcn_exp2f(x[1] - mx)); w.y = pk2(__builtin_amdgcn_exp2f(x[2] - mx), __builtin_amdgcn_exp2f(x[3] - mx));
                    w.z = pk2(__builtin_amdgcn_exp2f(y[0] - mx), __builtin_amdgcn_exp2f(y[1] - mx)); w.w = pk2(__builtin_amdgcn_exp2f(y[2] - mx), __builtin_amdgcn_exp2f(y[3] - mx));
                    *(u32x4*)(prow + bj * 128) = w; const f32x4 p0 = unpk4((u32x2){w.x, w.y}), p1 = unpk4((u32x2){w.z, w.w}); sum += ((p0[0] + p0[1]) + (p0[2] + p0[3])) + ((p1[0] + p1[1]) + (p1[2] + p1[3]));
                }
                sum += __shfl_xor(sum, 16); sum += __shfl_xor(sum, 32);
                if (fq == 0) Ps[r * 4 + wc] = sum;
            }
        EPI_BAR();
        const int tid = (wr * 4 + wc) * 64 + fq * 16 + fr;
        if (tid < 256) { const f32x4 s4 = *(LAS f32x4*)(Ps + tid * 4); linv[(size_t)(u.pm * 256 + tid) * 4 + u.pn] = 1.f / ((s4[0] + s4[1]) + (s4[2] + s4[3])); }
    }
};

template <int K, class F> DI void sample_gemm(int wv, LAS unsigned char* lds, const bf16* A, int lda, const bf16* Bt, int ldb, int nN, const F& f, int G, int c0) {
    unsigned z_ = 0u; asm volatile("" : "+v"(z_)); const int tid_ = wv * 64 + (int)__builtin_amdgcn_mbcnt_hi(~0u, __builtin_amdgcn_mbcnt_lo(~0u, z_)); const int tid = tid_, w = __builtin_amdgcn_readfirstlane(tid >> 6), lane = tid & 63, fr = lane & 15, fq = lane >> 4;
    LAS float* red = (LAS float*)lds;
    constexpr int kw = K / 8, NKS = kw / 32, KB = 4;
    const int n_mu = 16 * nN * 4;
    for (int mu = c0; mu < n_mu; mu += G) {
        const int rb = mu & 15, t = mu >> 4, pn = t >> 2, s = t & 3, row0 = MP + rb * 16;
        f32x4 acc[4];
#pragma unroll
        for (int j = 0; j < 4; ++j) acc[j] = (f32x4){0.f, 0.f, 0.f, 0.f};
        const bf16* ap = A + (size_t)(row0 + fr) * lda + w * kw + fq * 8;
        const bf16* bp = Bt + (size_t)(pn * 256 + s * 32 + fr) * ldb + w * kw + fq * 8;
#pragma unroll
        for (int k0 = 0; k0 < NKS; k0 += KB) {
            bf16x8 a[KB], b[KB][4];
#pragma unroll
            for (int kk = 0; kk < KB; ++kk) if (k0 + kk < NKS) {
                a[kk] = *(const bf16x8*)(ap + (k0 + kk) * 32);
#pragma unroll
                for (int j = 0; j < 4; ++j) b[kk][j] = *(const bf16x8*)(bp + (size_t)((j >> 1) * 128 + (j & 1) * 16) * ldb + (k0 + kk) * 32);
            }
#pragma unroll
            for (int kk = 0; kk < KB; ++kk) if (k0 + kk < NKS) {
#pragma unroll
                for (int j = 0; j < 4; ++j) acc[j] = __builtin_amdgcn_mfma_f32_16x16x32_bf16(b[kk][j], a[kk], acc[j], 0, 0, 0);
            }
        }
#pragma unroll
        for (int j = 0; j < 4; ++j) *(LAS f32x4*)(red + ((w * 4 + j) * 64 + lane) * 4) = acc[j];
        __syncthreads();
        if (w == 0) {
            f32x4 v0[2], v1[2];
#pragma unroll
            for (int wb = 0; wb < 2; ++wb) { v0[wb] = (f32x4){0.f, 0.f, 0.f, 0.f}; v1[wb] = v0[wb];
#pragma unroll
                for (int ww = 0; ww < 8; ++ww) { v0[wb] += *(LAS f32x4*)(red + ((ww * 4 + wb) * 64 + lane) * 4); v1[wb] += *(LAS f32x4*)(red + ((ww * 4 + wb + 2) * 64 + lane) * 4); } }
            apply_two(f, row0 + fr, pn, s * 32 + fq * 4, v0, v1, fq, s);
        }
        __syncthreads();
    }
}

template <class F> DI void sample_gemm_wide(int wv, LAS unsigned char* lds, const bf16* A, const bf16* Bt, int nN, const F& f, int G, int c0) {
    unsigned z_ = 0u; asm volatile("" : "+v"(z_)); const int lane = (int)__builtin_amdgcn_mbcnt_hi(~0u, __builtin_amdgcn_mbcnt_lo(~0u, z_)), fr = lane & 15, fq = lane >> 4, w = wv;
    constexpr int K = D;
    LAS float* red = (LAS float*)lds;
    const int n_mu = 4 * nN * 4;
    for (int mu = c0; mu < n_mu; mu += G) {
        const int rg = mu & 3, t = mu >> 2, pn = t >> 2, s = t & 3, row0 = MP + rg * 64;
        f32x4 acc[4][4];
#pragma unroll
        for (int rb = 0; rb < 4; ++rb)
#pragma unroll
            for (int j = 0; j < 4; ++j) acc[rb][j] = (f32x4){0.f, 0.f, 0.f, 0.f};
        const bf16* ap = A + (size_t)(row0 + fr) * K + w * 128 + fq * 8;
        const bf16* bp = Bt + (size_t)(pn * 256 + s * 32 + fr) * K + w * 128 + fq * 8;
        bf16x8 a[4][4], b[4][4];
#pragma unroll
        for (int kk = 0; kk < 4; ++kk)
#pragma unroll
            for (int x = 0; x < 4; ++x) { a[kk][x] = *(const bf16x8*)(ap + (size_t)x * 16 * K + kk * 32); b[kk][x] = *(const bf16x8*)(bp + (size_t)((x >> 1) * 128 + (x & 1) * 16) * K + kk * 32); }
#pragma unroll
        for (int kk = 0; kk < 4; ++kk)
#pragma unroll
            for (int rb = 0; rb < 4; ++rb)
#pragma unroll
                for (int j = 0; j < 4; ++j) acc[rb][j] = __builtin_amdgcn_mfma_f32_16x16x32_bf16(b[kk][j], a[kk][rb], acc[rb][j], 0, 0, 0);
#pragma unroll
        for (int rb = 0; rb < 4; ++rb)
#pragma unroll
            for (int j = 0; j < 4; ++j) *(LAS f32x4*)(red + ((w * 16 + rb * 4 + j) * 64 + lane) * 4) = acc[rb][j];
        __syncthreads();
        {
            const int rb = w >> 1, wb = w & 1; f32x4 v0 = (f32x4){0.f, 0.f, 0.f, 0.f}, v1 = v0;
#pragma unroll
            for (int ww = 0; ww < 8; ++ww) { v0 += *(LAS f32x4*)(red + ((ww * 16 + rb * 4 + wb) * 64 + lane) * 4); v1 += *(LAS f32x4*)(red + ((ww * 16 + rb * 4 + wb + 2) * 64 + lane) * 4); }
            const int row = row0 + rb * 16 + fr, c = s * 32 + wb * 16 + fq * 4; typename F::Row rc; f.row_begin(rc, row, pn, -1);
            if constexpr (F::NKIND == 1) f.template apply<0>(rc, row, pn, c, v0, v1);
            else { const int kd = f.kind(pn);
                if (kd == 0) f.template apply<0>(rc, row, pn, c, v0, v1); else if (kd == 1) f.template apply<1>(rc, row, pn, c, v0, v1);
                else if constexpr (F::NKIND > 2) { if (kd == 2) f.template apply<2>(rc, row, pn, c, v0, v1); else if (kd == 3) f.template apply<3>(rc, row, pn, c, v0, v1); else f.template apply<4>(rc, row, pn, c, v0, v1); } }
        }
        __syncthreads();
    }
}

DI void tr_item(const float* W, int N, int sc0, const float* gain, bf16* WT, int K, int n0, int k0, LAS float* scr, int lane) {
#pragma unroll
    for (int i = 0; i < 8; ++i) { const int kk = 8 * i + (lane >> 3), n4 = (lane & 7) * 4; const float g = gain ? gain[k0 + kk] : 1.f; const f32x4 v = *(const f32x4*)(W + (size_t)(k0 + kk) * N + sc0 + n4);
        LAS float* d = scr + kk * 33 + n4; d[0] = v[0] * g; d[1] = v[1] * g; d[2] = v[2] * g; d[3] = v[3] * g; }
    LDS_WAIT();
    const int c = lane & 7;
#pragma unroll
    for (int j = 0; j < 4; ++j) { const int n = (lane >> 3) + 8 * j; const LAS float* s = scr + (8 * c) * 33 + n;
        u32x4 o; o.x = pk2(s[0 * 33], s[1 * 33]); o.y = pk2(s[2 * 33], s[3 * 33]); o.z = pk2(s[4 * 33], s[5 * 33]); o.w = pk2(s[6 * 33], s[7 * 33]);
        *(u32x4*)(WT + (size_t)(n0 + n) * K + k0 + 8 * c) = o; }
    LDS_WAIT();
}
DI int map_win(int n0) {
    const int t = n0 >> 8, r = n0 & 255, hb = r >> 7, rr = r & 127;
    switch (t) {
        case 0: return r;
        case 1: case 2: return (hb ? 512 : 256) + (t - 1) * 128 + rr;
        case 3: case 4: return 768 + ((t - 3) * 4 + (rr >> 5)) * 64 + hb * 32 + (rr & 31);
        case 5: { const int blk = rr >> 5; return (blk < 2 ? 1280 + blk * 64 : 1408 + (blk - 2) * 64) + hb * 32 + (rr & 31); }
        default: return (hb ? 1792 : 1536) + (t - 6) * 128 + rr;
    }
}
DI void sincos_d(double a, float& sn, float& cs) {
    const double k = rint(a * 0.6366197723675814); double r = fma(-k, 1.5707963267948966, a); r = fma(-k, 6.123233995736766e-17, r); const double r2 = r * r;
    const double s = r * (1.0 + r2 * (-1.0 / 6 + r2 * (1.0 / 120 + r2 * (-1.0 / 5040 + r2 * (1.0 / 362880 + r2 * (-1.0 / 39916800 + r2 * (1.0 / 6227020800.0)))))));
    const double c = 1.0 + r2 * (-0.5 + r2 * (1.0 / 24 + r2 * (-1.0 / 720 + r2 * (1.0 / 40320 + r2 * (-1.0 / 3628800 + r2 * (1.0 / 479001600 + r2 * (-1.0 / 87178291200.0)))))));
    const int q = (int)((long long)k & 3);
    sn = (float)(q == 0 ? s : q == 1 ? c : q == 2 ? -s : -c); cs = (float)(q == 0 ? c : q == 1 ? -s : q == 2 ? -c : s);
}
DI void prologue(int wv, unsigned char* ws, float* out, LAS unsigned char* lds) {
    unsigned z_ = 0u; asm volatile("" : "+v"(z_)); const int tid_ = wv * 64 + (int)__builtin_amdgcn_mbcnt_hi(~0u, __builtin_amdgcn_mbcnt_lo(~0u, z_)); const int tid = tid_, w = __builtin_amdgcn_readfirstlane(tid >> 6), lane = tid & 63, G = gridDim.x;
    const int gw = blockIdx.x * 8 + w, NGW = G * 8; const int gt = blockIdx.x * NTHR + tid, NGT = G * NTHR;
    { float* rc = (float*)(ws + WS_ROPE); float* rs = rc + (size_t)S * 32;
      for (int i = gt; i < S * 32; i += NGT) { const int pos = i >> 5, j = i & 31; double inv = 1.0; for (int q = 0; q < j; ++q) inv *= 0.74989420933245587; float sn, cs; sincos_d((double)pos * inv, sn, cs); rc[i] = cs; rs[i] = sn; } }
    { bf16* xb = (bf16*)(ws + WS_XB); float* ss0 = (float*)(ws + WS_SS); bf16* mn = (bf16*)(ws + WS_MN);
      for (int m = gw; m < MT + 512; m += NGW) {
          const float* src = m < MP ? IN(I_XP) + (size_t)m * D : m < MT ? IN(I_XS) + (size_t)(m - MP) * D : IN(I_MEM) + (size_t)(m - MT) * D;
          f32x4 v[4]; float s = 0.f;
#pragma unroll
          for (int j = 0; j < 4; ++j) { v[j] = *((const f32x4*)src + lane + 64 * j); }
          if (m < MT) {
              bf16* o = xb + (size_t)m * D;
#pragma unroll
              for (int j = 0; j < 4; ++j) { u32x2 wv; wv.x = pk2(v[j][0], v[j][1]); wv.y = pk2(v[j][2], v[j][3]); *((u32x2*)o + lane + 64 * j) = wv; const f32x4 r = unpk4(wv); s += (r[0] * r[0] + r[1] * r[1]) + (r[2] * r[2] + r[3] * r[3]); }
              s = wave_sum(s); if (lane < 16) ss0[(size_t)m * 16 + lane] = lane == 0 ? s : 0.f;
          } else {
#pragma unroll
              for (int j = 0; j < 4; ++j) s += (v[j][0] * v[j][0] + v[j][1] * v[j][1]) + (v[j][2] * v[j][2] + v[j][3] * v[j][3]);
              const float rstd = rsqrtf(wave_sum(s) * (1.f / D) + EPS); bf16* o = mn + (size_t)(m - MT) * D;
#pragma unroll
              for (int j = 0; j < 4; ++j) st4bf(o + 4 * (lane + 64 * j), v[j] * rstd);
          }
      } }
    { LAS float* scr = (LAS float*)(lds + w * 16384);
      constexpr int I1 = 16 * 176, ID = 44 * 32, IIN = 16 * 64, ISQ = 16 * 32, IKV = 16 * 64, IL = 2 * I1 + 2 * ID + IIN + 3 * ISQ + IKV;
      for (int it = gw; it < NL * IL; it += NGW) {
          const int l = it / IL; int r = it % IL; unsigned char* wl = ws + WS_W + (size_t)l * LW;
          if (r < 2 * I1) { const int second = r >= I1; if (second) r -= I1; const int nb = r % 176, kb = r / 176, n0 = nb * 32, pn = n0 >> 8, rr = n0 & 255;
              const float* W = (second ? (rr >= 128 ? IN(I_F2U) : IN(I_F2G)) : (rr >= 128 ? IN(I_F1U) : IN(I_F1G))) + (size_t)l * D * FF;
              tr_item(W, FF, pn * 128 + (rr & 127), (second ? IN(I_F2N) : IN(I_F1N)) + l * D, (bf16*)(wl + (second ? W_2 : W_1)), D, n0, kb * 64, scr, lane); continue; }
          r -= 2 * I1;
          if (r < 2 * ID) { const int second = r >= ID; if (second) r -= ID; const int nb = r % 32, kb = r / 32;
              tr_item((second ? IN(I_F2D) : IN(I_F1D)) + (size_t)l * FF * D, D, nb * 32, nullptr, (bf16*)(wl + (second ? W_D2 : W_D1)), FF, nb * 32, kb * 64, scr, lane); continue; }
          r -= 2 * ID;
          if (r < IIN) { const int nb = r % 64, kb = r / 64; tr_item(IN(I_WIN) + (size_t)l * D * 2048, 2048, map_win(nb * 32), IN(I_MIXN) + l * D, (bf16*)(wl + W_IN), D, nb * 32, kb * 64, scr, lane); continue; }
          r -= IIN;
          if (r < 3 * ISQ) { const int which = r / ISQ; r -= which * ISQ; const int nb = r % 32, kb = r / 32;
              const float* W = (which == 0 ? IN(I_WOUT) : which == 1 ? IN(I_WQ) : IN(I_WO)) + (size_t)l * D * D; const float* g = which == 0 ? IN(I_MON) + l * D : which == 1 ? IN(I_XAN) + l * D : nullptr;
              tr_item(W, D, nb * 32, g, (bf16*)(wl + (which == 0 ? W_OUT : which == 1 ? W_Q : W_O)), D, nb * 32, kb * 64, scr, lane); continue; }
          r -= 3 * ISQ;
          { const int nb = r % 64, kb = r / 64, n0 = nb * 32; tr_item((n0 < 1024 ? IN(I_WK) : IN(I_WV)) + (size_t)l * D * D, D, n0 & 1023, IN(I_MEMN) + l * D, (bf16*)(wl + W_KV), D, n0, kb * 64, scr, lane); }
      } }
}

DI f32x16 mfma32(bf16x8 a, bf16x8 b, f32x16 c) { return __builtin_amdgcn_mfma_f32_32x32x16_bf16(a, b, c, 0, 0, 0); }
constexpr int MX_KSZ = 192 * 144, MX_VOFF = 2 * MX_KSZ, MX_VP = 392, MX_SSB = MX_VOFF + 128 * MX_VP, MX_WC = MX_SSB + 2048, MX_END = MX_WC + 48 * 256 * 4;
static_assert(MX_END <= LDS_TAB, "mixer LDS");

template <int TW, class LA, class LC, class LCP, class LG> DI void conv_tokens(int l, LAS unsigned char* lds, int lane, LA ldA, LC ldC, LCP ldCp, LG ldG, bf16* ymix_row0  ) {
    const int ch = 4 * lane;
    const float* caw = IN(I_CAW) + (size_t)l * 3 * 256 + ch; const f32x4 wa0 = *(const f32x4*)caw, wa1 = *(const f32x4*)(caw + 256), wa2 = *(const f32x4*)(caw + 512);
    const LAS float* wc = (const LAS float*)(lds + MX_WC) + ch;
    f32x4 accA[TW], accC[TW];
    const f32x4 bias = *(const f32x4*)(IN(I_CCB) + l * 256 + ch);
#pragma unroll
    for (int t = 0; t < TW; ++t) { accA[t] = (f32x4){0.f, 0.f, 0.f, 0.f}; accC[t] = bias; }
#pragma unroll
    for (int i = 0; i < TW + 2; ++i) { const f32x4 x = ldA(i);
#pragma unroll
        for (int t = 0; t < TW; ++t) { const int j = i - t; if (j == 0) accA[t] += wa0 * x; else if (j == 1) accA[t] += wa1 * x; else if (j == 2) accA[t] += wa2 * x; } }
    constexpr int NWIN = TW + 30;
    {
#pragma unroll 1
        for (int ib = 0; ib < NWIN; ib += 16) {
            f32x4 x[16];
#pragma unroll
            for (int ii = 0; ii < 16; ++ii) x[ii] = ldC(ib + ii);
#pragma unroll
            for (int ii = 0; ii < 16; ++ii)
#pragma unroll
                for (int t = 0; t < TW; ++t) accC[t] += *(const LAS f32x4*)(wc + (ib + ii - t + 8) * 256) * x[ii];
        }
    }
    const f32x4 lng = *(const f32x4*)(IN(I_LNG) + l * 256 + ch), lnb = *(const f32x4*)(IN(I_LNB) + l * 256 + ch);
#pragma unroll
    for (int t = 0; t < TW; ++t) {
        const f32x4 ya = ldG(t) * accA[t];
        const float ssa = wave_sum((ya[0] * ya[0] + ya[1] * ya[1]) + (ya[2] * ya[2] + ya[3] * ya[3]));
        st4bf(ymix_row0 + (size_t)t * D + ch, ya * rsqrtf(ssa * (1.f / 256) + EPS));
        const f32x4 cc = accC[t];
        const float mean = wave_sum((cc[0] + cc[1]) + (cc[2] + cc[3])) * (1.f / 256); const f32x4 dc = cc - mean;
        const float var = wave_sum((dc[0] * dc[0] + dc[1] * dc[1]) + (dc[2] * dc[2] + dc[3] * dc[3])) * (1.f / 256);
        const f32x4 ln = dc * rsqrtf(var + EPS) * lng + lnb; f32x4 yc;
#pragma unroll
        for (int e = 0; e < 4; ++e) yc[e] = ln[e] * sigmoidf_(ln[e]);
        const float ssc = wave_sum((yc[0] * yc[0] + yc[1] * yc[1]) + (yc[2] * yc[2] + yc[3] * yc[3]));
        st4bf(ymix_row0 + (size_t)t * D + 768 + ch, yc * rsqrtf(ssc * (1.f / 256) + EPS));
    }
}

template <bool SMP> DI void attn_qb(const LAS unsigned char* Kl, const LAS unsigned char* Vl, const bf16* qp, float sink2, int kb0, f32x16 (&o)[2]) {
    bf16x8 qf[4];
#pragma unroll
    for (int ks = 0; ks < 4; ++ks) qf[ks] = *(const bf16x8*)(qp + ks * 16);
    f32x16 s[6];
#pragma unroll
    for (int kb = 0; kb < 6; ++kb)
#pragma unroll
        for (int i = 0; i < 16; ++i) s[kb][i] = 0.f;
#pragma unroll
    for (int ks = 0; ks < 4; ++ks)
#pragma unroll
        for (int kb = 0; kb < 6; ++kb) { const bf16x8 a = *(const LAS bf16x8*)(Kl + kb * 32 * 144 + ks * 32); s[kb] = mfma32(a, qf[ks], s[kb]); }
#pragma unroll
    for (int kb = 0; kb < 6; ++kb) { if (SMP ? kb == 5 : kb < kb0) {
#pragma unroll
            for (int i = 0; i < 16; ++i) s[kb][i] = -3.0e38f; }
        if (SMP && kb == 4) {
#pragma unroll
            for (int i = 8; i < 16; ++i) s[kb][i] = -3.0e38f; } }
    float m4[4] = {sink2, sink2, sink2, sink2};
#pragma unroll
    for (int kb = 0; kb < 6; ++kb)
#pragma unroll
        for (int i = 0; i < 16; ++i) m4[i & 3] = fmaxf(m4[i & 3], s[kb][i]);
    float mx = fmaxf(fmaxf(m4[0], m4[1]), fmaxf(m4[2], m4[3]));
    mx = fmaxf(mx, __shfl_xor(mx, 32));
    float s4[4] = {0.f, 0.f, 0.f, 0.f};
#pragma unroll
    for (int kb = 0; kb < 6; ++kb)
#pragma unroll
        for (int i = 0; i < 16; ++i) { s[kb][i] = __builtin_amdgcn_exp2f(s[kb][i] - mx); s4[i & 3] += s[kb][i]; }
    float sum = (s4[0] + s4[1]) + (s4[2] + s4[3]);
    sum += __shfl_xor(sum, 32);
    const float inv = __builtin_amdgcn_rcpf(sum + __builtin_amdgcn_exp2f(sink2 - mx));
    f32x16 o2[2][2];
#pragma unroll
    for (int hb = 0; hb < 2; ++hb)
#pragma unroll
        for (int t = 0; t < 2; ++t)
#pragma unroll
            for (int i = 0; i < 16; ++i) o2[hb][t][i] = 0.f;
#pragma unroll
    for (int kb = 0; kb < 6; ++kb)
#pragma unroll
        for (int t = 0; t < 2; ++t) {
            u32x4 pw; pw.x = pk2(s[kb][8 * t] * inv, s[kb][8 * t + 1] * inv); pw.y = pk2(s[kb][8 * t + 2] * inv, s[kb][8 * t + 3] * inv);
            pw.z = pk2(s[kb][8 * t + 4] * inv, s[kb][8 * t + 5] * inv); pw.w = pk2(s[kb][8 * t + 6] * inv, s[kb][8 * t + 7] * inv);
            const bf16x8 pf = __builtin_bit_cast(bf16x8, pw);
#pragma unroll
            for (int hb = 0; hb < 2; ++hb) {
                const LAS unsigned char* vp = Vl + hb * 32 * MX_VP + (kb * 32 + t * 16) * 2;
                const u32x2 lo = *(const LAS u32x2*)vp, hi = *(const LAS u32x2*)(vp + 16);
                const bf16x8 vf = __builtin_bit_cast(bf16x8, (u32x4){lo.x, lo.y, hi.x, hi.y});
                o2[hb][t] = mfma32(vf, pf, o2[hb][t]);
            }
        }
#pragma unroll
    for (int hb = 0; hb < 2; ++hb) o[hb] = o2[hb][0] + o2[hb][1];
}

DI void mixer_phase(int wv, unsigned char* ws, float* out, int l, LAS unsigned char* lds, int G, int bx) {
    unsigned z_ = 0u; asm volatile("" : "+v"(z_)); const int tid_ = wv * 64 + (int)__builtin_amdgcn_mbcnt_hi(~0u, __builtin_amdgcn_mbcnt_lo(~0u, z_)); const int tid = tid_, w = __builtin_amdgcn_readfirstlane(tid >> 6), lane = tid & 63, r = lane & 31, hf = lane >> 5;
    unsigned char* R = ws + WS_R;
    const bf16* gb = (const bf16*)(R + R_GB); const bf16* cv = (const bf16*)(R + R_CV); const bf16* qb_ = (const bf16*)(R + R_Q); const bf16* kb_ = (const bf16*)(R + R_K);
    const bf16* vT = (const bf16*)(R + R_VT); const bf16* vS = (const bf16*)(R + R_VS); const bf16* glu = (const bf16*)(R + R_GLU); bf16* ymix = (bf16*)(R + R_YMIX);
    { const float* src = IN(I_CCW) + (size_t)l * 31 * 256; LAS float* dst = (LAS float*)(lds + MX_WC);
#pragma unroll
      for (int it = 0; it < 6; ++it) { const int i4 = tid + it * NTHR, j = (i4 >> 6) - 8; const bool ok = j >= 0 && j <= 30; const f32x4 v = *(const f32x4*)(src + (ok ? j : 0) * 256 + (i4 & 63) * 4);
          *(LAS f32x4*)(dst + i4 * 4) = ok ? v : (f32x4){0.f, 0.f, 0.f, 0.f}; } }
    const float sink2 = IN(I_SINK)[l * 8 + w] * LOG2E;
    LAS float* ssb = (LAS float*)(lds + MX_SSB);
    __syncthreads();
#ifndef PROBE
#define PROBE 0
#endif
    for (int rep_ = 0; rep_ < (PROBE == 12 ? 2 : 1); ++rep_)
    for (int u = bx; u < NB * 256; u += G) {
        const int b = u >> 8, n = u & 255; const size_t row0 = (size_t)b * S + n * 64;
        u32x4 kreg[6], vreg[6];
#pragma unroll
        for (int it = 0; it < 6; ++it) {
            const int p = tid + it * NTHR, key = p >> 4, part = p & 15, pos = n * 64 - 128 + key;
            kreg[it] = *(const u32x4*)(kb_ + ((size_t)b * S + (pos >= 0 ? pos : 0)) * 128 + part * 8);
            const int rr = p / 24, pc = p % 24, pos0 = n * 64 - 128 + pc * 8;
            vreg[it] = *(const u32x4*)(vT + ((size_t)(b * 128 + rr)) * S + (pos0 >= 0 ? pos0 : 0));
        }
        const int t0 = w * 8, p0 = n * 64 + t0; const size_t brow = (size_t)b * S;
        auto ldP = [&](const bf16* base, int p) -> u32x2 { const u32x2 v = *(const u32x2*)(base + (brow + (p >= 0 ? p : 0)) * 256 + 4 * lane); return p >= 0 ? v : (u32x2){0u, 0u}; };
        u32x2 wa_[10], wg_[8], w0_[8], nw_[8];
#pragma unroll
        for (int i = 0; i < 10; ++i) wa_[i] = ldP(cv, p0 - 2 + i);
#pragma unroll
        for (int i = 0; i < 8; ++i) { wg_[i] = ldP(gb, p0 + i); w0_[i] = ldP(glu, p0 - 30 + i); nw_[i] = ldP(glu, p0 - 22 + i); }
#pragma unroll
        for (int it = 0; it < 6; ++it) {
            const int p = tid + it * NTHR, key = p >> 4, part = p & 15, pos = n * 64 - 128 + key;
            *(LAS u32x4*)(lds + (part >> 3) * MX_KSZ + key * 144 + (part & 7) * 16) = pos >= 0 ? kreg[it] : (u32x4){0u, 0u, 0u, 0u};
            const int rr = p / 24, pc = p % 24, pos0 = n * 64 - 128 + pc * 8; const u32x4 v = pos0 >= 0 ? vreg[it] : (u32x4){0u, 0u, 0u, 0u};
            LAS u32x2* d = (LAS u32x2*)(lds + MX_VOFF + rr * MX_VP + pc * 16); d[0] = (u32x2){v.x, v.y}; d[1] = (u32x2){v.z, v.w};
        }
        {
            const int ch = 4 * lane;
            const float* caw = IN(I_CAW) + (size_t)l * 3 * 256 + ch; const f32x4 wa0 = *(const f32x4*)caw, wa1 = *(const f32x4*)(caw + 256), wa2 = *(const f32x4*)(caw + 512);
            const LAS float* wc = (const LAS float*)(lds + MX_WC) + ch;
            const f32x4 bias = *(const f32x4*)(IN(I_CCB) + l * 256 + ch);
            const f32x4 lng = *(const f32x4*)(IN(I_LNG) + l * 256 + ch), lnb = *(const f32x4*)(IN(I_LNB) + l * 256 + ch);
            f32x4 accC[8], Rg[8];
#pragma unroll
            for (int t = 0; t < 8; ++t) { accC[t] = bias; Rg[t] = unpk4(w0_[t]); }
#pragma unroll 1
            for (int jb = 0; jb < 32; jb += 8) {
                u32x2 nx[8];
#pragma unroll
                for (int s = 0; s < 8; ++s) { const int i = jb + 16 + s; nx[s] = (i < 38) ? ldP(glu, p0 - 30 + i) : (u32x2){0u, 0u}; }
#pragma unroll
                for (int s = 0; s < 8; ++s) { const f32x4 wt = *(const LAS f32x4*)(wc + (jb + s + 8) * 256);
#pragma unroll
                    for (int t = 0; t < 8; ++t) accC[t] += wt * Rg[(t + s) & 7];
                    Rg[s] = unpk4(nw_[s]); }
#pragma unroll
                for (int s = 0; s < 8; ++s) nw_[s] = nx[s];
            }
            bf16* yrow = ymix + (brow + p0) * D;
#pragma unroll
            for (int t = 0; t < 8; ++t) {
                const f32x4 ya = unpk4(wg_[t]) * (wa0 * unpk4(wa_[t]) + wa1 * unpk4(wa_[t + 1]) + wa2 * unpk4(wa_[t + 2]));
                const float ssa = wave_sum((ya[0] * ya[0] + ya[1] * ya[1]) + (ya[2] * ya[2] + ya[3] * ya[3]));
                st4bf(yrow + (size_t)t * D + ch, ya * rsqrtf(ssa * (1.f / 256) + EPS));
                const f32x4 cc = accC[t];
                const float mean = wave_sum((cc[0] + cc[1]) + (cc[2] + cc[3])) * (1.f / 256); const f32x4 dc = cc - mean;
                const float var = wave_sum((dc[0] * dc[0] + dc[1] * dc[1]) + (dc[2] * dc[2] + dc[3] * dc[3])) * (1.f / 256);
                const f32x4 ln = dc * rsqrtf(var + EPS) * lng + lnb; f32x4 yc;
#pragma unroll
                for (int e = 0; e < 4; ++e) yc[e] = ln[e] * sigmoidf_(ln[e]);
                const float ssc = wave_sum((yc[0] * yc[0] + yc[1] * yc[1]) + (yc[2] * yc[2] + yc[3] * yc[3]));
                st4bf(yrow + (size_t)t * D + 768 + ch, yc * rsqrtf(ssc * (1.f / 256) + EPS));
            }
        }
        __syncthreads();
        const int kvh = w >> 2, kb0 = n >= 2 ? 0 : (2 - n) * 2;
        const LAS unsigned char* Kl = lds + kvh * MX_KSZ + r * 144 + hf * 16; const LAS unsigned char* Vl = lds + MX_VOFF + (kvh * 64 + r) * MX_VP + hf * 8;
#pragma unroll 1
        for (int qb = 0; qb < (PROBE == 17 ? 4 : 2); ++qb) {
            f32x16 o[2]; attn_qb<false>(Kl, Vl, qb_ + (row0 + (qb & 1) * 32 + r) * 512 + w * 64 + hf * 8, sink2, kb0, o);
            float sq = 0.f;
#pragma unroll
            for (int hb = 0; hb < 2; ++hb)
#pragma unroll
                for (int i = 0; i < 16; ++i) sq += o[hb][i] * o[hb][i];
            sq += __shfl_xor(sq, 32);
            if (hf == 0) ssb[((qb & 1) * 8 + w) * 32 + r] = sq;
            __syncthreads();
            float tot = 0.f;
#pragma unroll
            for (int hh = 0; hh < 8; ++hh) tot += ssb[((qb & 1) * 8 + hh) * 32 + r];
            const float rs = rsqrtf(tot * (1.f / 512) + EPS); bf16* yp = ymix + (row0 + (qb & 1) * 32 + r) * D + 256 + w * 64 + 4 * hf;
#pragma unroll
            for (int hb = 0; hb < 2; ++hb)
#pragma unroll
                for (int g = 0; g < 4; ++g) st4bf(yp + hb * 32 + 8 * g, (f32x4){o[hb][4 * g] * rs, o[hb][4 * g + 1] * rs, o[hb][4 * g + 2] * rs, o[hb][4 * g + 3] * rs});
        }
        __syncthreads();
    }
    for (int rep_ = 0; rep_ < ((PROBE == 13 || PROBE == 14) ? 2 : 1); ++rep_)
    for (int sb = bx - (G - 32); sb >= 0 && sb < 16; sb += G) {
        const size_t srow0 = (size_t)MP + sb * 16;
        const int t0 = w * 2; const float* sa = IN(I_SA) + ((size_t)(l * 16 + sb) * 2) * 256; const float* sc = IN(I_SC) + ((size_t)(l * 16 + sb) * 30) * 256;
        auto ldA = [&](int i) -> f32x4 { const int p = t0 - 2 + i; return p >= 0 ? ld4bf(cv + (srow0 + p) * 256 + 4 * lane) : *(const f32x4*)(sa + (2 + p) * 256 + 4 * lane); };
        auto ldC = [&](int i) -> f32x4 { const int p = t0 - 30 + i; return p >= 0 ? ld4bf(glu + (srow0 + p) * 256 + 4 * lane) : *(const f32x4*)(sc + (30 + p) * 256 + 4 * lane); };
        auto ldG = [&](int t) -> f32x4 { return ld4bf(gb + (srow0 + t0 + t) * 256 + 4 * lane); };
        conv_tokens<2>(l, lds, lane, ldA, ldC, ldC, ldG, ymix + (srow0 + t0) * D);
        float* oc = out + O_CS + ((size_t)(l * 16 + sb) * 30) * 256;
        for (int i = tid; i < 14 * 256; i += NTHR) oc[i] = sc[16 * 256 + i];
    }
    __syncthreads();
    for (int rep_ = 0; rep_ < ((PROBE == 13 || PROBE == 15) ? 2 : 1); ++rep_)
    for (int sb = bx - (G - 16); sb >= 0 && sb < 16; sb += G) {
        const size_t srow0 = (size_t)MP + sb * 16;
        const float* ck = IN(I_CK) + ((size_t)(l * 16 + sb) * 128) * 128; const float* cvv = IN(I_CV) + ((size_t)(l * 16 + sb) * 128) * 128;
        f32x4 kr_[8], vr_[8];
#pragma unroll
        for (int it = 0; it < 8; ++it) { const int i = tid + it * NTHR; kr_[it] = *(const f32x4*)(ck + (size_t)i * 4); vr_[it] = *(const f32x4*)(cvv + (size_t)i * 4); }
        u32x4 kn_ = (u32x4){0u, 0u, 0u, 0u}, vn_ = kn_;
        if (tid < 256) { kn_ = *(const u32x4*)(kb_ + (srow0 + (tid >> 4)) * 128 + (tid & 15) * 8); vn_ = *(const u32x4*)(vS + ((size_t)sb * 16 + (tid >> 4)) * 128 + (tid & 15) * 8); }
        for (int i = tid; i < 128 * 12; i += NTHR) { const int rr = i / 12, pc = i % 12; *(LAS u32x2*)(lds + MX_VOFF + rr * MX_VP + 288 + pc * 8) = (u32x2){0u, 0u}; }
#pragma unroll
        for (int it = 0; it < 8; ++it) {
            const int i = tid + it * NTHR, key = i >> 5, c = (i & 31) * 4;
            *(LAS u32x2*)(lds + (c >> 6) * MX_KSZ + key * 144 + (c & 63) * 2) = (u32x2){pk2(kr_[it][0], kr_[it][1]), pk2(kr_[it][2], kr_[it][3])};
#pragma unroll
            for (int e = 0; e < 4; ++e) *(LAS bf16*)(lds + MX_VOFF + (c + e) * MX_VP + key * 2) = f2bf(vr_[it][e]);
        }
        if (tid < 256) {
            const int key = 128 + (tid >> 4), part = tid & 15;
            *(LAS u32x4*)(lds + (part >> 3) * MX_KSZ + key * 144 + (part & 7) * 16) = kn_;
            const unsigned vw[4] = {vn_.x, vn_.y, vn_.z, vn_.w};
#pragma unroll
            for (int e = 0; e < 8; ++e) *(LAS bf16*)(lds + MX_VOFF + (part * 8 + e) * MX_VP + key * 2) = (bf16)((vw[e >> 1] >> ((e & 1) * 16)) & 0xffffu);
        }
        __syncthreads();
        {
            const int kvh = w >> 2, tq = r & 15;
            const LAS unsigned char* Kl = lds + kvh * MX_KSZ + r * 144 + hf * 16; const LAS unsigned char* Vl = lds + MX_VOFF + (kvh * 64 + r) * MX_VP + hf * 8;
            f32x16 o[2]; attn_qb<true>(Kl, Vl, qb_ + (srow0 + tq) * 512 + w * 64 + hf * 8, sink2, 0, o);
            float sq = 0.f;
#pragma unroll
            for (int hb = 0; hb < 2; ++hb)
#pragma unroll
                for (int i = 0; i < 16; ++i) sq += o[hb][i] * o[hb][i];
            sq += __shfl_xor(sq, 32);
            if (hf == 0) ssb[w * 32 + r] = sq;
            __syncthreads();
            float tot = 0.f;
#pragma unroll
            for (int hh = 0; hh < 8; ++hh) tot += ssb[hh * 32 + r];
            const float rs = rsqrtf(tot * (1.f / 512) + EPS); bf16* yp = ymix + (srow0 + tq) * D + 256 + w * 64 + 4 * hf;
            if (r < 16) {
#pragma unroll
                for (int hb = 0; hb < 2; ++hb)
#pragma unroll
                    for (int g = 0; g < 4; ++g) st4bf(yp + hb * 32 + 8 * g, (f32x4){o[hb][4 * g] * rs, o[hb][4 * g + 1] * rs, o[hb][4 * g + 2] * rs, o[hb][4 * g + 3] * rs});
            }
        }
        __syncthreads();
    }
}

DI void xattn_sample(int wv, unsigned char* ws, float* out, int l, LAS unsigned char* lds, int G, int bx) {
    unsigned z_ = 0u; asm volatile("" : "+v"(z_)); const int tid_ = wv * 64 + (int)__builtin_amdgcn_mbcnt_hi(~0u, __builtin_amdgcn_mbcnt_lo(~0u, z_)); const int tid = tid_, w = __builtin_amdgcn_readfirstlane(tid >> 6), lane = tid & 63, fr = lane & 15, fq = lane >> 4;
    bf16* qx = (bf16*)(ws + WS_R + R_QX);
    LAS float* PS = (LAS float*)lds;
    LAS float* RM = (LAS float*)(lds + 16 * 260 * 4);
    for (int u = bx - (G - 64); u >= 0 && u < 64; u += G) {
        const int sb = u >> 2, h = u & 3; const size_t srow0 = (size_t)MP + sb * 16;
        const float* mk = IN(I_MK) + (((size_t)(l * 16 + sb) * 256) * 4 + h) * 256; const float* mv = IN(I_MV) + (((size_t)(l * 16 + sb) * 256) * 4 + h) * 256;
        f32x4 acc[2] = {(f32x4){0.f, 0.f, 0.f, 0.f}, (f32x4){0.f, 0.f, 0.f, 0.f}};
        const bf16* qp = qx + (srow0 + fr) * D + h * 256 + fq * 8;
#pragma unroll
        for (int ks = 0; ks < 8; ++ks) {
            const bf16x8 qf = *(const bf16x8*)(qp + ks * 32);
#pragma unroll
            for (int kbk = 0; kbk < 2; ++kbk) {
                const float* kp = mk + (size_t)(w * 32 + kbk * 16 + fr) * 1024 + ks * 32 + fq * 8; const f32x4 k0 = *(const f32x4*)kp, k1 = *(const f32x4*)(kp + 4);
                u32x4 kw; kw.x = pk2(k0[0], k0[1]); kw.y = pk2(k0[2], k0[3]); kw.z = pk2(k1[0], k1[1]); kw.w = pk2(k1[2], k1[3]);
                acc[kbk] = __builtin_amdgcn_mfma_f32_16x16x32_bf16(__builtin_bit_cast(bf16x8, kw), qf, acc[kbk], 0, 0, 0);
            }
        }
#pragma unroll
        for (int kbk = 0; kbk < 2; ++kbk)
#pragma unroll
            for (int i = 0; i < 4; ++i) PS[fr * 260 + w * 32 + kbk * 16 + 4 * fq + i] = acc[kbk][i];
        __syncthreads();
#pragma unroll
        for (int tt = 0; tt < 2; ++tt) { LAS float* sp = PS + (2 * w + tt) * 260; const f32x4 x = *(LAS f32x4*)(sp + 4 * lane);
            const float mx = wave_max(fmaxf(fmaxf(x[0], x[1]), fmaxf(x[2], x[3])));
            f32x4 e; for (int i = 0; i < 4; ++i) e[i] = __builtin_amdgcn_exp2f(x[i] - mx);
            const float inv = 1.f / wave_sum((e[0] + e[1]) + (e[2] + e[3]));
            for (int i = 0; i < 4; ++i) e[i] = bf2f(f2bf(e[i] * inv));
            *(LAS f32x4*)(sp + 4 * lane) = e; }
        __syncthreads();
        {
            f32x4 acc[16];
#pragma unroll
            for (int t = 0; t < 16; ++t) acc[t] = (f32x4){0.f, 0.f, 0.f, 0.f};
#pragma unroll 1
            for (int jb = 0; jb < 32; jb += 8) {
                f32x4 vv[8];
#pragma unroll
                for (int jj = 0; jj < 8; ++jj) vv[jj] = *(const f32x4*)(mv + (size_t)(w + 8 * (jb + jj)) * 1024 + 4 * lane);
#pragma unroll
                for (int jj = 0; jj < 8; ++jj) { const int key = w + 8 * (jb + jj);
#pragma unroll
                    for (int t = 0; t < 16; ++t) acc[t] += PS[t * 260 + key] * vv[jj]; }
            }
            LAS float* OP = (LAS float*)(lds + 32768);
#pragma unroll
            for (int half = 0; half < 2; ++half) {
#pragma unroll
                for (int tt = 0; tt < 8; ++tt) *(LAS f32x4*)(OP + (w * 8 + tt) * 256 + 4 * lane) = acc[half * 8 + tt];
                __syncthreads();
                f32x4 sum = (f32x4){0.f, 0.f, 0.f, 0.f};
#pragma unroll
                for (int ww = 0; ww < 8; ++ww) sum += *(LAS f32x4*)(OP + (ww * 8 + w) * 256 + 4 * lane);
                st4bf(qx + (srow0 + half * 8 + w) * D + h * 256 + 4 * lane, sum);
                __syncthreads();
            }
        }
    }
    (void)RM;
}

DI void final_norm(int wv, unsigned char* ws, float* out, LAS unsigned char* lds) {
    unsigned z_ = 0u; asm volatile("" : "+v"(z_)); const int tid_ = wv * 64 + (int)__builtin_amdgcn_mbcnt_hi(~0u, __builtin_amdgcn_mbcnt_lo(~0u, z_)); const int tid = tid_, w = __builtin_amdgcn_readfirstlane(tid >> 6), lane = tid & 63, gw = blockIdx.x * 8 + w, NGW = gridDim.x * 8;
    const bf16* xb = (const bf16*)(ws + WS_XB); const float* ss = (const float*)(ws + WS_SS) + (size_t)8 * MT * 16; const float* g = IN(I_FIN);
    f32x4 gv[4];
#pragma unroll
    for (int j = 0; j < 4; ++j) gv[j] = *((const f32x4*)g + lane + 64 * j);
    for (int m = gw; m < MT; m += NGW) {
        const float rs = rsqrtf(ss_row(ss, m) * (1.f / D) + EPS); float* o = out + (m < MP ? O_YP + (size_t)m * D : O_YS + (size_t)(m - MP) * D);
#pragma unroll
        for (int j = 0; j < 4; ++j) { const f32x4 x = ld4bf(xb + (size_t)m * D + 4 * (lane + 64 * j)); *((f32x4*)o + lane + 64 * j) = x * rs * gv[j]; }
    }
}

#ifndef EN
#define EN 0xFFFFF
#endif
#ifndef ONE_LAUNCH
#define ONE_LAUNCH 1
#endif
constexpr int N_PHASES = 24;

template <int NM, int NN, size_t A_M, size_t A_N, size_t B_B, size_t B_N, int BSHIFT, class F>
DI void run_gemm(int wv, LAS unsigned char* lds, int G, int bx, const bf16* A_, int lda, const bf16* Bt, int ldb, int K, const F& f) {
    pg8::Gemm g{A_, Bt, lda, ldb, K, wv}; pg8::Sched<NM, NN, A_M, A_N, B_B, B_N, BSHIFT> Sc; Sc.G = G; Sc.c = bx;
    EpiA<F> E{f};
    pg8::gemm_phase<EpiA<F>, pg8::Sched<NM, NN, A_M, A_N, B_B, B_N, BSHIFT>, true, true>(lds, g, Sc, E);
}
template <int K, int N, class F> DI void prompt_gemm(int wv, LAS unsigned char* lds, int G, int bx, const bf16* A_, const bf16* Bt, const F& f) {
    run_gemm<MP / 256, N / 256, (size_t)256 * K * 2, 0, 0, (size_t)256 * K * 2, 31>(wv, lds, G, bx, A_, K, Bt, K, K, f);
}


#define XB_TMO      128
#define XB_XCNT(j)  (256  + 64 * (j))
#define XB_XSUB(j)  (1280 + 64 * (j))
#define XB_XGEN(j)  (2304 + 64 * (j))
#define XB_TOP      3328
#define XB_TOPGEN   3392
#define XCD_BAR_WORDS 3456
#define XB_SPIN_CAP (1u << 18)
DI unsigned xb_ld(unsigned* p)              { return __hip_atomic_load(p, __ATOMIC_RELAXED, __HIP_MEMORY_SCOPE_AGENT); }
DI unsigned xb_add(unsigned* p, unsigned v) { return __hip_atomic_fetch_add(p, v, __ATOMIC_RELAXED, __HIP_MEMORY_SCOPE_AGENT); }
DI unsigned xb_xcc_id() { return (unsigned)__builtin_amdgcn_s_getreg((3 << 11) | 20) & 0xFu; }
#define XB_SPIN(cond, bar) do { unsigned _sp = 0; while (cond) { __builtin_amdgcn_s_sleep(1); \
    if ((++_sp & 255u) == 0u) { if (xb_ld(&(bar)[XB_TMO])) break; if (_sp > XB_SPIN_CAP) { atomicAdd(&(bar)[XB_TMO], 1u); break; } } } } while (0)
DI void xcd_barrier_complete(unsigned* bar, unsigned x, unsigned G, unsigned& nloc, unsigned& nx) {
    unsigned sum, cnt, mine, sp = 0u;
    for (;;) {
        sum = 0u; cnt = 0u; mine = 0u;
#pragma unroll
        for (unsigned j = 0; j < 16; ++j) { const unsigned c = xb_ld(&bar[XB_XCNT(j)]); sum += c; cnt += (c > 0u) ? 1u : 0u; mine = (j == x) ? c : mine; }
        if (sum == G) break;
        __builtin_amdgcn_s_sleep(1);
        if ((++sp & 255u) == 0u) { if (xb_ld(&bar[XB_TMO])) break; if (sp > XB_SPIN_CAP) { atomicAdd(&bar[XB_TMO], 1u); break; } }
    }
    nloc = mine > 0u ? mine : 1u; nx = cnt > 0u ? cnt : 1u;
}
DI void xcd_barrier(unsigned* bar, volatile LAS unsigned* st, bool first_thread, unsigned G) {
    asm volatile("s_waitcnt vmcnt(0)" ::: "memory");
    __syncthreads();
    if (first_thread) {
        const unsigned x = xb_xcc_id();
        __builtin_amdgcn_s_waitcnt(0);
        unsigned nloc = st[0], nx = st[1];
        if (nloc == 0u) { xcd_barrier_complete(bar, x, G, nloc, nx); st[0] = nloc; st[1] = nx; }
        const unsigned old = xb_add(&bar[XB_XSUB(x)], 1u);
        const unsigned gen = old / nloc;
        if (old + 1u == (gen + 1u) * nloc) {
            __builtin_amdgcn_fence(__ATOMIC_RELEASE, "agent");
            asm volatile("s_waitcnt vmcnt(0)" ::: "memory");
            const unsigned og = xb_add(&bar[XB_TOP], 1u);
            const unsigned tg = og / nx;
            if (og + 1u == (tg + 1u) * nx) xb_add(&bar[XB_TOPGEN], 1u);
            else XB_SPIN(xb_ld(&bar[XB_TOPGEN]) == tg, bar);
            __builtin_amdgcn_fence(__ATOMIC_ACQUIRE, "agent");
            xb_add(&bar[XB_XGEN(x)], 1u);
            asm volatile("s_waitcnt vmcnt(0)" ::: "memory");
        } else {
            XB_SPIN(xb_ld(&bar[XB_XGEN(x)]) == gen, bar);
            __builtin_amdgcn_fence(__ATOMIC_ACQUIRE, "agent");
            asm volatile("s_waitcnt vmcnt(0)" ::: "memory");
        }
    }
    __syncthreads();
}

__global__ void __launch_bounds__(NTHR, 2) fwd_kernel(Args A) {
    extern __shared__ __attribute__((aligned(16))) unsigned char lds_raw[];
    LAS unsigned char* lds = (LAS unsigned char*)lds_raw;
    const int lo = A.ph_lo, hi = A.ph_hi; const int wv = __builtin_amdgcn_readfirstlane((int)threadIdx.x >> 6);
    unsigned char* ws = A.ws; float* out = A.out;
    if (threadIdx.x == 0) { LAS unsigned long long* T = (LAS unsigned long long*)(lds + LDS_TAB);
        T[0] = (unsigned long long)A.in[0];
        T[1] = (unsigned long long)A.in[1];
        T[2] = (unsigned long long)A.in[2];
        T[3] = (unsigned long long)A.in[3];
        T[4] = (unsigned long long)A.in[4];
        T[5] = (unsigned long long)A.in[5];
        T[6] = (unsigned long long)A.in[6];
        T[7] = (unsigned long long)A.in[7];
        T[8] = (unsigned long long)A.in[8];
        T[9] = (unsigned long long)A.in[9];
        T[10] = (unsigned long long)A.in[10];
        T[11] = (unsigned long long)A.in[11];
        T[12] = (unsigned long long)A.in[12];
        T[13] = (unsigned long long)A.in[13];
        T[14] = (unsigned long long)A.in[14];
        T[15] = (unsigned long long)A.in[15];
        T[16] = (unsigned long long)A.in[16];
        T[17] = (unsigned long long)A.in[17];
        T[18] = (unsigned long long)A.in[18];
        T[19] = (unsigned long long)A.in[19];
        T[20] = (unsigned long long)A.in[20];
        T[21] = (unsigned long long)A.in[21];
        T[22] = (unsigned long long)A.in[22];
        T[23] = (unsigned long long)A.in[23];
        T[24] = (unsigned long long)A.in[24];
        T[25] = (unsigned long long)A.in[25];
        T[26] = (unsigned long long)A.in[26];
        T[27] = (unsigned long long)A.in[27];
        T[28] = (unsigned long long)A.in[28];
        T[29] = (unsigned long long)A.in[29];
        T[30] = (unsigned long long)A.in[30];
        T[31] = (unsigned long long)A.in[31];
        T[32] = (unsigned long long)A.in[32];
        T[33] = (unsigned long long)A.in[33];
        *(LAS unsigned*)(lds + LDS_TAB + 384) = 0u; *(LAS unsigned*)(lds + LDS_TAB + 388) = 0u;
    }
    __syncthreads();
#ifndef CG_ALL
#define CG_ALL 0
#endif
#define SYNC(ph) do { if ((ph) + 1 < hi) { if (CG_ALL || (ph) == 0) cg::this_grid().sync(); else for (int rb_ = 0; rb_ < (PROBE == 16 ? 2 : 1); ++rb_) { unsigned z2_ = 0u; asm volatile("" : "+v"(z2_)); const bool ft_ = wv == 0 && __builtin_amdgcn_mbcnt_hi(~0u, __builtin_amdgcn_mbcnt_lo(~0u, z2_)) == 0u; xcd_barrier((unsigned*)ws, (volatile LAS unsigned*)(lds + LDS_TAB + 384), ft_, gridDim.x); } } } while (0)
    if (lo == 0) { if (EN & 0x10000) prologue(wv, ws, out, lds);
        if (blockIdx.x == 0) for (int i = threadIdx.x; i < 4096; i += NTHR) ((unsigned*)ws)[i] = 0u;
        __syncthreads();
        SYNC(0);
        if (threadIdx.x == 0) (void)xb_add(&((unsigned*)ws)[XB_XCNT(xb_xcc_id())], 1u);
    }
    for (int ph = (lo > 1 ? lo : 1); ph < (hi < N_PHASES - 1 ? hi : N_PHASES - 1); ++ph) {
        int G = gridDim.x, bx = blockIdx.x; asm volatile("" : "+s"(G), "+s"(bx), "+s"(out));
        const int smp_c0 = (bx + G / 2) % G;
        const int l = (ph - 1) / 11, k = (ph - 1) % 11;
        asm volatile("" : "+s"(ws));
        unsigned char* R = ws + WS_R; bf16* xb = (bf16*)(ws + WS_XB); float* ss = (float*)(ws + WS_SS); bf16* hb = (bf16*)(R + R_H);
        unsigned char* wl = ws + WS_W + (size_t)l * LW;
        float* ssl = ss + (size_t)(4 * l) * MT * 16;
        if (!((EN >> k) & 1)) continue;
        switch (k) {
        case 0: case 9: {
            const bool second = k == 9;
            if (!second) {
                FMemKV f{out + O_MK + (size_t)l * 512 * D, out + O_MV + (size_t)l * 512 * D, (bf16*)(ws + WS_MKB) + (size_t)l * 512 * D, (bf16*)(ws + WS_MVT) + (size_t)l * 8 * 65536};
                run_gemm<2, 8, (size_t)256 * D * 2, 0, 0, (size_t)256 * D * 2, 31>(wv, lds, G, bx, (const bf16*)(ws + WS_MN), D, (const bf16*)(wl + W_KV), D, D, f);
                __syncthreads();
            }
            FUp f{ssl + (second ? 3 : 0) * (size_t)MT * 16, hb, (LAS float*)(lds + LDS_EPI)};
#if PROBE == 11
            { FUpCheap f0{hb}; prompt_gemm<D, 2 * FF>(wv, lds, G, bx, xb, (const bf16*)(wl + (second ? W_2 : W_1)), f0); __syncthreads(); }
#endif
            prompt_gemm<D, 2 * FF>(wv, lds, G, bx, xb, (const bf16*)(wl + (second ? W_2 : W_1)), f);
#if PROBE == 1
            __syncthreads(); prompt_gemm<D, 2 * FF>(wv, lds, G, bx, xb, (const bf16*)(wl + (second ? W_2 : W_1)), f);
#endif
            __syncthreads();
            sample_gemm_wide(wv, lds, xb, (const bf16*)(wl + (second ? W_2 : W_1)), 2 * FF / 256, f, G, smp_c0);
        } break;
        case 1: case 10: {
            const bool second = k == 10;
            FRes f{xb, ssl + (second ? 4 : 1) * (size_t)MT * 16, 0.5f};
#if PROBE == 4
            { FRes f0{xb, ssl + (second ? 4 : 1) * (size_t)MT * 16, 0.0f}; prompt_gemm<FF, D>(wv, lds, G, bx, hb, (const bf16*)(wl + (second ? W_D2 : W_D1)), f0); __syncthreads(); }
#endif
            prompt_gemm<FF, D>(wv, lds, G, bx, hb, (const bf16*)(wl + (second ? W_D2 : W_D1)), f);
            __syncthreads();
            sample_gemm<FF>(wv, lds, hb, FF, (const bf16*)(wl + (second ? W_D2 : W_D1)), FF, D / 256, f, G, smp_c0);
        } break;
        case 2: {
            FWin f{ssl + (size_t)MT * 16, ws, out, l, (LAS float*)(lds + LDS_EPI)};
            prompt_gemm<D, 2048>(wv, lds, G, bx, xb, (const bf16*)(wl + W_IN), f);
#if PROBE == 8
            __syncthreads(); prompt_gemm<D, 2048>(wv, lds, G, bx, xb, (const bf16*)(wl + W_IN), f);
#endif
            __syncthreads();
            sample_gemm_wide(wv, lds, xb, (const bf16*)(wl + W_IN), 8, f, G, smp_c0);
        } break;
        case 3: mixer_phase(wv, ws, out, l, lds, G, bx);
#if PROBE == 2
            __syncthreads(); mixer_phase(wv, ws, out, l, lds, G, bx);
#endif
            break;
        case 4: case 8: {
            const bool xo = k == 8;
            FRes f{xb, ssl + (xo ? 3 : 2) * (size_t)MT * 16, 1.0f};
            const bf16* Ain = xo ? (const bf16*)(R + R_QX) : (const bf16*)(R + R_YMIX);
            prompt_gemm<D, D>(wv, lds, G, bx, Ain, (const bf16*)(wl + (xo ? W_O : W_OUT)), f);
            __syncthreads();
            sample_gemm<D>(wv, lds, Ain, D, (const bf16*)(wl + (xo ? W_O : W_OUT)), D, 4, f, G, smp_c0);
        } break;
        case 5: {
            FScale f{ssl + 2 * (size_t)MT * 16, (bf16*)(R + R_QX), 0.0625f * LOG2E, (LAS float*)(lds + LDS_EPI)};
            prompt_gemm<D, D>(wv, lds, G, bx, xb, (const bf16*)(wl + W_Q), f);
#if PROBE == 5
            __syncthreads(); prompt_gemm<D, D>(wv, lds, G, bx, xb, (const bf16*)(wl + W_Q), f);
#endif
            __syncthreads();
            sample_gemm<D>(wv, lds, xb, D, (const bf16*)(wl + W_Q), D, 4, f, G, smp_c0);
#if PROBE == 10
            sample_gemm<D>(wv, lds, xb, D, (const bf16*)(wl + W_Q), D, 4, f, G, smp_c0);
#endif
        } break;
        case 6: {
            pg8::Gemm g{(const bf16*)(R + R_QX), (const bf16*)(ws + WS_MKB) + (size_t)l * 512 * D, D, D, 256, wv};
            typedef pg8::Sched<MP / 256, 4, (size_t)256 * D * 2, 512, (size_t)256 * D * 2, 512, 6> SchS; SchS Sc; Sc.G = G; Sc.c = bx;
            EpiS E{(bf16*)(R + R_P), (float*)(ws + WS_LINV), (LAS float*)(lds + LDS_EPI)};
            pg8::gemm_phase<EpiS, SchS, true, true>(lds, g, Sc, E);
#if PROBE == 9
            __syncthreads(); pg8::gemm_phase<EpiS, SchS, true, true>(lds, g, Sc, E);
#endif
            __syncthreads();
            xattn_sample(wv, ws, out, l, lds, G, bx);
            asm volatile("s_waitcnt vmcnt(0)" ::: "memory"); __syncthreads();
            FPV f{(const float*)(ws + WS_LINV), (bf16*)(R + R_QX)};
            run_gemm<MP / 256, 4, (size_t)256 * D * 2, 512, (size_t)4 * 65536 * 2, (size_t)65536 * 2, 6>(wv, lds, G, bx, (const bf16*)(ws + WS_R + R_P), D, (const bf16*)(ws + WS_MVT) + (size_t)l * 8 * 65536, 256, 256, f);
#if PROBE == 9
            __syncthreads();
            run_gemm<MP / 256, 4, (size_t)256 * D * 2, 512, (size_t)4 * 65536 * 2, (size_t)65536 * 2, 6>(wv, lds, G, bx, (const bf16*)(ws + WS_R + R_P), D, (const bf16*)(ws + WS_MVT) + (size_t)l * 8 * 65536, 256, 256, f);
#endif
        } break;
        case 7: break;
        }
        __syncthreads();
        if (k != 6) SYNC(ph);
    }
    if (hi == N_PHASES) { if (EN & 0x20000) final_norm(wv, ws, out, lds); }
#undef SYNC
}

extern "C" void kernel_launch(void* const* d_in, const int* in_sizes, int n_in, void* d_out, int out_size, void* d_ws, size_t ws_size, hipStream_t stream) {
    static int grid = 0;
    if (grid == 0) {
        if (n_in != 34 || (size_t)out_size != O_END || ws_size < WS_END) { fprintf(stderr, "kernel_launch: unexpected shapes n_in %d out %d ws %zu (need %zu)\n", n_in, out_size, ws_size, (size_t)WS_END); grid = -1; return; }
        int dev = 0, cus = 0, per_cu = 0;
        hipGetDevice(&dev); hipDeviceGetAttribute(&cus, hipDeviceAttributeMultiprocessorCount, dev);
        if (hipFuncSetAttribute((const void*)fwd_kernel, hipFuncAttributeMaxDynamicSharedMemorySize, LDS_BYTES) != hipSuccess) { fprintf(stderr, "kernel_launch: hipFuncSetAttribute failed\n"); grid = -1; return; }
        if (hipOccupancyMaxActiveBlocksPerMultiprocessor(&per_cu, (const void*)fwd_kernel, NTHR, LDS_BYTES) != hipSuccess || per_cu < 1) { fprintf(stderr, "kernel_launch: occupancy query says %d\n", per_cu); per_cu = 1; }
        (void)hipGetLastError();
        grid = cus;
    }
    if (grid < 0) return;
    Args a{};
    for (int i = 0; i < 34; ++i) a.in[i] = (const float*)d_in[i];
    a.out = (float*)d_out; a.ws = (unsigned char*)d_ws;
#if ONE_LAUNCH
    a.ph_lo = 0; a.ph_hi = N_PHASES;
    void* args[] = {&a};
    hipError_t e = hipLaunchCooperativeKernel((const void*)fwd_kernel, dim3(grid), dim3(NTHR), args, LDS_BYTES, stream);
    if (e != hipSuccess) fprintf(stderr, "cooperative launch failed: %s (grid %d)\n", hipGetErrorString(e), grid);
#else
    for (int ph = 0; ph < N_PHASES; ++ph) { a.ph_lo = ph; a.ph_hi = ph + 1; hipLaunchKernelGGL(fwd_kernel, dim3(grid), dim3(NTHR), LDS_BYTES, stream, a); }
#endif
}
```

```cpp
#include <hip/hip_runtime.h>
#include <hip/hip_cooperative_groups.h>
#include <cstdio>
#include <cstdint>
namespace cg = cooperative_groups;
#ifndef PROBE
#define PROBE 0
#endif
namespace pg8 {
#define PG8_LAS __attribute__((address_space(3)))
typedef unsigned short bf16_t;
typedef short bf16x8 __attribute__((ext_vector_type(8)));
typedef float f32x4 __attribute__((ext_vector_type(4)));
typedef unsigned u32x4 __attribute__((ext_vector_type(4)));
constexpr int BM = 256, BK = 64, HALF = 128, HTB = HALF * BK * 2  , STAGE_BYTES = 8 * HTB, NXCD = 8, WGM = 8;

__host__ __device__ __forceinline__ int lds_byte(int r, int c) { const int st = (r >> 4) * 2 + (c >> 5), rr = r & 15, cc = c & 31, ob = rr * 64 + cc * 2; return st * 1024 + (ob ^ (((ob >> 9) & 1) << 5)); }
__host__ __device__ __forceinline__ void stage_rc(int b, int& R, int& C) { const int st = b / 1024, sb = b % 1024, swz = sb ^ (((sb >> 9) & 1) << 5); R = (st >> 1) * 16 + swz / 64; C = (st & 1) * 32 + (swz % 64) / 2; }
__host__ __device__ __forceinline__ int perm32(int rho) { const int n = rho >> 4, i = rho & 15; return 8 * (i >> 2) + 4 * n + (i & 3); }


struct Unit { int pm, pn; size_t aoff, boff; int npm, par; };
struct Gemm { const bf16_t* A; const bf16_t* Bt; int lda, ldb, K, wv; };

template <int NM, int NN, size_t A_M, size_t A_N, size_t B_B, size_t B_N, int BSHIFT> struct Sched {
    int G, c;
    __device__ bool next(int i, Unit& u) const {
        constexpr int nwg = NM * NN;
        const long L = (long)i * G + c; if (L >= nwg) return false;
        int wgid = (int)L; { constexpr int q = nwg / NXCD, r = nwg % NXCD; const int xcd = wgid % NXCD, off = wgid / NXCD; wgid = (xcd < r ? xcd * (q + 1) : r * (q + 1) + (xcd - r) * q) + off; }
        constexpr int nig = WGM * NN; const int gid = wgid / nig, fm = gid * WGM, gsz = (NM - fm) < WGM ? (NM - fm) : WGM;
        u.pm = fm + ((wgid % nig) % gsz); u.pn = (wgid % nig) / gsz;
        u.aoff = (size_t)u.pm * A_M + (size_t)u.pn * A_N; u.boff = (size_t)(u.pm >> BSHIFT) * B_B + (size_t)u.pn * B_N; return true;
    }
    __device__ __forceinline__ void a_ready(const Unit&) const {}
    __device__ __forceinline__ void done(const Unit&) const {}
};
template <class Epi, class Sched, bool ALIGN_EPI = false, bool SP2 = false>
__device__ __forceinline__ void gemm_phase(PG8_LAS unsigned char* lds, const Gemm g, const Sched& S, const Epi& E) {
    unsigned z_ = 0u; asm volatile("" : "+v"(z_)); const int tid_ = g.wv * 64 + (int)__builtin_amdgcn_mbcnt_hi(~0u, __builtin_amdgcn_mbcnt_lo(~0u, z_)); const int tid = tid_, wid = __builtin_amdgcn_readfirstlane(tid >> 6), lane = tid & 63, wr = wid >> 2, wc = wid & 3, fr = lane & 15, fq = lane >> 4;
    const int K = g.K, nt = K / BK;
    unsigned voffA[2], voffB[2];
#pragma unroll
    for (int i = 0; i < 2; ++i) { int R, C; stage_rc(tid * 16 + i * 8192, R, C); const int Rb = Epi::PERM ? ((R & ~31) + perm32(R & 31)) : R;
        voffA[i] = (unsigned)(R * g.lda + C) * 2u; voffB[i] = (unsigned)(Rb * g.ldb + C) * 2u; }
    const size_t kstep = (size_t)(BK * 2);
    const size_t hstepA = (size_t)HALF * g.lda * 2, hstepB = (size_t)HALF * g.ldb * 2;
    const unsigned ldsw = (unsigned)wid * 1024u;
    const int aoff = lds_byte(wr * 64 + fr, fq * 8), boff = lds_byte(wc * 32 + fr, fq * 8);
#define PG8_SA(b, h) (((b) * 2 + (h)) * HTB)
#define PG8_SB(b, h) ((4 + (b) * 2 + (h)) * HTB)
#define PG8_STAGE(bufoff, gbase, voff) do { _Pragma("unroll") for (int _i = 0; _i < 2; ++_i) \
        __builtin_amdgcn_global_load_lds((const unsigned*)((const char*)(gbase) + (voff)[_i]), (PG8_LAS unsigned*)(lds + (bufoff) + ldsw + _i * 8192), 16, 0, 0); } while (0)
#define PG8_LDA(dst, b, h) do { _Pragma("unroll") for (int m = 0; m < 4; ++m) _Pragma("unroll") for (int k = 0; k < 2; ++k) dst[m][k] = *(const PG8_LAS bf16x8*)(lds + PG8_SA(b, h) + aoff + m * 2048 + k * 1024); } while (0)
#define PG8_LDB(dst, b, h) do { _Pragma("unroll") for (int n = 0; n < 2; ++n) _Pragma("unroll") for (int k = 0; k < 2; ++k) dst[n][k] = *(const PG8_LAS bf16x8*)(lds + PG8_SB(b, h) + boff + n * 2048 + k * 1024); } while (0)
#define PG8_MMA(ai, bj, At, Bt) do { __builtin_amdgcn_s_setprio(1); _Pragma("unroll") for (int m = 0; m < 4; ++m) _Pragma("unroll") for (int n = 0; n < 2; ++n) _Pragma("unroll") for (int k = 0; k < 2; ++k) \
        acc[ai][bj][m][n] = __builtin_amdgcn_mfma_f32_16x16x32_bf16(Bt[n][k], At[m][k], acc[ai][bj][m][n], 0, 0, 0); __builtin_amdgcn_s_setprio(0); } while (0)
#define PG8_WAIT_V(n) asm volatile("s_waitcnt vmcnt(" #n ")" ::: "memory")
#define PG8_WAIT_L(n) asm volatile("s_waitcnt lgkmcnt(" #n ")" ::: "memory")
#define PG8_BAR __builtin_amdgcn_s_barrier()
#define PG8_SCHED __builtin_amdgcn_sched_barrier(0)
    Unit cur, nxt; int ui = 0;
    if (!S.next(0, cur)) return;
    f32x4 acc[2][2][4][2];
#pragma unroll
    for (int a = 0; a < 2; ++a)
#pragma unroll
        for (int b = 0; b < 2; ++b)
#pragma unroll
            for (int m = 0; m < 4; ++m)
#pragma unroll
                for (int n = 0; n < 2; ++n) acc[a][b][m][n] = (f32x4){0.f, 0.f, 0.f, 0.f};
    bf16x8 At[4][2], B0[2][2], B1[2][2];
    const char* cA = (const char*)g.A + cur.aoff; const char* cB = (const char*)g.Bt + cur.boff;
    S.a_ready(cur);
    if constexpr (SP2) {
        PG8_STAGE(PG8_SB(0, 0), cB, voffB); PG8_STAGE(PG8_SB(0, 1), cB + hstepB, voffB); PG8_STAGE(PG8_SA(0, 0), cA, voffA); PG8_STAGE(PG8_SA(0, 1), cA + hstepA, voffA);
        if (wr == 1) PG8_BAR;
        PG8_WAIT_V(2); PG8_BAR;
        PG8_STAGE(PG8_SB(1, 0), cB + kstep, voffB); PG8_STAGE(PG8_SA(1, 0), cA + kstep, voffA); PG8_STAGE(PG8_SB(1, 1), cB + hstepB + kstep, voffB);
        PG8_WAIT_V(6); PG8_BAR;
    } else {
        PG8_STAGE(PG8_SB(0, 0), cB, voffB); PG8_STAGE(PG8_SA(0, 0), cA, voffA); PG8_STAGE(PG8_SB(0, 1), cB + hstepB, voffB); PG8_STAGE(PG8_SA(0, 1), cA + hstepA, voffA);
        if (wr == 1) PG8_BAR;
        PG8_WAIT_V(4); PG8_BAR;
        PG8_STAGE(PG8_SB(1, 0), cB + kstep, voffB); PG8_STAGE(PG8_SA(1, 0), cA + kstep, voffA); PG8_STAGE(PG8_SB(1, 1), cB + hstepB + kstep, voffB);
        PG8_WAIT_V(6); PG8_BAR;
    }
    for (;;) {
        const bool has_next = S.next(ui + 1, nxt);
        const char* nA = has_next ? (const char*)g.A + nxt.aoff : cA; const char* nB = has_next ? (const char*)g.Bt + nxt.boff : cB;
#pragma unroll 1
        for (int t = 0; t < nt; t += 2) {
            const bool last = (t == nt - 2);
            const char* a1 = cA + (size_t)(t + 1) * kstep;
            const char* a2 = last ? nA : cA + (size_t)(t + 2) * kstep; const char* b2 = last ? nB : cB + (size_t)(t + 2) * kstep;
            const char* a3 = a2 + kstep; const char* b3 = b2 + kstep;
            if (last && has_next) S.a_ready(nxt);
            if constexpr (SP2) {
            PG8_LDB(B0, 0, 0); PG8_LDB(B1, 0, 1); PG8_SCHED; PG8_LDA(At, 0, 0); PG8_STAGE(PG8_SA(1, 1), a1 + hstepA, voffA);
            PG8_WAIT_V(8); PG8_WAIT_L(0); PG8_BAR; PG8_MMA(0, 0, At, B0); PG8_MMA(0, 1, At, B1); PG8_BAR; PG8_SCHED;
            PG8_LDA(At, 0, 1); PG8_STAGE(PG8_SB(0, 0), b2, voffB); PG8_STAGE(PG8_SB(0, 1), b2 + hstepB, voffB); PG8_STAGE(PG8_SA(0, 0), a2, voffA);
            PG8_WAIT_V(8); PG8_WAIT_L(0); PG8_BAR; PG8_MMA(1, 0, At, B0); PG8_MMA(1, 1, At, B1); PG8_BAR; PG8_SCHED;
            PG8_LDB(B0, 1, 0); PG8_LDB(B1, 1, 1); PG8_SCHED; PG8_LDA(At, 1, 0); PG8_STAGE(PG8_SA(0, 1), a2 + hstepA, voffA);
            PG8_WAIT_V(8); PG8_WAIT_L(0); PG8_BAR; PG8_MMA(0, 0, At, B0); PG8_MMA(0, 1, At, B1); PG8_BAR; PG8_SCHED;
            PG8_LDA(At, 1, 1); PG8_STAGE(PG8_SB(1, 0), b3, voffB); PG8_STAGE(PG8_SB(1, 1), b3 + hstepB, voffB); PG8_STAGE(PG8_SA(1, 0), a3, voffA);
            PG8_WAIT_V(8); PG8_WAIT_L(0); PG8_BAR; PG8_MMA(1, 0, At, B0); PG8_MMA(1, 1, At, B1); PG8_BAR; PG8_SCHED;
            } else {
            PG8_LDB(B0, 0, 0); PG8_SCHED; PG8_LDA(At, 0, 0); PG8_STAGE(PG8_SA(1, 1), a1 + hstepA, voffA);
            PG8_WAIT_L(8); PG8_BAR; PG8_WAIT_L(0); PG8_MMA(0, 0, At, B0); PG8_BAR; PG8_SCHED;
            PG8_LDB(B1, 0, 1); PG8_STAGE(PG8_SB(0, 0), b2, voffB);
            PG8_BAR; PG8_WAIT_L(0); PG8_MMA(0, 1, At, B1); PG8_BAR;
            PG8_LDA(At, 0, 1); PG8_STAGE(PG8_SA(0, 0), a2, voffA);
            PG8_BAR; PG8_WAIT_L(0); PG8_MMA(1, 0, At, B0); PG8_BAR; PG8_SCHED;
            PG8_STAGE(PG8_SB(0, 1), b2 + hstepB, voffB);
            PG8_WAIT_V(6); PG8_BAR; PG8_MMA(1, 1, At, B1); PG8_BAR;
            PG8_LDB(B0, 1, 0); PG8_SCHED; PG8_LDA(At, 1, 0); PG8_STAGE(PG8_SA(0, 1), a2 + hstepA, voffA);
            PG8_WAIT_L(8); PG8_BAR; PG8_WAIT_L(0); PG8_MMA(0, 0, At, B0); PG8_BAR; PG8_SCHED;
            PG8_LDB(B1, 1, 1); PG8_STAGE(PG8_SB(1, 0), b3, voffB);
            PG8_BAR; PG8_WAIT_L(0); PG8_MMA(0, 1, At, B1); PG8_BAR;
            PG8_LDA(At, 1, 1); PG8_STAGE(PG8_SA(1, 0), a3, voffA);
            PG8_BAR; PG8_WAIT_L(0); PG8_MMA(1, 0, At, B0); PG8_BAR; PG8_SCHED;
            PG8_STAGE(PG8_SB(1, 1), b3 + hstepB, voffB);
            PG8_WAIT_V(6); PG8_BAR; PG8_MMA(1, 1, At, B1); PG8_BAR;
            }
        }
        if constexpr (ALIGN_EPI) { if (wr == 0) PG8_BAR; }
        if constexpr (!Epi::AFTER_DRAIN) { E(acc, cur, wr, wc, fr, fq); S.done(cur); }
        if (!has_next) break;
#pragma unroll
        for (int a = 0; a < 2; ++a)
#pragma unroll
            for (int b = 0; b < 2; ++b)
#pragma unroll
                for (int m = 0; m < 4; ++m)
#pragma unroll
                    for (int n = 0; n < 2; ++n) acc[a][b][m][n] = (f32x4){0.f, 0.f, 0.f, 0.f};
        cur = nxt; cA = nA; cB = nB; ++ui;
        if constexpr (ALIGN_EPI) { if (wr == 1) PG8_BAR; }
    }
    PG8_WAIT_V(0);
    if constexpr (!ALIGN_EPI) { if (wr == 0) PG8_BAR; }
    PG8_BAR;
    if constexpr (Epi::AFTER_DRAIN) { E.fused(acc, cur, wr, wc, fr, fq, lds, wid, lane); S.done(cur); }
#undef PG8_SA
#undef PG8_SB
#undef PG8_STAGE
#undef PG8_LDA
#undef PG8_LDB
#undef PG8_MMA
#undef PG8_WAIT_V
#undef PG8_WAIT_L
#undef PG8_BAR
#undef PG8_SCHED
}}

#define DI __device__ __forceinline__
#define LAS __attribute__((address_space(3)))
typedef unsigned short bf16;
typedef short bf16x8 __attribute__((ext_vector_type(8)));
typedef float f32x4 __attribute__((ext_vector_type(4)));
typedef float f32x16 __attribute__((ext_vector_type(16)));
typedef unsigned u32x4 __attribute__((ext_vector_type(4)));
typedef unsigned u32x2 __attribute__((ext_vector_type(2)));
typedef __bf16 bf16x2_t __attribute__((ext_vector_type(2)));
typedef float f32x2_t __attribute__((ext_vector_type(2)));
using pg8::Unit;

constexpr int D = 1024, S = 16384, NB = 2, MP = NB * S, MS = 256, MT = MP + MS, FF = 2816, NL = 2, NTHR = 512;
constexpr float EPS = 1e-6f, LOG2E = 1.4426950408889634f;
constexpr size_t MiB = 1u << 20;
constexpr size_t WS_SS_OLD = 0;
constexpr size_t WS_LINV = 2 * MiB;
constexpr size_t WS_ROPE = 3 * MiB;
constexpr size_t WS_MN = 7 * MiB;
constexpr size_t WS_MKB = 8 * MiB;
constexpr size_t WS_MVT = 10 * MiB;
constexpr size_t WS_W = 12 * MiB, LW = 47 * MiB;
constexpr size_t W_1 = 0, W_D1 = 11 * MiB, W_IN = W_D1 + 11 * MiB / 2, W_OUT = W_IN + 4 * MiB, W_Q = W_OUT + 2 * MiB, W_O = W_Q + 2 * MiB, W_2 = W_O + 2 * MiB, W_D2 = W_2 + 11 * MiB, W_KV = W_D2 + 11 * MiB / 2;
static_assert(W_KV + 4 * MiB == LW, "weights map");
constexpr size_t WS_XB = WS_W + 2 * LW;
constexpr size_t WS_R = WS_XB + 65 * MiB;
constexpr size_t R_H = 0;
constexpr size_t R_GB = 0, R_CV = R_GB + (size_t)MT * 256 * 2, R_Q = R_CV + (size_t)MT * 256 * 2, R_K = R_Q + (size_t)MT * 512 * 2, R_VT = R_K + (size_t)MT * 128 * 2,
                 R_VS = R_VT + (size_t)NB * 128 * S * 2, R_GLU = R_VS + (size_t)MS * 128 * 2, R_YMIX = 101 * MiB;
static_assert(R_GLU + (size_t)MT * 256 * 2 <= R_YMIX, "R map");
constexpr size_t R_QX = 0, R_P = 68 * MiB;
constexpr size_t WS_SS = WS_R + 178 * MiB;
constexpr size_t WS_END = WS_SS + 19 * MiB;
static_assert((size_t)9 * MT * 64 <= 19 * MiB, "ss");
static_assert((size_t)MT * FF * 2 <= 178 * MiB && (size_t)MT * D * 2 <= 65 * MiB, "sizes");
constexpr size_t O_YP = 0, O_YS = O_YP + (size_t)MP * D, O_KP = O_YS + (size_t)MS * D, O_VP = O_KP + 65536, O_AP = O_VP + 65536, O_CP = O_AP + 2048, O_MK = O_CP + 30720,
                 O_MV = O_MK + 1048576, O_KS = O_MV + 1048576, O_VS = O_KS + 65536, O_AS = O_VS + 65536, O_CS = O_AS + 16384, O_END = O_CS + 245760;
constexpr int LDS_BYTES = 162816, LDS_EPI = 131072, LDS_TAB = 162816 - 512;

struct Args { const float* in[34]; float* out; unsigned char* ws; int ph_lo, ph_hi; };
enum { I_XP = 0, I_XS, I_CK, I_CV, I_SA, I_SC, I_MK, I_MV, I_MEM, I_F1N, I_F1G, I_F1U, I_F1D, I_MIXN, I_WIN, I_CAW, I_SINK, I_CCW, I_CCB, I_LNG, I_LNB, I_MON, I_WOUT,
       I_XAN, I_MEMN, I_WQ, I_WK, I_WV, I_WO, I_F2N, I_F2G, I_F2U, I_F2D, I_FIN };

DI const float* tab_ptr(LAS unsigned char* lds, int idx) { const u32x2 v = *((const LAS u32x2*)(lds + LDS_TAB) + idx); const unsigned lo = __builtin_amdgcn_readfirstlane(v.x), hi = __builtin_amdgcn_readfirstlane(v.y); return (const float*)(((unsigned long long)hi << 32) | lo); }
#define IN(idx) tab_ptr(lds, idx)
DI float ss_row(const float* ss, int row) { const f32x4* p = (const f32x4*)(ss + (size_t)row * 16); const f32x4 a = p[0], b = p[1], c = p[2], d = p[3]; return (((a[0] + a[1]) + (a[2] + a[3])) + ((b[0] + b[1]) + (b[2] + b[3]))) + (((c[0] + c[1]) + (c[2] + c[3])) + ((d[0] + d[1]) + (d[2] + d[3]))); }
DI float bf2f(unsigned short b) { return __uint_as_float((unsigned)b << 16); }
DI unsigned pk2(float lo, float hi) { f32x2_t v = {lo, hi}; bf16x2_t b = __builtin_convertvector(v, bf16x2_t); return __builtin_bit_cast(unsigned, b); }
DI bf16 f2bf(float f) { return (bf16)(pk2(f, 0.f) & 0xffffu); }
DI void st4bf(bf16* p, f32x4 v) { u32x2 w; w.x = pk2(v[0], v[1]); w.y = pk2(v[2], v[3]); *(u32x2*)p = w; }
DI f32x4 unpk4(u32x2 w) { return (f32x4){__uint_as_float(w.x << 16), __uint_as_float(w.x & 0xffff0000u), __uint_as_float(w.y << 16), __uint_as_float(w.y & 0xffff0000u)}; }
DI f32x4 ld4bf(const bf16* p) { return unpk4(*(const u32x2*)p); }
DI void st8bf(bf16* p, f32x4 a, f32x4 b) { u32x4 w; w.x = pk2(a[0], a[1]); w.y = pk2(a[2], a[3]); w.z = pk2(b[0], b[1]); w.w = pk2(b[2], b[3]); *(u32x4*)p = w; }
DI float dpp_f(float v, const int ctrl_tag);
template <int CTRL> DI float dppx(float v) { return __builtin_bit_cast(float, __builtin_amdgcn_update_dpp(0, __builtin_bit_cast(int, v), CTRL, 0xf, 0xf, true)); }
DI float wave_sum(float v) {
    v += dppx<0xB1>(v); v += dppx<0x4E>(v); v += dppx<0x141>(v); v += dppx<0x140>(v);
    const float a = __builtin_bit_cast(float, __builtin_amdgcn_readlane(__builtin_bit_cast(int, v), 0)), b = __builtin_bit_cast(float, __builtin_amdgcn_readlane(__builtin_bit_cast(int, v), 16)),
                c = __builtin_bit_cast(float, __builtin_amdgcn_readlane(__builtin_bit_cast(int, v), 32)), d = __builtin_bit_cast(float, __builtin_amdgcn_readlane(__builtin_bit_cast(int, v), 48));
    return (a + b) + (c + d);
}
DI float wave_max(float v) {
#pragma unroll
    for (int o = 1; o < 64; o <<= 1) v = fmaxf(v, __shfl_xor(v, o));
    return v;
}
DI float sigmoidf_(float x) { return __builtin_amdgcn_rcpf(1.f + __builtin_amdgcn_exp2f(-LOG2E * x)); }
#define LDS_WAIT() asm volatile("s_waitcnt lgkmcnt(0)" ::: "memory")
#define EPI_BAR() do { asm volatile("s_waitcnt lgkmcnt(0)" ::: "memory"); __builtin_amdgcn_s_barrier(); asm volatile("" ::: "memory"); } while (0)

template <class F> struct EpiA {
    static constexpr bool PERM = F::PERM, AFTER_DRAIN = false; F f;
    template <int KIND> DI void body(const f32x4 (&acc)[2][2][4][2], const Unit& u, int wr, int wc, int fr, int fq) const {
#pragma unroll
        for (int ai = 0; ai < 2; ++ai)
#pragma unroll
            for (int m = 0; m < 4; ++m) {
                const int lr = ai * 128 + wr * 64 + m * 16 + fr, row = u.pm * 256 + lr; typename F::Row rc; f.row_begin(rc, row, u.pn, lr);
                if constexpr (F::PERM) f.template apply8<KIND>(rc, row, u.pn, wc * 32 + fq * 8, acc[ai][0][m][0], acc[ai][0][m][1], acc[ai][1][m][0], acc[ai][1][m][1]);
                else {
#pragma unroll
                for (int n = 0; n < 2; ++n) f.template apply<KIND>(rc, row, u.pn, wc * 32 + n * 16 + fq * 4, acc[ai][0][m][n], acc[ai][1][m][n]); }
                f.row_end(rc, row, u.pn, fq, wc);
            }
    }
    DI void operator()(const f32x4 (&acc)[2][2][4][2], const Unit& u, int wr, int wc, int fr, int fq) const {
        asm volatile("" : "+v"(fr), "+v"(fq));
        if constexpr (F::USE_SS) {
            const int t = (wr * 4 + wc) * 64 + fq * 16 + fr;
            if (t < 256) f.rsl[t] = rsqrtf(ss_row(f.ss, u.pm * 256 + t) * (1.f / D) + EPS);
            EPI_BAR();
        }
        if constexpr (F::NKIND == 1) body<0>(acc, u, wr, wc, fr, fq);
        else { const int kd = f.kind(u.pn);
            if (kd == 0) body<0>(acc, u, wr, wc, fr, fq); else if (kd == 1) body<1>(acc, u, wr, wc, fr, fq);
            else if constexpr (F::NKIND > 2) { if (kd == 2) body<2>(acc, u, wr, wc, fr, fq); else if (kd == 3) body<3>(acc, u, wr, wc, fr, fq); else body<4>(acc, u, wr, wc, fr, fq); } }    }
};
template <class F> DI void apply_two(const F& f, int row, int pn, int c, const f32x4 (&v0)[2], const f32x4 (&v1)[2], int fq, int sub) {
    typename F::Row rc; f.row_begin(rc, row, pn, -1);
#pragma unroll
    for (int wb = 0; wb < 2; ++wb) {
        if constexpr (F::NKIND == 1) f.template apply<0>(rc, row, pn, c + wb * 16, v0[wb], v1[wb]);
        else { const int kd = f.kind(pn);
            if (kd == 0) f.template apply<0>(rc, row, pn, c + wb * 16, v0[wb], v1[wb]); else if (kd == 1) f.template apply<1>(rc, row, pn, c + wb * 16, v0[wb], v1[wb]);
            else if constexpr (F::NKIND > 2) { if (kd == 2) f.template apply<2>(rc, row, pn, c + wb * 16, v0[wb], v1[wb]); else if (kd == 3) f.template apply<3>(rc, row, pn, c + wb * 16, v0[wb], v1[wb]); else f.template apply<4>(rc, row, pn, c + wb * 16, v0[wb], v1[wb]); } }
    }
    f.row_end(rc, row, pn, fq, sub);
}

struct FUp {
    static constexpr int NKIND = 1; static constexpr bool USE_SS = true, PERM = true; const float* ss; bf16* h; LAS float* rsl;
    struct Row { float rs; };
    DI void row_begin(Row& rc, int row, int, int lr) const { rc.rs = lr >= 0 ? rsl[lr] : rsqrtf(ss_row(ss, row) * (1.f / D) + EPS); }
    template <int> DI void apply(const Row& rc, int row, int pn, int c, f32x4 v0, f32x4 v1) const {
        f32x4 o;
#pragma unroll
        for (int e = 0; e < 4; ++e) { const float g = v0[e] * rc.rs, u = v1[e] * rc.rs; o[e] = g * sigmoidf_(g) * u; }
        st4bf(h + (size_t)row * FF + pn * 128 + c, o);
    }
    template <int> DI void apply8(const Row& rc, int row, int pn, int c, f32x4 g0, f32x4 g1, f32x4 u0, f32x4 u1) const {
        f32x4 o0, o1;
#pragma unroll
        for (int e = 0; e < 4; ++e) { const float ga = g0[e] * rc.rs, gb = g1[e] * rc.rs; o0[e] = ga * sigmoidf_(ga) * (u0[e] * rc.rs); o1[e] = gb * sigmoidf_(gb) * (u1[e] * rc.rs); }
        st8bf(h + (size_t)row * FF + pn * 128 + c, o0, o1);
    }
    DI void row_end(const Row&, int, int, int, int) const {}
};
struct FUpCheap {
    static constexpr int NKIND = 1; static constexpr bool USE_SS = false, PERM = false; bf16* h;
    struct Row { float rs; };
    DI void row_begin(Row&, int, int, int) const {}
    template <int> DI void apply(const Row&, int row, int pn, int c, f32x4 v0, f32x4 v1) const { st4bf(h + (size_t)row * FF + pn * 128 + c, v0 + v1); }
    DI void row_end(const Row&, int, int, int, int) const {}
};
struct FRes {
    static constexpr int NKIND = 1; static constexpr bool USE_SS = false, PERM = true; bf16* xb; float* ssn; float alpha;
    struct Row { float a; };
    DI void row_begin(Row& rc, int, int, int) const { rc.a = 0.f; }
    template <int> DI void apply(Row& rc, int row, int pn, int c, f32x4 v0, f32x4 v1) const {
#pragma unroll
        for (int bj = 0; bj < 2; ++bj) {
            bf16* p = xb + (size_t)row * D + pn * 256 + bj * 128 + c; const f32x4 x = ld4bf(p); const f32x4 v = bj ? v1 : v0;
            u32x2 w; w.x = pk2(x[0] + alpha * v[0], x[1] + alpha * v[1]); w.y = pk2(x[2] + alpha * v[2], x[3] + alpha * v[3]); *(u32x2*)p = w;
            const f32x4 r = unpk4(w); rc.a += (r[0] * r[0] + r[1] * r[1]) + (r[2] * r[2] + r[3] * r[3]);
        }
    }
    template <int> DI void apply8(Row& rc, int row, int pn, int c, f32x4 a0, f32x4 a1, f32x4 b0, f32x4 b1) const {
#pragma unroll
        for (int bj = 0; bj < 2; ++bj) {
            bf16* p = xb + (size_t)row * D + pn * 256 + bj * 128 + c; const u32x4 xw = *(const u32x4*)p; const f32x4 x0 = unpk4((u32x2){xw.x, xw.y}), x1 = unpk4((u32x2){xw.z, xw.w});
            const f32x4 v0 = bj ? b0 : a0, v1 = bj ? b1 : a1;
            u32x4 w; w.x = pk2(x0[0] + alpha * v0[0], x0[1] + alpha * v0[1]); w.y = pk2(x0[2] + alpha * v0[2], x0[3] + alpha * v0[3]); w.z = pk2(x1[0] + alpha * v1[0], x1[1] + alpha * v1[1]); w.w = pk2(x1[2] + alpha * v1[2], x1[3] + alpha * v1[3]);
            *(u32x4*)p = w; const f32x4 r0 = unpk4((u32x2){w.x, w.y}), r1 = unpk4((u32x2){w.z, w.w});
            rc.a += ((r0[0] * r0[0] + r0[1] * r0[1]) + (r0[2] * r0[2] + r0[3] * r0[3])) + ((r1[0] * r1[0] + r1[1] * r1[1]) + (r1[2] * r1[2] + r1[3] * r1[3]));
        }
    }
    DI void row_end(const Row& rc, int row, int pn, int fq, int sub) const { float s = rc.a; s += __shfl_xor(s, 16); s += __shfl_xor(s, 32); if (fq == 0) ssn[(size_t)row * 16 + pn * 4 + sub] = s; }
};
struct FScale {
    static constexpr int NKIND = 1; static constexpr bool USE_SS = true, PERM = true; const float* ss; bf16* o; float sc; LAS float* rsl;
    struct Row { float rs; };
    DI void row_begin(Row& rc, int row, int, int lr) const { rc.rs = (lr >= 0 ? rsl[lr] : rsqrtf(ss_row(ss, row) * (1.f / D) + EPS)) * sc; }
    template <int> DI void apply(const Row& rc, int row, int pn, int c, f32x4 v0, f32x4 v1) const {
        st4bf(o + (size_t)row * D + pn * 256 + c, v0 * rc.rs); st4bf(o + (size_t)row * D + pn * 256 + 128 + c, v1 * rc.rs);
    }
    template <int> DI void apply8(const Row& rc, int row, int pn, int c, f32x4 a0, f32x4 a1, f32x4 b0, f32x4 b1) const { st8bf(o + (size_t)row * D + pn * 256 + c, a0 * rc.rs, a1 * rc.rs); st8bf(o + (size_t)row * D + pn * 256 + 128 + c, b0 * rc.rs, b1 * rc.rs); }
    DI void row_end(const Row&, int, int, int, int) const {}
};
struct FPV {
    static constexpr int NKIND = 1; static constexpr bool USE_SS = false, PERM = true; const float* linv; bf16* o;
    struct Row { float s; };
    DI void row_begin(Row& rc, int row, int pn, int) const { rc.s = linv[(size_t)row * 4 + pn]; }
    template <int> DI void apply(const Row& rc, int row, int pn, int c, f32x4 v0, f32x4 v1) const {
        st4bf(o + (size_t)row * D + pn * 256 + c, v0 * rc.s); st4bf(o + (size_t)row * D + pn * 256 + 128 + c, v1 * rc.s);
    }
    template <int> DI void apply8(const Row& rc, int row, int pn, int c, f32x4 a0, f32x4 a1, f32x4 b0, f32x4 b1) const { st8bf(o + (size_t)row * D + pn * 256 + c, a0 * rc.s, a1 * rc.s); st8bf(o + (size_t)row * D + pn * 256 + 128 + c, b0 * rc.s, b1 * rc.s); }
    DI void row_end(const Row&, int, int, int, int) const {}
};
struct FMemKV {
    static constexpr int NKIND = 2; static constexpr bool USE_SS = false, PERM = false; float* ok; float* ov; bf16* mkb; bf16* mvt;
    struct Row { int d; };
    DI int kind(int pn) const { return pn < 4 ? 0 : 1; }
    DI void row_begin(Row&, int, int, int) const {}
    template <int KIND> DI void apply(const Row&, int row, int pn, int c, f32x4 v0, f32x4 v1) const {
        if constexpr (KIND == 0) {
#pragma unroll
            for (int bj = 0; bj < 2; ++bj) { const int col = pn * 256 + bj * 128 + c; const f32x4 v = bj ? v1 : v0; *(f32x4*)(ok + (size_t)row * D + col) = v; st4bf(mkb + (size_t)row * D + col, v); }
        } else {
            const int h = pn - 4, b = row >> 8, mem = row & 255;
#pragma unroll
            for (int bj = 0; bj < 2; ++bj) { const int dd = bj * 128 + c; const f32x4 v = bj ? v1 : v0; *(f32x4*)(ov + (size_t)row * D + h * 256 + dd) = v;
#pragma unroll
                for (int e = 0; e < 4; ++e) mvt[((size_t)(b * 4 + h) * 256 + dd + e) * 256 + mem] = f2bf(v[e]); }
        }
    }
    DI void row_end(const Row&, int, int, int, int) const {}
};
struct FWin {
    static constexpr int NKIND = 5; static constexpr bool USE_SS = true, PERM = true; const float* ss; unsigned char* ws; float* out; int l; LAS float* rsl;
    struct Row { float rs; int pos, b, t; bool smp; };
    DI int kind(int pn) const { return pn == 0 ? 0 : pn <= 2 ? 1 : pn <= 4 ? 2 : pn == 5 ? 3 : 4; }
    DI void row_begin(Row& rc, int row, int, int lr) const {
        rc.rs = lr >= 0 ? rsl[lr] : rsqrtf(ss_row(ss, row) * (1.f / D) + EPS);
        if (row < MP) { rc.smp = false; rc.b = row >> 14; rc.pos = row & (S - 1); rc.t = 0; } else { const int sr = row - MP; rc.smp = true; rc.b = sr >> 4; rc.t = sr & 15; rc.pos = 1024 + rc.t; }
    }
    template <int KIND> DI void apply(const Row& rc, int row, int pn, int c, f32x4 v0, f32x4 v1) const {
        unsigned char* R = ws + WS_R; const f32x4 a0 = v0 * rc.rs, a1 = v1 * rc.rs;
        if constexpr (KIND == 0) { bf16* gb = (bf16*)(R + R_GB) + (size_t)row * 256 + c; st4bf(gb, a0); st4bf(gb + 128, a1); }
        else if constexpr (KIND == 1) {
            const int ch = (pn - 1) * 128 + c; const f32x4 p = a0 * a1; st4bf((bf16*)(R + R_CV) + (size_t)row * 256 + ch, p);
            if (!rc.smp) { if (rc.pos >= S - 2) *(f32x4*)(out + O_AP + (size_t)l * 1024 + (size_t)(rc.b * 2 + rc.pos - (S - 2)) * 256 + ch) = p; }
            else if (rc.t >= 14) *(f32x4*)(out + O_AS + (size_t)l * 8192 + (size_t)(rc.b * 2 + rc.t - 14) * 256 + ch) = p;
        } else if constexpr (KIND == 2 || KIND == 3) {
            const int blk = c >> 5, i = c & 31;
            if (KIND == 3 && blk >= 2) {
                const int kvh = blk - 2;
                if (!rc.smp) {
                    bf16* vT = (bf16*)(R + R_VT) + ((size_t)(rc.b * 2 + kvh) * 64 + i) * S + rc.pos;
#pragma unroll
                    for (int e = 0; e < 4; ++e) { vT[(size_t)e * S] = f2bf(a0[e]); vT[(size_t)(32 + e) * S] = f2bf(a1[e]); }
                    if (rc.pos >= S - 128) { float* o = out + O_VP + (size_t)l * 32768 + ((size_t)(rc.b * 128 + rc.pos - (S - 128)) * 2 + kvh) * 64 + i; *(f32x4*)o = a0; *(f32x4*)(o + 32) = a1; }
                } else {
                    bf16* p = (bf16*)(R + R_VS) + (size_t)(row - MP) * 128 + kvh * 64 + i; st4bf(p, a0); st4bf(p + 32, a1);
                    float* o = out + O_VS + (size_t)l * 32768 + ((size_t)(rc.b * 16 + rc.t) * 2 + kvh) * 64 + i; *(f32x4*)o = a0; *(f32x4*)(o + 32) = a1;
                }
            } else {
                const float* rcos = (const float*)(ws + WS_ROPE) + (size_t)rc.pos * 32 + i;
                const f32x4 cs = *(const f32x4*)rcos, sn = *(const f32x4*)(rcos + (size_t)S * 32);
                const f32x4 o1 = a0 * cs - a1 * sn, o2 = a1 * cs + a0 * sn;
                if constexpr (KIND == 2) { const int head = (pn - 3) * 4 + blk; const float QS = 0.125f * LOG2E; bf16* p = (bf16*)(R + R_Q) + (size_t)row * 512 + head * 64 + i; st4bf(p, o1 * QS); st4bf(p + 32, o2 * QS); }
                else {
                    bf16* p = (bf16*)(R + R_K) + (size_t)row * 128 + blk * 64 + i; st4bf(p, o1); st4bf(p + 32, o2);
                    if (!rc.smp) { if (rc.pos >= S - 128) { float* o = out + O_KP + (size_t)l * 32768 + ((size_t)(rc.b * 128 + rc.pos - (S - 128)) * 2 + blk) * 64 + i; *(f32x4*)o = o1; *(f32x4*)(o + 32) = o2; } }
                    else { float* o = out + O_KS + (size_t)l * 32768 + ((size_t)(rc.b * 16 + rc.t) * 2 + blk) * 64 + i; *(f32x4*)o = o1; *(f32x4*)(o + 32) = o2; }
                }
            }
        } else {
            const int ch = (pn - 6) * 128 + c; f32x4 g;
#pragma unroll
            for (int e = 0; e < 4; ++e) g[e] = a0[e] * sigmoidf_(a1[e]);
            st4bf((bf16*)(R + R_GLU) + (size_t)row * 256 + ch, g);
            if (!rc.smp) { if (rc.pos >= S - 30) *(f32x4*)(out + O_CP + (size_t)l * 15360 + (size_t)(rc.b * 30 + rc.pos - (S - 30)) * 256 + ch) = g; }
            else *(f32x4*)(out + O_CS + (size_t)l * 122880 + (size_t)(rc.b * 30 + 14 + rc.t) * 256 + ch) = g;
        }
    }
    template <int KIND> DI void apply8(const Row& rc, int row, int pn, int c, f32x4 v0a, f32x4 v0b, f32x4 v1a, f32x4 v1b) const {
        unsigned char* R = ws + WS_R; const f32x4 a0 = v0a * rc.rs, a1 = v0b * rc.rs, b0 = v1a * rc.rs, b1 = v1b * rc.rs;
        if constexpr (KIND == 0) { bf16* gb = (bf16*)(R + R_GB) + (size_t)row * 256 + c; st8bf(gb, a0, a1); st8bf(gb + 128, b0, b1); }
        else if constexpr (KIND == 1) {
            const int ch = (pn - 1) * 128 + c; const f32x4 p0 = a0 * b0, p1 = a1 * b1; st8bf((bf16*)(R + R_CV) + (size_t)row * 256 + ch, p0, p1);
            if (rc.pos >= S - 2) { float* o = out + O_AP + (size_t)l * 1024 + (size_t)(rc.b * 2 + rc.pos - (S - 2)) * 256 + ch; *(f32x4*)o = p0; *(f32x4*)(o + 4) = p1; }
        } else if constexpr (KIND == 2 || KIND == 3) {
            const int blk = c >> 5, i = c & 31;
            if (KIND == 3 && blk >= 2) { apply<3>(rc, row, pn, c, v0a, v1a); apply<3>(rc, row, pn, c + 4, v0b, v1b); }
            else {
                const float* rcos = (const float*)(ws + WS_ROPE) + (size_t)rc.pos * 32 + i; const float* rsin = rcos + (size_t)S * 32;
                const f32x4 c0 = *(const f32x4*)rcos, c1 = *(const f32x4*)(rcos + 4), s0 = *(const f32x4*)rsin, s1 = *(const f32x4*)(rsin + 4);
                const f32x4 o1a = a0 * c0 - b0 * s0, o1b = a1 * c1 - b1 * s1, o2a = b0 * c0 + a0 * s0, o2b = b1 * c1 + a1 * s1;
                if constexpr (KIND == 2) { const int head = (pn - 3) * 4 + blk; const float QS = 0.125f * LOG2E; bf16* p = (bf16*)(R + R_Q) + (size_t)row * 512 + head * 64 + i; st8bf(p, o1a * QS, o1b * QS); st8bf(p + 32, o2a * QS, o2b * QS); }
                else {
                    bf16* p = (bf16*)(R + R_K) + (size_t)row * 128 + blk * 64 + i; st8bf(p, o1a, o1b); st8bf(p + 32, o2a, o2b);
                    if (rc.pos >= S - 128) { float* o = out + O_KP + (size_t)l * 32768 + ((size_t)(rc.b * 128 + rc.pos - (S - 128)) * 2 + blk) * 64 + i; *(f32x4*)o = o1a; *(f32x4*)(o + 4) = o1b; *(f32x4*)(o + 32) = o2a; *(f32x4*)(o + 36) = o2b; }
                }
            }
        } else {
            const int ch = (pn - 6) * 128 + c; f32x4 g0, g1;
#pragma unroll
            for (int e = 0; e < 4; ++e) { g0[e] = a0[e] * sigmoidf_(b0[e]); g1[e] = a1[e] * sigmoidf_(b1[e]); }
            st8bf((bf16*)(R + R_GLU) + (size_t)row * 256 + ch, g0, g1);
            if (rc.pos >= S - 30) { float* o = out + O_CP + (size_t)l * 15360 + (size_t)(rc.b * 30 + rc.pos - (S - 30)) * 256 + ch; *(f32x4*)o = g0; *(f32x4*)(o + 4) = g1; }
        }
    }
    DI void row_end(const Row&, int, int, int, int) const {}
};
struct EpiS {
    static constexpr bool PERM = true, AFTER_DRAIN = false;
    bf16* P; float* linv; LAS float* sc;
    DI void operator()(const f32x4 (&acc)[2][2][4][2], const Unit& u, int wr, int wc, int fr, int fq) const {
        LAS float* Pm = sc; LAS float* Ps = sc + 1024;
#pragma unroll
        for (int ai = 0; ai < 2; ++ai)
#pragma unroll
            for (int m = 0; m < 4; ++m) {
                float mx = -3.0e38f;
#pragma unroll
                for (int bj = 0; bj < 2; ++bj)
#pragma unroll
                    for (int n = 0; n < 2; ++n) { const f32x4 x = acc[ai][bj][m][n]; mx = fmaxf(mx, fmaxf(fmaxf(x[0], x[1]), fmaxf(x[2], x[3]))); }
                mx = fmaxf(mx, __shfl_xor(mx, 16)); mx = fmaxf(mx, __shfl_xor(mx, 32));
                if (fq == 0) Pm[(ai * 128 + wr * 64 + m * 16 + fr) * 4 + wc] = mx;
            }
        EPI_BAR();
#pragma unroll
        for (int ai = 0; ai < 2; ++ai)
#pragma unroll
            for (int m = 0; m < 4; ++m) {
                const int r = ai * 128 + wr * 64 + m * 16 + fr; const f32x4 m4 = *(LAS f32x4*)(Pm + r * 4);
                const float mx = fmaxf(fmaxf(m4[0], m4[1]), fmaxf(m4[2], m4[3])); float sum = 0.f;
                bf16* prow = P + (size_t)(u.pm * 256 + r) * D + u.pn * 256 + wc * 32 + fq * 8;
#pragma unroll
                for (int bj = 0; bj < 2; ++bj) {
                    const f32x4 x = acc[ai][bj][m][0], y = acc[ai][bj][m][1]; u32x4 w;
                    w.x = pk2(__builtin_amdgcn_exp2f(x[0] - mx), __builtin_amdgcn_exp2f(x[1] - mx)); w.y = pk2(__builtin_amdgcn_exp2f(x[2] - mx), __builtin_amdgcn_exp2f(x[3] - mx));
                    w.z = pk2(__builtin_amdgcn_exp2f(y[0] - mx), __builtin_amdgcn_exp2f(y[1] - mx)); w.w = pk2(__builtin_amdgcn_exp2f(y[2] - mx), __builtin_amdgcn_exp2f(y[3] - mx));
                    *(u32x4*)(prow + bj * 128) = w; const f32x4 p0 = unpk4((u32x2){w.x, w.y}), p1 = unpk4((u32x2){w.z, w.w}); sum += ((p0[0] + p0[1]) + (p0[2] + p0[3])) + ((p1[0] + p1[1]) + (p1[2] + p1[3]));
                }
                sum += __shfl_xor(sum, 16); sum += __shfl_xor(sum, 32);
                if (fq == 0) Ps[r * 4 + wc] = sum;
            }
        EPI_BAR();
        const int tid = (wr * 4 + wc) * 64 + fq * 16 + fr;
        if (tid < 256) { const f32x4 s4 = *(LAS f32x4*)(Ps + tid * 4); linv[(size_t)(u.pm * 256 + tid) * 4 + u.pn] = 1.f / ((s4[0] + s4[1]) + (s4[2] + s4[3])); }
    }
};

template <int K, class F> DI void sample_gemm(int wv, LAS unsigned char* lds, const bf16* A, int lda, const bf16* Bt, int ldb, int nN, const F& f, int G, int c0) {
    unsigned z_ = 0u; asm volatile("" : "+v"(z_)); const int tid_ = wv * 64 + (int)__builtin_amdgcn_mbcnt_hi(~0u, __builtin_amdgcn_mbcnt_lo(~0u, z_)); const int tid = tid_, w = __builtin_amdgcn_readfirstlane(tid >> 6), lane = tid & 63, fr = lane & 15, fq = lane >> 4;
    LAS float* red = (LAS float*)lds;
    constexpr int kw = K / 8, NKS = kw / 32, KB = 4;
    const int n_mu = 16 * nN * 4;
    for (int mu = c0; mu < n_mu; mu += G) {
        const int rb = mu & 15, t = mu >> 4, pn = t >> 2, s = t & 3, row0 = MP + rb * 16;
        f32x4 acc[4];
#pragma unroll
        for (int j = 0; j < 4; ++j) acc[j] = (f32x4){0.f, 0.f, 0.f, 0.f};
        const bf16* ap = A + (size_t)(row0 + fr) * lda + w * kw + fq * 8;
        const bf16* bp = Bt + (size_t)(pn * 256 + s * 32 + fr) * ldb + w * kw + fq * 8;
#pragma unroll
        for (int k0 = 0; k0 < NKS; k0 += KB) {
            bf16x8 a[KB], b[KB][4];
#pragma unroll
            for (int kk = 0; kk < KB; ++kk) if (k0 + kk < NKS) {
                a[kk] = *(const bf16x8*)(ap + (k0 + kk) * 32);
#pragma unroll
                for (int j = 0; j < 4; ++j) b[kk][j] = *(const bf16x8*)(bp + (size_t)((j >> 1) * 128 + (j & 1) * 16) * ldb + (k0 + kk) * 32);
            }
#pragma unroll
            for (int kk = 0; kk < KB; ++kk) if (k0 + kk < NKS) {
#pragma unroll
                for (int j = 0; j < 4; ++j) acc[j] = __builtin_amdgcn_mfma_f32_16x16x32_bf16(b[kk][j], a[kk], acc[j], 0, 0, 0);
            }
        }
#pragma unroll
        for (int j = 0; j < 4; ++j) *(LAS f32x4*)(red + ((w * 4 + j) * 64 + lane) * 4) = acc[j];
        __syncthreads();
        if (w == 0) {
            f32x4 v0[2], v1[2];
#pragma unroll
            for (int wb = 0; wb < 2; ++wb) { v0[wb] = (f32x4){0.f, 0.f, 0.f, 0.f}; v1[wb] = v0[wb];
#pragma unroll
                for (int ww = 0; ww < 8; ++ww) { v0[wb] += *(LAS f32x4*)(red + ((ww * 4 + wb) * 64 + lane) * 4); v1[wb] += *(LAS f32x4*)(red + ((ww * 4 + wb + 2) * 64 + lane) * 4); } }
            apply_two(f, row0 + fr, pn, s * 32 + fq * 4, v0, v1, fq, s);
        }
        __syncthreads();
    }
}

template <class F> DI void sample_gemm_wide(int wv, LAS unsigned char* lds, const bf16* A, const bf16* Bt, int nN, const F& f, int G, int c0) {
    unsigned z_ = 0u; asm volatile("" : "+v"(z_)); const int lane = (int)__builtin_amdgcn_mbcnt_hi(~0u, __builtin_amdgcn_mbcnt_lo(~0u, z_)), fr = lane & 15, fq = lane >> 4, w = wv;
    constexpr int K = D;
    LAS float* red = (LAS float*)lds;
    const int n_mu = 4 * nN * 4;
    for (int mu = c0; mu < n_mu; mu += G) {
        const int rg = mu & 3, t = mu >> 2, pn = t >> 2, s = t & 3, row0 = MP + rg * 64;
        f32x4 acc[4][4];
#pragma unroll
        for (int rb = 0; rb < 4; ++rb)
#pragma unroll
            for (int j = 0; j < 4; ++j) acc[rb][j] = (f32x4){0.f, 0.f, 0.f, 0.f};
        const bf16* ap = A + (size_t)(row0 + fr) * K + w * 128 + fq * 8;
        const bf16* bp = Bt + (size_t)(pn * 256 + s * 32 + fr) * K + w * 128 + fq * 8;
        bf16x8 a[4][4], b[4][4];
#pragma unroll
        for (int kk = 0; kk < 4; ++kk)
#pragma unroll
            for (int x = 0; x < 4; ++x) { a[kk][x] = *(const bf16x8*)(ap + (size_t)x * 16 * K + kk * 32); b[kk][x] = *(const bf16x8*)(bp + (size_t)((x >> 1) * 128 + (x & 1) * 16) * K + kk * 32); }
#pragma unroll
        for (int kk = 0; kk < 4; ++kk)
#pragma unroll
            for (int rb = 0; rb < 4; ++rb)
#pragma unroll
                for (int j = 0; j < 4; ++j) acc[rb][j] = __builtin_amdgcn_mfma_f32_16x16x32_bf16(b[kk][j], a[kk][rb], acc[rb][j], 0, 0, 0);
#pragma unroll
        for (int rb = 0; rb < 4; ++rb)
#pragma unroll
            for (int j = 0; j < 4; ++j) *(LAS f32x4*)(red + ((w * 16 + rb * 4 + j) * 64 + lane) * 4) = acc[rb][j];
        __syncthreads();
        {
            const int rb = w >> 1, wb = w & 1; f32x4 v0 = (f32x4){0.f, 0.f, 0.f, 0.f}, v1 = v0;
#pragma unroll
            for (int ww = 0; ww < 8; ++ww) { v0 += *(LAS f32x4*)(red + ((ww * 16 + rb * 4 + wb) * 64 + lane) * 4); v1 += *(LAS f32x4*)(red + ((ww * 16 + rb * 4 + wb + 2) * 64 + lane) * 4); }
            const int row = row0 + rb * 16 + fr, c = s * 32 + wb * 16 + fq * 4; typename F::Row rc; f.row_begin(rc, row, pn, -1);
            if constexpr (F::NKIND == 1) f.template apply<0>(rc, row, pn, c, v0, v1);
            else { const int kd = f.kind(pn);
                if (kd == 0) f.template apply<0>(rc, row, pn, c, v0, v1); else if (kd == 1) f.template apply<1>(rc, row, pn, c, v0, v1);
                else if constexpr (F::NKIND > 2) { if (kd == 2) f.template apply<2>(rc, row, pn, c, v0, v1); else if (kd == 3) f.template apply<3>(rc, row, pn, c, v0, v1); else f.template apply<4>(rc, row, pn, c, v0, v1); } }
        }
        __syncthreads();
    }
}

DI void tr_item(const float* W, int N, int sc0, const float* gain, bf16* WT, int K, int n0, int k0, LAS float* scr, int lane) {
#pragma unroll
    for (int i = 0; i < 8; ++i) { const int kk = 8 * i + (lane >> 3), n4 = (lane & 7) * 4; const float g = gain ? gain[k0 + kk] : 1.f; const f32x4 v = *(const f32x4*)(W + (size_t)(k0 + kk) * N + sc0 + n4);
        LAS float* d = scr + kk * 33 + n4; d[0] = v[0] * g; d[1] = v[1] * g; d[2] = v[2] * g; d[3] = v[3] * g; }
    LDS_WAIT();
    const int c = lane & 7;
#pragma unroll
    for (int j = 0; j < 4; ++j) { const int n = (lane >> 3) + 8 * j; const LAS float* s = scr + (8 * c) * 33 + n;
        u32x4 o; o.x = pk2(s[0 * 33], s[1 * 33]); o.y = pk2(s[2 * 33], s[3 * 33]); o.z = pk2(s[4 * 33], s[5 * 33]); o.w = pk2(s[6 * 33], s[7 * 33]);
        *(u32x4*)(WT + (size_t)(n0 + n) * K + k0 + 8 * c) = o; }
    LDS_WAIT();
}
DI int map_win(int n0) {
    const int t = n0 >> 8, r = n0 & 255, hb = r >> 7, rr = r & 127;
    switch (t) {
        case 0: return r;
        case 1: case 2: return (hb ? 512 : 256) + (t - 1) * 128 + rr;
        case 3: case 4: return 768 + ((t - 3) * 4 + (rr >> 5)) * 64 + hb * 32 + (rr & 31);
        case 5: { const int blk = rr >> 5; return (blk < 2 ? 1280 + blk * 64 : 1408 + (blk - 2) * 64) + hb * 32 + (rr & 31); }
        default: return (hb ? 1792 : 1536) + (t - 6) * 128 + rr;
    }
}
DI void sincos_d(double a, float& sn, float& cs) {
    const double k = rint(a * 0.6366197723675814); double r = fma(-k, 1.5707963267948966, a); r = fma(-k, 6.123233995736766e-17, r); const double r2 = r * r;
    const double s = r * (1.0 + r2 * (-1.0 / 6 + r2 * (1.0 / 120 + r2 * (-1.0 / 5040 + r2 * (1.0 / 362880 + r2 * (-1.0 / 39916800 + r2 * (1.0 / 6227020800.0)))))));
    const double c = 1.0 + r2 * (-0.5 + r2 * (1.0 / 24 + r2 * (-1.0 / 720 + r2 * (1.0 / 40320 + r2 * (-1.0 / 3628800 + r2 * (1.0 / 479001600 + r2 * (-1.0 / 87178291200.0)))))));
    const int q = (int)((long long)k & 3);
    sn = (float)(q == 0 ? s : q == 1 ? c : q == 2 ? -s : -c); cs = (float)(q == 0 ? c : q == 1 ? -s : q == 2 ? -c : s);
}
DI void prologue(int wv, unsigned char* ws, float* out, LAS unsigned char* lds) {
    unsigned z_ = 0u; asm volatile("" : "+v"(z_)); const int tid_ = wv * 64 + (int)__builtin_amdgcn_mbcnt_hi(~0u, __builtin_amdgcn_mbcnt_lo(~0u, z_)); const int tid = tid_, w = __builtin_amdgcn_readfirstlane(tid >> 6), lane = tid & 63, G = gridDim.x;
    const int gw = blockIdx.x * 8 + w, NGW = G * 8; const int gt = blockIdx.x * NTHR + tid, NGT = G * NTHR;
    { float* rc = (float*)(ws + WS_ROPE); float* rs = rc + (size_t)S * 32;
      for (int i = gt; i < S * 32; i += NGT) { const int pos = i >> 5, j = i & 31; double inv = 1.0; for (int q = 0; q < j; ++q) inv *= 0.74989420933245587; float sn, cs; sincos_d((double)pos * inv, sn, cs); rc[i] = cs; rs[i] = sn; } }
    { bf16* xb = (bf16*)(ws + WS_XB); float* ss0 = (float*)(ws + WS_SS); bf16* mn = (bf16*)(ws + WS_MN);
      for (int m = gw; m < MT + 512; m += NGW) {
          const float* src = m < MP ? IN(I_XP) + (size_t)m * D : m < MT ? IN(I_XS) + (size_t)(m - MP) * D : IN(I_MEM) + (size_t)(m - MT) * D;
          f32x4 v[4]; float s = 0.f;
#pragma unroll
          for (int j = 0; j < 4; ++j) { v[j] = *((const f32x4*)src + lane + 64 * j); }
          if (m < MT) {
              bf16* o = xb + (size_t)m * D;
#pragma unroll
              for (int j = 0; j < 4; ++j) { u32x2 wv; wv.x = pk2(v[j][0], v[j][1]); wv.y = pk2(v[j][2], v[j][3]); *((u32x2*)o + lane + 64 * j) = wv; const f32x4 r = unpk4(wv); s += (r[0] * r[0] + r[1] * r[1]) + (r[2] * r[2] + r[3] * r[3]); }
              s = wave_sum(s); if (lane < 16) ss0[(size_t)m * 16 + lane] = lane == 0 ? s : 0.f;
          } else {
#pragma unroll
              for (int j = 0; j < 4; ++j) s += (v[j][0] * v[j][0] + v[j][1] * v[j][1]) + (v[j][2] * v[j][2] + v[j][3] * v[j][3]);
              const float rstd = rsqrtf(wave_sum(s) * (1.f / D) + EPS); bf16* o = mn + (size_t)(m - MT) * D;
#pragma unroll
              for (int j = 0; j < 4; ++j) st4bf(o + 4 * (lane + 64 * j), v[j] * rstd);
          }
      } }
    { LAS float* scr = (LAS float*)(lds + w * 16384);
      constexpr int I1 = 16 * 176, ID = 44 * 32, IIN = 16 * 64, ISQ = 16 * 32, IKV = 16 * 64, IL = 2 * I1 + 2 * ID + IIN + 3 * ISQ + IKV;
      for (int it = gw; it < NL * IL; it += NGW) {
          const int l = it / IL; int r = it % IL; unsigned char* wl = ws + WS_W + (size_t)l * LW;
          if (r < 2 * I1) { const int second = r >= I1; if (second) r -= I1; const int nb = r % 176, kb = r / 176, n0 = nb * 32, pn = n0 >> 8, rr = n0 & 255;
              const float* W = (second ? (rr >= 128 ? IN(I_F2U) : IN(I_F2G)) : (rr >= 128 ? IN(I_F1U) : IN(I_F1G))) + (size_t)l * D * FF;
              tr_item(W, FF, pn * 128 + (rr & 127), (second ? IN(I_F2N) : IN(I_F1N)) + l * D, (bf16*)(wl + (second ? W_2 : W_1)), D, n0, kb * 64, scr, lane); continue; }
          r -= 2 * I1;
          if (r < 2 * ID) { const int second = r >= ID; if (second) r -= ID; const int nb = r % 32, kb = r / 32;
              tr_item((second ? IN(I_F2D) : IN(I_F1D)) + (size_t)l * FF * D, D, nb * 32, nullptr, (bf16*)(wl + (second ? W_D2 : W_D1)), FF, nb * 32, kb * 64, scr, lane); continue; }
          r -= 2 * ID;
          if (r < IIN) { const int nb = r % 64, kb = r / 64; tr_item(IN(I_WIN) + (size_t)l * D * 2048, 2048, map_win(nb * 32), IN(I_MIXN) + l * D, (bf16*)(wl + W_IN), D, nb * 32, kb * 64, scr, lane); continue; }
          r -= IIN;
          if (r < 3 * ISQ) { const int which = r / ISQ; r -= which * ISQ; const int nb = r % 32, kb = r / 32;
              const float* W = (which == 0 ? IN(I_WOUT) : which == 1 ? IN(I_WQ) : IN(I_WO)) + (size_t)l * D * D; const float* g = which == 0 ? IN(I_MON) + l * D : which == 1 ? IN(I_XAN) + l * D : nullptr;
              tr_item(W, D, nb * 32, g, (bf16*)(wl + (which == 0 ? W_OUT : which == 1 ? W_Q : W_O)), D, nb * 32, kb * 64, scr, lane); continue; }
          r -= 3 * ISQ;
          { const int nb = r % 64, kb = r / 64, n0 = nb * 32; tr_item((n0 < 1024 ? IN(I_WK) : IN(I_WV)) + (size_t)l * D * D, D, n0 & 1023, IN(I_MEMN) + l * D, (bf16*)(wl + W_KV), D, n0, kb * 64, scr, lane); }
      } }
}

DI f32x16 mfma32(bf16x8 a, bf16x8 b, f32x16 c) { return __builtin_amdgcn_mfma_f32_32x32x16_bf16(a, b, c, 0, 0, 0); }
constexpr int MX_KSZ = 192 * 144, MX_VOFF = 2 * MX_KSZ, MX_VP = 392, MX_SSB = MX_VOFF + 128 * MX_VP, MX_WC = MX_SSB + 2048, MX_END = MX_WC + 48 * 256 * 4;
static_assert(MX_END <= LDS_TAB, "mixer LDS");

template <int TW, class LA, class LC, class LCP, class LG> DI void conv_tokens(int l, LAS unsigned char* lds, int lane, LA ldA, LC ldC, LCP ldCp, LG ldG, bf16* ymix_row0  ) {
    const int ch = 4 * lane;
    const float* caw = IN(I_CAW) + (size_t)l * 3 * 256 + ch; const f32x4 wa0 = *(const f32x4*)caw, wa1 = *(const f32x4*)(caw + 256), wa2 = *(const f32x4*)(caw + 512);
    const LAS float* wc = (const LAS float*)(lds + MX_WC) + ch;
    f32x4 accA[TW], accC[TW];
    const f32x4 bias = *(const f32x4*)(IN(I_CCB) + l * 256 + ch);
#pragma unroll
    for (int t = 0; t < TW; ++t) { accA[t] = (f32x4){0.f, 0.f, 0.f, 0.f}; accC[t] = bias; }
#pragma unroll
    for (int i = 0; i < TW + 2; ++i) { const f32x4 x = ldA(i);
#pragma unroll
        for (int t = 0; t < TW; ++t) { const int j = i - t; if (j == 0) accA[t] += wa0 * x; else if (j == 1) accA[t] += wa1 * x; else if (j == 2) accA[t] += wa2 * x; } }
    constexpr int NWIN = TW + 30;
    {
#pragma unroll 1
        for (int ib = 0; ib < NWIN; ib += 16) {
            f32x4 x[16];
#pragma unroll
            for (int ii = 0; ii < 16; ++ii) x[ii] = ldC(ib + ii);
#pragma unroll
            for (int ii = 0; ii < 16; ++ii)
#pragma unroll
                for (int t = 0; t < TW; ++t) accC[t] += *(const LAS f32x4*)(wc + (ib + ii - t + 8) * 256) * x[ii];
        }
    }
    const f32x4 lng = *(const f32x4*)(IN(I_LNG) + l * 256 + ch), lnb = *(const f32x4*)(IN(I_LNB) + l * 256 + ch);
#pragma unroll
    for (int t = 0; t < TW; ++t) {
        const f32x4 ya = ldG(t) * accA[t];
        const float ssa = wave_sum((ya[0] * ya[0] + ya[1] * ya[1]) + (ya[2] * ya[2] + ya[3] * ya[3]));
        st4bf(ymix_row0 + (size_t)t * D + ch, ya * rsqrtf(ssa * (1.f / 256) + EPS));
        const f32x4 cc = accC[t];
        const float mean = wave_sum((cc[0] + cc[1]) + (cc[2] + cc[3])) * (1.f / 256); const f32x4 dc = cc - mean;
        const float var = wave_sum((dc[0] * dc[0] + dc[1] * dc[1]) + (dc[2] * dc[2] + dc[3] * dc[3])) * (1.f / 256);
        const f32x4 ln = dc * rsqrtf(var + EPS) * lng + lnb; f32x4 yc;
#pragma unroll
        for (int e = 0; e < 4; ++e) yc[e] = ln[e] * sigmoidf_(ln[e]);
        const float ssc = wave_sum((yc[0] * yc[0] + yc[1] * yc[1]) + (yc[2] * yc[2] + yc[3] * yc[3]));
        st4bf(ymix_row0 + (size_t)t * D + 768 + ch, yc * rsqrtf(ssc * (1.f / 256) + EPS));
    }
}

template <bool SMP> DI void attn_qb(const LAS unsigned char* Kl, const LAS unsigned char* Vl, const bf16* qp, float sink2, int kb0, f32x16 (&o)[2]) {
    bf16x8 qf[4];
#pragma unroll
    for (int ks = 0; ks < 4; ++ks) qf[ks] = *(const bf16x8*)(qp + ks * 16);
    f32x16 s[6];
#pragma unroll
    for (int kb = 0; kb < 6; ++kb)
#pragma unroll
        for (int i = 0; i < 16; ++i) s[kb][i] = 0.f;
#pragma unroll
    for (int ks = 0; ks < 4; ++ks)
#pragma unroll
        for (int kb = 0; kb < 6; ++kb) { const bf16x8 a = *(const LAS bf16x8*)(Kl + kb * 32 * 144 + ks * 32); s[kb] = mfma32(a, qf[ks], s[kb]); }
#pragma unroll
    for (int kb = 0; kb < 6; ++kb) { if (SMP ? kb == 5 : kb < kb0) {
#pragma unroll
            for (int i = 0; i < 16; ++i) s[kb][i] = -3.0e38f; }
        if (SMP && kb == 4) {
#pragma unroll
            for (int i = 8; i < 16; ++i) s[kb][i] = -3.0e38f; } }
    float m4[4] = {sink2, sink2, sink2, sink2};
#pragma unroll
    for (int kb = 0; kb < 6; ++kb)
#pragma unroll
        for (int i = 0; i < 16; ++i) m4[i & 3] = fmaxf(m4[i & 3], s[kb][i]);
    float mx = fmaxf(fmaxf(m4[0], m4[1]), fmaxf(m4[2], m4[3]));
    mx = fmaxf(mx, __shfl_xor(mx, 32));
    float s4[4] = {0.f, 0.f, 0.f, 0.f};
#pragma unroll
    for (int kb = 0; kb < 6; ++kb)
#pragma unroll
        for (int i = 0; i < 16; ++i) { s[kb][i] = __builtin_amdgcn_exp2f(s[kb][i] - mx); s4[i & 3] += s[kb][i]; }
    float sum = (s4[0] + s4[1]) + (s4[2] + s4[3]);
    sum += __shfl_xor(sum, 32);
    const float inv = __builtin_amdgcn_rcpf(sum + __builtin_amdgcn_exp2f(sink2 - mx));
    f32x16 o2[2][2];
#pragma unroll
    for (int hb = 0; hb < 2; ++hb)
#pragma unroll
        for (int t = 0; t < 2; ++t)
#pragma unroll
            for (int i = 0; i < 16; ++i) o2[hb][t][i] = 0.f;
#pragma unroll
    for (int kb = 0; kb < 6; ++kb)
#pragma unroll
        for (int t = 0; t < 2; ++t) {
            u32x4 pw; pw.x = pk2(s[kb][8 * t] * inv, s[kb][8 * t + 1] * inv); pw.y = pk2(s[kb][8 * t + 2] * inv, s[kb][8 * t + 3] * inv);
            pw.z = pk2(s[kb][8 * t + 4] * inv, s[kb][8 * t + 5] * inv); pw.w = pk2(s[kb][8 * t + 6] * inv, s[kb][8 * t + 7] * inv);
            const bf16x8 pf = __builtin_bit_cast(bf16x8, pw);
#pragma unroll
            for (int hb = 0; hb < 2; ++hb) {
                const LAS unsigned char* vp = Vl + hb * 32 * MX_VP + (kb * 32 + t * 16) * 2;
                const u32x2 lo = *(const LAS u32x2*)vp, hi = *(const LAS u32x2*)(vp + 16);
                const bf16x8 vf = __builtin_bit_cast(bf16x8, (u32x4){lo.x, lo.y, hi.x, hi.y});
                o2[hb][t] = mfma32(vf, pf, o2[hb][t]);
            }
        }
#pragma unroll
    for (int hb = 0; hb < 2; ++hb) o[hb] = o2[hb][0] + o2[hb][1];
}

DI void mixer_phase(int wv, unsigned char* ws, float* out, int l, LAS unsigned char* lds, int G, int bx) {
    unsigned z_ = 0u; asm volatile("" : "+v"(z_)); const int tid_ = wv * 64 + (int)__builtin_amdgcn_mbcnt_hi(~0u, __builtin_amdgcn_mbcnt_lo(~0u, z_)); const int tid = tid_, w = __builtin_amdgcn_readfirstlane(tid >> 6), lane = tid & 63, r = lane & 31, hf = lane >> 5;
    unsigned char* R = ws + WS_R;
    const bf16* gb = (const bf16*)(R + R_GB); const bf16* cv = (const bf16*)(R + R_CV); const bf16* qb_ = (const bf16*)(R + R_Q); const bf16* kb_ = (const bf16*)(R + R_K);
    const bf16* vT = (const bf16*)(R + R_VT); const bf16* vS = (const bf16*)(R + R_VS); const bf16* glu = (const bf16*)(R + R_GLU); bf16* ymix = (bf16*)(R + R_YMIX);
    { const float* src = IN(I_CCW) + (size_t)l * 31 * 256; LAS float* dst = (LAS float*)(lds + MX_WC);
#pragma unroll
      for (int it = 0; it < 6; ++it) { const int i4 = tid + it * NTHR, j = (i4 >> 6) - 8; const bool ok = j >= 0 && j <= 30; const f32x4 v = *(const f32x4*)(src + (ok ? j : 0) * 256 + (i4 & 63) * 4);
          *(LAS f32x4*)(dst + i4 * 4) = ok ? v : (f32x4){0.f, 0.f, 0.f, 0.f}; } }
    const float sink2 = IN(I_SINK)[l * 8 + w] * LOG2E;
    LAS float* ssb = (LAS float*)(lds + MX_SSB);
    __syncthreads();
#ifndef PROBE
#define PROBE 0
#endif
    for (int rep_ = 0; rep_ < (PROBE == 12 ? 2 : 1); ++rep_)
    for (int u = bx; u < NB * 256; u += G) {
        const int b = u >> 8, n = u & 255; const size_t row0 = (size_t)b * S + n * 64;
        u32x4 kreg[6], vreg[6];
#pragma unroll
        for (int it = 0; it < 6; ++it) {
            const int p = tid + it * NTHR, key = p >> 4, part = p & 15, pos = n * 64 - 128 + key;
            kreg[it] = *(const u32x4*)(kb_ + ((size_t)b * S + (pos >= 0 ? pos : 0)) * 128 + part * 8);
            const int rr = p / 24, pc = p % 24, pos0 = n * 64 - 128 + pc * 8;
            vreg[it] = *(const u32x4*)(vT + ((size_t)(b * 128 + rr)) * S + (pos0 >= 0 ? pos0 : 0));
        }
        const int t0 = w * 8, p0 = n * 64 + t0; const size_t brow = (size_t)b * S;
        auto ldP = [&](const bf16* base, int p) -> u32x2 { const u32x2 v = *(const u32x2*)(base + (brow + (p >= 0 ? p : 0)) * 256 + 4 * lane); return p >= 0 ? v : (u32x2){0u, 0u}; };
        u32x2 wa_[10], wg_[8], w0_[8], nw_[8];
#pragma unroll
        for (int i = 0; i < 10; ++i) wa_[i] = ldP(cv, p0 - 2 + i);
#pragma unroll
        for (int i = 0; i < 8; ++i) { wg_[i] = ldP(gb, p0 + i); w0_[i] = ldP(glu, p0 - 30 + i); nw_[i] = ldP(glu, p0 - 22 + i); }
#pragma unroll
        for (int it = 0; it < 6; ++it) {
            const int p = tid + it * NTHR, key = p >> 4, part = p & 15, pos = n * 64 - 128 + key;
            *(LAS u32x4*)(lds + (part >> 3) * MX_KSZ + key * 144 + (part & 7) * 16) = pos >= 0 ? kreg[it] : (u32x4){0u, 0u, 0u, 0u};
            const int rr = p / 24, pc = p % 24, pos0 = n * 64 - 128 + pc * 8; const u32x4 v = pos0 >= 0 ? vreg[it] : (u32x4){0u, 0u, 0u, 0u};
            LAS u32x2* d = (LAS u32x2*)(lds + MX_VOFF + rr * MX_VP + pc * 16); d[0] = (u32x2){v.x, v.y}; d[1] = (u32x2){v.z, v.w};
        }
        {
            const int ch = 4 * lane;
            const float* caw = IN(I_CAW) + (size_t)l * 3 * 256 + ch; const f32x4 wa0 = *(const f32x4*)caw, wa1 = *(const f32x4*)(caw + 256), wa2 = *(const f32x4*)(caw + 512);
            const LAS float* wc = (const LAS float*)(lds + MX_WC) + ch;
            const f32x4 bias = *(const f32x4*)(IN(I_CCB) + l * 256 + ch);
            const f32x4 lng = *(const f32x4*)(IN(I_LNG) + l * 256 + ch), lnb = *(const f32x4*)(IN(I_LNB) + l * 256 + ch);
            f32x4 accC[8], Rg[8];
#pragma unroll
            for (int t = 0; t < 8; ++t) { accC[t] = bias; Rg[t] = unpk4(w0_[t]); }
#pragma unroll 1
            for (int jb = 0; jb < 32; jb += 8) {
                u32x2 nx[8];
#pragma unroll
                for (int s = 0; s < 8; ++s) { const int i = jb + 16 + s; nx[s] = (i < 38) ? ldP(glu, p0 - 30 + i) : (u32x2){0u, 0u}; }
#pragma unroll
                for (int s = 0; s < 8; ++s) { const f32x4 wt = *(const LAS f32x4*)(wc + (jb + s + 8) * 256);
#pragma unroll
                    for (int t = 0; t < 8; ++t) accC[t] += wt * Rg[(t + s) & 7];
                    Rg[s] = unpk4(nw_[s]); }
#pragma unroll
                for (int s = 0; s < 8; ++s) nw_[s] = nx[s];
            }
            bf16* yrow = ymix + (brow + p0) * D;
#pragma unroll
            for (int t = 0; t < 8; ++t) {
                const f32x4 ya = unpk4(wg_[t]) * (wa0 * unpk4(wa_[t]) + wa1 * unpk4(wa_[t + 1]) + wa2 * unpk4(wa_[t + 2]));
                const float ssa = wave_sum((ya[0] * ya[0] + ya[1] * ya[1]) + (ya[2] * ya[2] + ya[3] * ya[3]));
                st4bf(yrow + (size_t)t * D + ch, ya * rsqrtf(ssa * (1.f / 256) + EPS));
                const f32x4 cc = accC[t];
                const float mean = wave_sum((cc[0] + cc[1]) + (cc[2] + cc[3])) * (1.f / 256); const f32x4 dc = cc - mean;
                const float var = wave_sum((dc[0] * dc[0] + dc[1] * dc[1]) + (dc[2] * dc[2] + dc[3] * dc[3])) * (1.f / 256);
                const f32x4 ln = dc * rsqrtf(var + EPS) * lng + lnb; f32x4 yc;
#pragma unroll
                for (int e = 0; e < 4; ++e) yc[e] = ln[e] * sigmoidf_(ln[e]);
                const float ssc = wave_sum((yc[0] * yc[0] + yc[1] * yc[1]) + (yc[2] * yc[2] + yc[3] * yc[3]));
                st4bf(yrow + (size_t)t * D + 768 + ch, yc * rsqrtf(ssc * (1.f / 256) + EPS));
            }
        }
        __syncthreads();
        const int kvh = w >> 2, kb0 = n >= 2 ? 0 : (2 - n) * 2;
        const LAS unsigned char* Kl = lds + kvh * MX_KSZ + r * 144 + hf * 16; const LAS unsigned char* Vl = lds + MX_VOFF + (kvh * 64 + r) * MX_VP + hf * 8;
#pragma unroll 1
        for (int qb = 0; qb < (PROBE == 17 ? 4 : 2); ++qb) {
            f32x16 o[2]; attn_qb<false>(Kl, Vl, qb_ + (row0 + (qb & 1) * 32 + r) * 512 + w * 64 + hf * 8, sink2, kb0, o);
            float sq = 0.f;
#pragma unroll
            for (int hb = 0; hb < 2; ++hb)
#pragma unroll
                for (int i = 0; i < 16; ++i) sq += o[hb][i] * o[hb][i];
            sq += __shfl_xor(sq, 32);
            if (hf == 0) ssb[((qb & 1) * 8 + w) * 32 + r] = sq;
            __syncthreads();
            float tot = 0.f;
#pragma unroll
            for (int hh = 0; hh < 8; ++hh) tot += ssb[((qb & 1) * 8 + hh) * 32 + r];
            const float rs = rsqrtf(tot * (1.f / 512) + EPS); bf16* yp = ymix + (row0 + (qb & 1) * 32 + r) * D + 256 + w * 64 + 4 * hf;
#pragma unroll
            for (int hb = 0; hb < 2; ++hb)
#pragma unroll
                for (int g = 0; g < 4; ++g) st4bf(yp + hb * 32 + 8 * g, (f32x4){o[hb][4 * g] * rs, o[hb][4 * g + 1] * rs, o[hb][4 * g + 2] * rs, o[hb][4 * g + 3] * rs});
        }
        __syncthreads();
    }
    for (int rep_ = 0; rep_ < ((PROBE == 13 || PROBE == 14) ? 2 : 1); ++rep_)
    for (int sb = bx - (G - 32); sb >= 0 && sb < 16; sb += G) {
        const size_t srow0 = (size_t)MP + sb * 16;
        const int t0 = w * 2; const float* sa = IN(I_SA) + ((size_t)(l * 16 + sb) * 2) * 256; const float* sc = IN(I_SC) + ((size_t)(l * 16 + sb) * 30) * 256;
        auto ldA = [&](int i) -> f32x4 { const int p = t0 - 2 + i; return p >= 0 ? ld4bf(cv + (srow0 + p) * 256 + 4 * lane) : *(const f32x4*)(sa + (2 + p) * 256 + 4 * lane); };
        auto ldC = [&](int i) -> f32x4 { const int p = t0 - 30 + i; return p >= 0 ? ld4bf(glu + (srow0 + p) * 256 + 4 * lane) : *(const f32x4*)(sc + (30 + p) * 256 + 4 * lane); };
        auto ldG = [&](int t) -> f32x4 { return ld4bf(gb + (srow0 + t0 + t) * 256 + 4 * lane); };
        conv_tokens<2>(l, lds, lane, ldA, ldC, ldC, ldG, ymix + (srow0 + t0) * D);
        float* oc = out + O_CS + ((size_t)(l * 16 + sb) * 30) * 256;
        for (int i = tid; i < 14 * 256; i += NTHR) oc[i] = sc[16 * 256 + i];
    }
    __syncthreads();
    for (int rep_ = 0; rep_ < ((PROBE == 13 || PROBE == 15) ? 2 : 1); ++rep_)
    for (int sb = bx - (G - 16); sb >= 0 && sb < 16; sb += G) {
        const size_t srow0 = (size_t)MP + sb * 16;
        const float* ck = IN(I_CK) + ((size_t)(l * 16 + sb) * 128) * 128; const float* cvv = IN(I_CV) + ((size_t)(l * 16 + sb) * 128) * 128;
        f32x4 kr_[8], vr_[8];
#pragma unroll
        for (int it = 0; it < 8; ++it) { const int i = tid + it * NTHR; kr_[it] = *(const f32x4*)(ck + (size_t)i * 4); vr_[it] = *(const f32x4*)(cvv + (size_t)i * 4); }
        u32x4 kn_ = (u32x4){0u, 0u, 0u, 0u}, vn_ = kn_;
        if (tid < 256) { kn_ = *(const u32x4*)(kb_ + (srow0 + (tid >> 4)) * 128 + (tid & 15) * 8); vn_ = *(const u32x4*)(vS + ((size_t)sb * 16 + (tid >> 4)) * 128 + (tid & 15) * 8); }
        for (int i = tid; i < 128 * 12; i += NTHR) { const int rr = i / 12, pc = i % 12; *(LAS u32x2*)(lds + MX_VOFF + rr * MX_VP + 288 + pc * 8) = (u32x2){0u, 0u}; }
#pragma unroll
        for (int it = 0; it < 8; ++it) {
            const int i = tid + it * NTHR, key = i >> 5, c = (i & 31) * 4;
            *(LAS u32x2*)(lds + (c >> 6) * MX_KSZ + key * 144 + (c & 63) * 2) = (u32x2){pk2(kr_[it][0], kr_[it][1]), pk2(kr_[it][2], kr_[it][3])};
#pragma unroll
            for (int e = 0; e < 4; ++e) *(LAS bf16*)(lds + MX_VOFF + (c + e) * MX_VP + key * 2) = f2bf(vr_[it][e]);
        }
        if (tid < 256) {
            const int key = 128 + (tid >> 4), part = tid & 15;
            *(LAS u32x4*)(lds + (part >> 3) * MX_KSZ + key * 144 + (part & 7) * 16) = kn_;
            const unsigned vw[4] = {vn_.x, vn_.y, vn_.z, vn_.w};
#pragma unroll
            for (int e = 0; e < 8; ++e) *(LAS bf16*)(lds + MX_VOFF + (part * 8 + e) * MX_VP + key * 2) = (bf16)((vw[e >> 1] >> ((e & 1) * 16)) & 0xffffu);
        }
        __syncthreads();
        {
            const int kvh = w >> 2, tq = r & 15;
            const LAS unsigned char* Kl = lds + kvh * MX_KSZ + r * 144 + hf * 16; const LAS unsigned char* Vl = lds + MX_VOFF + (kvh * 64 + r) * MX_VP + hf * 8;
            f32x16 o[2]; attn_qb<true>(Kl, Vl, qb_ + (srow0 + tq) * 512 + w * 64 + hf * 8, sink2, 0, o);
            float sq = 0.f;
#pragma unroll
            for (int hb = 0; hb < 2; ++hb)
#pragma unroll
                for (int i = 0; i < 16; ++i) sq += o[hb][i] * o[hb][i];
            sq += __shfl_xor(sq, 32);
            if (hf == 0) ssb[w * 32 + r] = sq;
            __syncthreads();
            float tot = 0.f;
#pragma unroll
            for (int hh = 0; hh < 8; ++hh) tot += ssb[hh * 32 + r];
            const float rs = rsqrtf(tot * (1.f / 512) + EPS); bf16* yp = ymix + (srow0 + tq) * D + 256 + w * 64 + 4 * hf;
            if (r < 16) {
#pragma unroll
                for (int hb = 0; hb < 2; ++hb)
#pragma unroll
                    for (int g = 0; g < 4; ++g) st4bf(yp + hb * 32 + 8 * g, (f32x4){o[hb][4 * g] * rs, o[hb][4 * g + 1] * rs, o[hb][4 * g + 2] * rs, o[hb][4 * g + 3] * rs});
            }
        }
        __syncthreads();
    }
}

DI void xattn_sample(int wv, unsigned char* ws, float* out, int l, LAS unsigned char* lds, int G, int bx) {
    unsigned z_ = 0u; asm volatile("" : "+v"(z_)); const int tid_ = wv * 64 + (int)__builtin_amdgcn_mbcnt_hi(~0u, __builtin_amdgcn_mbcnt_lo(~0u, z_)); const int tid = tid_, w = __builtin_amdgcn_readfirstlane(tid >> 6), lane = tid & 63, fr = lane & 15, fq = lane >> 4;
    bf16* qx = (bf16*)(ws + WS_R + R_QX);
    LAS float* PS = (LAS float*)lds;
    LAS float* RM = (LAS float*)(lds + 16 * 260 * 4);
    for (int u = bx - (G - 64); u >= 0 && u < 64; u += G) {
        const int sb = u >> 2, h = u & 3; const size_t srow0 = (size_t)MP + sb * 16;
        const float* mk = IN(I_MK) + (((size_t)(l * 16 + sb) * 256) * 4 + h) * 256; const float* mv = IN(I_MV) + (((size_t)(l * 16 + sb) * 256) * 4 + h) * 256;
        f32x4 acc[2] = {(f32x4){0.f, 0.f, 0.f, 0.f}, (f32x4){0.f, 0.f, 0.f, 0.f}};
        const bf16* qp = qx + (srow0 + fr) * D + h * 256 + fq * 8;
#pragma unroll
        for (int ks = 0; ks < 8; ++ks) {
            const bf16x8 qf = *(const bf16x8*)(qp + ks * 32);
#pragma unroll
            for (int kbk = 0; kbk < 2; ++kbk) {
                const float* kp = mk + (size_t)(w * 32 + kbk * 16 + fr) * 1024 + ks * 32 + fq * 8; const f32x4 k0 = *(const f32x4*)kp, k1 = *(const f32x4*)(kp + 4);
                u32x4 kw; kw.x = pk2(k0[0], k0[1]); kw.y = pk2(k0[2], k0[3]); kw.z = pk2(k1[0], k1[1]); kw.w = pk2(k1[2], k1[3]);
                acc[kbk] = __builtin_amdgcn_mfma_f32_16x16x32_bf16(__builtin_bit_cast(bf16x8, kw), qf, acc[kbk], 0, 0, 0);
            }
        }
#pragma unroll
        for (int kbk = 0; kbk < 2; ++kbk)
#pragma unroll
            for (int i = 0; i < 4; ++i) PS[fr * 260 + w * 32 + kbk * 16 + 4 * fq + i] = acc[kbk][i];
        __syncthreads();
#pragma unroll
        for (int tt = 0; tt < 2; ++tt) { LAS float* sp = PS + (2 * w + tt) * 260; const f32x4 x = *(LAS f32x4*)(sp + 4 * lane);
            const float mx = wave_max(fmaxf(fmaxf(x[0], x[1]), fmaxf(x[2], x[3])));
            f32x4 e; for (int i = 0; i < 4; ++i) e[i] = __builtin_amdgcn_exp2f(x[i] - mx);
            const float inv = 1.f / wave_sum((e[0] + e[1]) + (e[2] + e[3]));
            for (int i = 0; i < 4; ++i) e[i] = bf2f(f2bf(e[i] * inv));
            *(LAS f32x4*)(sp + 4 * lane) = e; }
        __syncthreads();
        {
            f32x4 acc[16];
#pragma unroll
            for (int t = 0; t < 16; ++t) acc[t] = (f32x4){0.f, 0.f, 0.f, 0.f};
#pragma unroll 1
            for (int jb = 0; jb < 32; jb += 8) {
                f32x4 vv[8];
#pragma unroll
                for (int jj = 0; jj < 8; ++jj) vv[jj] = *(const f32x4*)(mv + (size_t)(w + 8 * (jb + jj)) * 1024 + 4 * lane);
#pragma unroll
                for (int jj = 0; jj < 8; ++jj) { const int key = w + 8 * (jb + jj);
#pragma unroll
                    for (int t = 0; t < 16; ++t) acc[t] += PS[t * 260 + key] * vv[jj]; }
            }
            LAS float* OP = (LAS float*)(lds + 32768);
#pragma unroll
            for (int half = 0; half < 2; ++half) {
#pragma unroll
                for (int tt = 0; tt < 8; ++tt) *(LAS f32x4*)(OP + (w * 8 + tt) * 256 + 4 * lane) = acc[half * 8 + tt];
                __syncthreads();
                f32x4 sum = (f32x4){0.f, 0.f, 0.f, 0.f};
#pragma unroll
                for (int ww = 0; ww < 8; ++ww) sum += *(LAS f32x4*)(OP + (ww * 8 + w) * 256 + 4 * lane);
                st4bf(qx + (srow0 + half * 8 + w) * D + h * 256 + 4 * lane, sum);
                __syncthreads();
            }
        }
    }
    (void)RM;
}

DI void final_norm(int wv, unsigned char* ws, float* out, LAS unsigned char* lds) {
    unsigned z_ = 0u; asm volatile("" : "+v"(z_)); const int tid_ = wv * 64 + (int)__builtin_amdgcn_mbcnt_hi(~0u, __builtin_amdgcn_mbcnt_lo(~0u, z_)); const int tid = tid_, w = __builtin_amdgcn_readfirstlane(tid >> 6), lane = tid & 63, gw = blockIdx.x * 8 + w, NGW = gridDim.x * 8;
    const bf16* xb = (const bf16*)(ws + WS_XB); const float* ss = (const float*)(ws + WS_SS) + (size_t)8 * MT * 16; const float* g = IN(I_FIN);
    f32x4 gv[4];
#pragma unroll
    for (int j = 0; j < 4; ++j) gv[j] = *((const f32x4*)g + lane + 64 * j);
    for (int m = gw; m < MT; m += NGW) {
        const float rs = rsqrtf(ss_row(ss, m) * (1.f / D) + EPS); float* o = out + (m < MP ? O_YP + (size_t)m * D : O_YS + (size_t)(m - MP) * D);
#pragma unroll
        for (int j = 0; j < 4; ++j) { const f32x4 x = ld4bf(xb + (size_t)m * D + 4 * (lane + 64 * j)); *((f32x4*)o + lane + 64 * j) = x * rs * gv[j]; }
    }
}

#ifndef EN
#define EN 0xFFFFF
#endif
#ifndef ONE_LAUNCH
#define ONE_LAUNCH 1
#endif
constexpr int N_PHASES = 24;

template <int NM, int NN, size_t A_M, size_t A_N, size_t B_B, size_t B_N, int BSHIFT, class F>
DI void run_gemm(int wv, LAS unsigned char* lds, int G, int bx, const bf16* A_, int lda, const bf16* Bt, int ldb, int K, const F& f) {
    pg8::Gemm g{A_, Bt, lda, ldb, K, wv}; pg8::Sched<NM, NN, A_M, A_N, B_B, B_N, BSHIFT> Sc; Sc.G = G; Sc.c = bx;
    EpiA<F> E{f};
    pg8::gemm_phase<EpiA<F>, pg8::Sched<NM, NN, A_M, A_N, B_B, B_N, BSHIFT>, true, true>(lds, g, Sc, E);
}
template <int K, int N, class F> DI void prompt_gemm(int wv, LAS unsigned char* lds, int G, int bx, const bf16* A_, const bf16* Bt, const F& f) {
    run_gemm<MP / 256, N / 256, (size_t)256 * K * 2, 0, 0, (size_t)256 * K * 2, 31>(wv, lds, G, bx, A_, K, Bt, K, K, f);
}


#define XB_TMO      128
#define XB_XCNT(j)  (256  + 64 * (j))
#define XB_XSUB(j)  (1280 + 64 * (j))
#define XB_XGEN(j)  (2304 + 64 * (j))
#define XB_TOP      3328
#define XB_TOPGEN   3392
#define XCD_BAR_WORDS 3456
#define XB_SPIN_CAP (1u << 18)
DI unsigned xb_ld(unsigned* p)              { return __hip_atomic_load(p, __ATOMIC_RELAXED, __HIP_MEMORY_SCOPE_AGENT); }
DI unsigned xb_add(unsigned* p, unsigned v) { return __hip_atomic_fetch_add(p, v, __ATOMIC_RELAXED, __HIP_MEMORY_SCOPE_AGENT); }
DI unsigned xb_xcc_id() { return (unsigned)__builtin_amdgcn_s_getreg((3 << 11) | 20) & 0xFu; }
#define XB_SPIN(cond, bar) do { unsigned _sp = 0; while (cond) { __builtin_amdgcn_s_sleep(1); \
    if ((++_sp & 255u) == 0u) { if (xb_ld(&(bar)[XB_TMO])) break; if (_sp > XB_SPIN_CAP) { atomicAdd(&(bar)[XB_TMO], 1u); break; } } } } while (0)
DI void xcd_barrier_complete(unsigned* bar, unsigned x, unsigned G, unsigned& nloc, unsigned& nx) {
    unsigned sum, cnt, mine, sp = 0u;
    for (;;) {
        sum = 0u; cnt = 0u; mine = 0u;
#pragma unroll
        for (unsigned j = 0; j < 16; ++j) { const unsigned c = xb_ld(&bar[XB_XCNT(j)]); sum += c; cnt += (c > 0u) ? 1u : 0u; mine = (j == x) ? c : mine; }
        if (sum == G) break;
        __builtin_amdgcn_s_sleep(1);
        if ((++sp & 255u) == 0u) { if (xb_ld(&bar[XB_TMO])) break; if (sp > XB_SPIN_CAP) { atomicAdd(&bar[XB_TMO], 1u); break; } }
    }
    nloc = mine > 0u ? mine : 1u; nx = cnt > 0u ? cnt : 1u;
}
DI void xcd_barrier(unsigned* bar, volatile LAS unsigned* st, bool first_thread, unsigned G) {
    asm volatile("s_waitcnt vmcnt(0)" ::: "memory");
    __syncthreads();
    if (first_thread) {
        const unsigned x = xb_xcc_id();
        __builtin_amdgcn_s_waitcnt(0);
        unsigned nloc = st[0], nx = st[1];
        if (nloc == 0u) { xcd_barrier_complete(bar, x, G, nloc, nx); st[0] = nloc; st[1] = nx; }
        const unsigned old = xb_add(&bar[XB_XSUB(x)], 1u);
        const unsigned gen = old / nloc;
        if (old + 1u == (gen + 1u) * nloc) {
            __builtin_amdgcn_fence(__ATOMIC_RELEASE, "agent");
            asm volatile("s_waitcnt vmcnt(0)" ::: "memory");
            const unsigned og = xb_add(&bar[XB_TOP], 1u);
            const unsigned tg = og / nx;
            if (og + 1u == (tg + 1u) * nx) xb_add(&bar[XB_TOPGEN], 1u);
            else XB_SPIN(xb_ld(&bar[XB_TOPGEN]) == tg, bar);
            __builtin_amdgcn_fence(__ATOMIC_ACQUIRE, "agent");
            xb_add(&bar[XB_XGEN(x)], 1u);
            asm volatile("s_waitcnt vmcnt(0)" ::: "memory");
        } else {
            XB_SPIN(xb_ld(&bar[XB_XGEN(x)]) == gen, bar);
            __builtin_amdgcn_fence(__ATOMIC_ACQUIRE, "agent");
            asm volatile("s_waitcnt vmcnt(0)" ::: "memory");
        }
    }
    __syncthreads();
}

__global__ void __launch_bounds__(NTHR, 2) fwd_kernel(Args A) {
    extern __shared__ __attribute__((aligned(16))) unsigned char lds_raw[];
    LAS unsigned char* lds = (LAS unsigned char*)lds_raw;
    const int lo = A.ph_lo, hi = A.ph_hi; const int wv = __builtin_amdgcn_readfirstlane((int)threadIdx.x >> 6);
    unsigned char* ws = A.ws; float* out = A.out;
    if (threadIdx.x == 0) { LAS unsigned long long* T = (LAS unsigned long long*)(lds + LDS_TAB);
        T[0] = (unsigned long long)A.in[0];
        T[1] = (unsigned long long)A.in[1];
        T[2] = (unsigned long long)A.in[2];
        T[3] = (unsigned long long)A.in[3];
        T[4] = (unsigned long long)A.in[4];
        T[5] = (unsigned long long)A.in[5];
        T[6] = (unsigned long long)A.in[6];
        T[7] = (unsigned long long)A.in[7];
        T[8] = (unsigned long long)A.in[8];
        T[9] = (unsigned long long)A.in[9];
        T[10] = (unsigned long long)A.in[10];
        T[11] = (unsigned long long)A.in[11];
        T[12] = (unsigned long long)A.in[12];
        T[13] = (unsigned long long)A.in[13];
        T[14] = (unsigned long long)A.in[14];
        T[15] = (unsigned long long)A.in[15];
        T[16] = (unsigned long long)A.in[16];
        T[17] = (unsigned long long)A.in[17];
        T[18] = (unsigned long long)A.in[18];
        T[19] = (unsigned long long)A.in[19];
        T[20] = (unsigned long long)A.in[20];
        T[21] = (unsigned long long)A.in[21];
        T[22] = (unsigned long long)A.in[22];
        T[23] = (unsigned long long)A.in[23];
        T[24] = (unsigned long long)A.in[24];
        T[25] = (unsigned long long)A.in[25];
        T[26] = (unsigned long long)A.in[26];
        T[27] = (unsigned long long)A.in[27];
        T[28] = (unsigned long long)A.in[28];
        T[29] = (unsigned long long)A.in[29];
        T[30] = (unsigned long long)A.in[30];
        T[31] = (unsigned long long)A.in[31];
        T[32] = (unsigned long long)A.in[32];
        T[33] = (unsigned long long)A.in[33];
        *(LAS unsigned*)(lds + LDS_TAB + 384) = 0u; *(LAS unsigned*)(lds + LDS_TAB + 388) = 0u;
        { const unsigned xcc_ = xb_xcc_id(); *(LAS unsigned*)(lds + LDS_TAB + 396) = xcc_; *(LAS unsigned*)(lds + LDS_TAB + 392) = xb_add(&((unsigned*)ws)[XB_XCNT(xcc_)], 1u); }
    }
    __syncthreads();
#ifndef CG_ALL
#define CG_ALL 0
#endif
#define SYNC(ph) do { if ((ph) + 1 < hi) { if (CG_ALL || (ph) == 0) cg::this_grid().sync(); else for (int rb_ = 0; rb_ < (PROBE == 16 ? 2 : 1); ++rb_) { unsigned z2_ = 0u; asm volatile("" : "+v"(z2_)); const bool ft_ = wv == 0 && __builtin_amdgcn_mbcnt_hi(~0u, __builtin_amdgcn_mbcnt_lo(~0u, z2_)) == 0u; xcd_barrier((unsigned*)ws, (volatile LAS unsigned*)(lds + LDS_TAB + 384), ft_, gridDim.x); } } } while (0)
    if (lo == 0) { if (EN & 0x10000) prologue(wv, ws, out, lds); __syncthreads();
#if PROBE == 3
        prologue(wv, ws, out, lds); __syncthreads();
#endif
        SYNC(0); }
    if (wv == 0 && __builtin_amdgcn_mbcnt_hi(~0u, __builtin_amdgcn_mbcnt_lo(~0u, 0u)) == 0u) {
        bool ok = (gridDim.x & 7u) == 0u;
#pragma unroll
        for (unsigned j = 0; j < 16; ++j) { const unsigned c = xb_ld(&((unsigned*)ws)[XB_XCNT(j)]); ok = ok && (c == (j < 8u ? gridDim.x / 8u : 0u)); }
        const unsigned rank = *(LAS unsigned*)(lds + LDS_TAB + 392), xcc = *(LAS unsigned*)(lds + LDS_TAB + 396);
        *(LAS unsigned*)(lds + LDS_TAB + 400) = ok ? rank * 8u + xcc : (unsigned)blockIdx.x;
    }
    __syncthreads();
    const int vcu = __builtin_amdgcn_readfirstlane(*(LAS int*)(lds + LDS_TAB + 400));
    for (int ph = (lo > 1 ? lo : 1); ph < (hi < N_PHASES - 1 ? hi : N_PHASES - 1); ++ph) {
        int G = gridDim.x, bx = vcu; asm volatile("" : "+s"(G), "+s"(bx), "+s"(out));
        const int smp_c0 = (bx + G / 2) % G;
        const int l = (ph - 1) / 11, k = (ph - 1) % 11;
        asm volatile("" : "+s"(ws));
        unsigned char* R = ws + WS_R; bf16* xb = (bf16*)(ws + WS_XB); float* ss = (float*)(ws + WS_SS); bf16* hb = (bf16*)(R + R_H);
        unsigned char* wl = ws + WS_W + (size_t)l * LW;
        float* ssl = ss + (size_t)(4 * l) * MT * 16;
        if (!((EN >> k) & 1)) continue;
        switch (k) {
        case 0: case 9: {
            const bool second = k == 9;
            if (!second) {
                FMemKV f{out + O_MK + (size_t)l * 512 * D, out + O_MV + (size_t)l * 512 * D, (bf16*)(ws + WS_MKB) + (size_t)l * 512 * D, (bf16*)(ws + WS_MVT) + (size_t)l * 8 * 65536};
                run_gemm<2, 8, (size_t)256 * D * 2, 0, 0, (size_t)256 * D * 2, 31>(wv, lds, G, bx, (const bf16*)(ws + WS_MN), D, (const bf16*)(wl + W_KV), D, D, f);
                __syncthreads();
            }
            FUp f{ssl + (second ? 3 : 0) * (size_t)MT * 16, hb, (LAS float*)(lds + LDS_EPI)};
#if PROBE == 11
            { FUpCheap f0{hb}; prompt_gemm<D, 2 * FF>(wv, lds, G, bx, xb, (const bf16*)(wl + (second ? W_2 : W_1)), f0); __syncthreads(); }
#endif
            prompt_gemm<D, 2 * FF>(wv, lds, G, bx, xb, (const bf16*)(wl + (second ? W_2 : W_1)), f);
#if PROBE == 1
            __syncthreads(); prompt_gemm<D, 2 * FF>(wv, lds, G, bx, xb, (const bf16*)(wl + (second ? W_2 : W_1)), f);
#endif
            __syncthreads();
            sample_gemm_wide(wv, lds, xb, (const bf16*)(wl + (second ? W_2 : W_1)), 2 * FF / 256, f, G, smp_c0);
        } break;
        case 1: case 10: {
            const bool second = k == 10;
            FRes f{xb, ssl + (second ? 4 : 1) * (size_t)MT * 16, 0.5f};
#if PROBE == 4
            { FRes f0{xb, ssl + (second ? 4 : 1) * (size_t)MT * 16, 0.0f}; prompt_gemm<FF, D>(wv, lds, G, bx, hb, (const bf16*)(wl + (second ? W_D2 : W_D1)), f0); __syncthreads(); }
#endif
            prompt_gemm<FF, D>(wv, lds, G, bx, hb, (const bf16*)(wl + (second ? W_D2 : W_D1)), f);
            __syncthreads();
            sample_gemm<FF>(wv, lds, hb, FF, (const bf16*)(wl + (second ? W_D2 : W_D1)), FF, D / 256, f, G, smp_c0);
        } break;
        case 2: {
            FWin f{ssl + (size_t)MT * 16, ws, out, l, (LAS float*)(lds + LDS_EPI)};
            prompt_gemm<D, 2048>(wv, lds, G, bx, xb, (const bf16*)(wl + W_IN), f);
#if PROBE == 8
            __syncthreads(); prompt_gemm<D, 2048>(wv, lds, G, bx, xb, (const bf16*)(wl + W_IN), f);
#endif
            __syncthreads();
            sample_gemm_wide(wv, lds, xb, (const bf16*)(wl + W_IN), 8, f, G, smp_c0);
        } break;
        case 3: mixer_phase(wv, ws, out, l, lds, G, bx);
#if PROBE == 2
            __syncthreads(); mixer_phase(wv, ws, out, l, lds, G, bx);
#endif
            break;
        case 4: case 8: {
            const bool xo = k == 8;
            FRes f{xb, ssl + (xo ? 3 : 2) * (size_t)MT * 16, 1.0f};
            const bf16* Ain = xo ? (const bf16*)(R + R_QX) : (const bf16*)(R + R_YMIX);
            prompt_gemm<D, D>(wv, lds, G, bx, Ain, (const bf16*)(wl + (xo ? W_O : W_OUT)), f);
            __syncthreads();
            sample_gemm<D>(wv, lds, Ain, D, (const bf16*)(wl + (xo ? W_O : W_OUT)), D, 4, f, G, smp_c0);
        } break;
        case 5: {
            FScale f{ssl + 2 * (size_t)MT * 16, (bf16*)(R + R_QX), 0.0625f * LOG2E, (LAS float*)(lds + LDS_EPI)};
            prompt_gemm<D, D>(wv, lds, G, bx, xb, (const bf16*)(wl + W_Q), f);
#if PROBE == 5
            __syncthreads(); prompt_gemm<D, D>(wv, lds, G, bx, xb, (const bf16*)(wl + W_Q), f);
#endif
            __syncthreads();
            sample_gemm<D>(wv, lds, xb, D, (const bf16*)(wl + W_Q), D, 4, f, G, smp_c0);
#if PROBE == 10
            sample_gemm<D>(wv, lds, xb, D, (const bf16*)(wl + W_Q), D, 4, f, G, smp_c0);
#endif
        } break;
        case 6: {
            pg8::Gemm g{(const bf16*)(R + R_QX), (const bf16*)(ws + WS_MKB) + (size_t)l * 512 * D, D, D, 256, wv};
            typedef pg8::Sched<MP / 256, 4, (size_t)256 * D * 2, 512, (size_t)256 * D * 2, 512, 6> SchS; SchS Sc; Sc.G = G; Sc.c = bx;
            EpiS E{(bf16*)(R + R_P), (float*)(ws + WS_LINV), (LAS float*)(lds + LDS_EPI)};
            pg8::gemm_phase<EpiS, SchS, true, true>(lds, g, Sc, E);
#if PROBE == 9
            __syncthreads(); pg8::gemm_phase<EpiS, SchS, true, true>(lds, g, Sc, E);
#endif
            __syncthreads();
            xattn_sample(wv, ws, out, l, lds, G, bx);
            asm volatile("s_waitcnt vmcnt(0)" ::: "memory"); __syncthreads();
            FPV f{(const float*)(ws + WS_LINV), (bf16*)(R + R_QX)};
            run_gemm<MP / 256, 4, (size_t)256 * D * 2, 512, (size_t)4 * 65536 * 2, (size_t)65536 * 2, 6>(wv, lds, G, bx, (const bf16*)(ws + WS_R + R_P), D, (const bf16*)(ws + WS_MVT) + (size_t)l * 8 * 65536, 256, 256, f);
#if PROBE == 9
            __syncthreads();
            run_gemm<MP / 256, 4, (size_t)256 * D * 2, 512, (size_t)4 * 65536 * 2, (size_t)65536 * 2, 6>(wv, lds, G, bx, (const bf16*)(ws + WS_R + R_P), D, (const bf16*)(ws + WS_MVT) + (size_t)l * 8 * 65536, 256, 256, f);
#endif
        } break;
        case 7: break;
        }
        __syncthreads();
        if (k != 6) SYNC(ph);
    }
    if (hi == N_PHASES) { if (EN & 0x20000) final_norm(wv, ws, out, lds); }
#undef SYNC
}

extern "C" void kernel_launch(void* const* d_in, const int* in_sizes, int n_in, void* d_out, int out_size, void* d_ws, size_t ws_size, hipStream_t stream) {
    static int grid = 0;
    if (grid == 0) {
        if (n_in != 34 || (size_t)out_size != O_END || ws_size < WS_END) { fprintf(stderr, "kernel_launch: unexpected shapes n_in %d out %d ws %zu (need %zu)\n", n_in, out_size, ws_size, (size_t)WS_END); grid = -1; return; }
        int dev = 0, cus = 0, per_cu = 0;
        hipGetDevice(&dev); hipDeviceGetAttribute(&cus, hipDeviceAttributeMultiprocessorCount, dev);
        if (hipFuncSetAttribute((const void*)fwd_kernel, hipFuncAttributeMaxDynamicSharedMemorySize, LDS_BYTES) != hipSuccess) { fprintf(stderr, "kernel_launch: hipFuncSetAttribute failed\n"); grid = -1; return; }
        if (hipOccupancyMaxActiveBlocksPerMultiprocessor(&per_cu, (const void*)fwd_kernel, NTHR, LDS_BYTES) != hipSuccess || per_cu < 1) { fprintf(stderr, "kernel_launch: occupancy query says %d\n", per_cu); per_cu = 1; }
        (void)hipGetLastError();
        grid = cus;
    }
    if (grid < 0) return;
    Args a{};
    for (int i = 0; i < 34; ++i) a.in[i] = (const float*)d_in[i];
    a.out = (float*)d_out; a.ws = (unsigned char*)d_ws;
    if (hipMemsetAsync(d_ws, 0, 16384, stream) != hipSuccess) { fprintf(stderr, "kernel_launch: memset failed\n"); return; }
#if ONE_LAUNCH
    a.ph_lo = 0; a.ph_hi = N_PHASES;
    void* args[] = {&a};
    hipError_t e = hipLaunchCooperativeKernel((const void*)fwd_kernel, dim3(grid), dim3(NTHR), args, LDS_BYTES, stream);
    if (e != hipSuccess) fprintf(stderr, "cooperative launch failed: %s (grid %d)\n", hipGetErrorString(e), grid);
#else
    for (int ph = 0; ph < N_PHASES; ++ph) { a.ph_lo = ph; a.ph_hi = ph + 1; hipLaunchKernelGGL(fwd_kernel, dim3(grid), dim3(NTHR), LDS_BYTES, stream, a); }
#endif
}
```

```cpp
#include <hip/hip_runtime.h>
#include <hip/hip_cooperative_groups.h>
#include <cstdio>
#include <cstdint>
namespace cg = cooperative_groups;
#ifndef PROBE
#define PROBE 0
#endif
namespace pg8 {
#define PG8_LAS __attribute__((address_space(3)))
typedef unsigned short bf16_t;
typedef short bf16x8 __attribute__((ext_vector_type(8)));
typedef float f32x4 __attribute__((ext_vector_type(4)));
typedef unsigned u32x4 __attribute__((ext_vector_type(4)));
constexpr int BM = 256, BK = 64, HALF = 128, HTB = HALF * BK * 2  , STAGE_BYTES = 8 * HTB, NXCD = 8, WGM = 8;

__host__ __device__ __forceinline__ int lds_byte(int r, int c) { const int st = (r >> 4) * 2 + (c >> 5), rr = r & 15, cc = c & 31, ob = rr * 64 + cc * 2; return st * 1024 + (ob ^ (((ob >> 9) & 1) << 5)); }
__host__ __device__ __forceinline__ void stage_rc(int b, int& R, int& C) { const int st = b / 1024, sb = b % 1024, swz = sb ^ (((sb >> 9) & 1) << 5); R = (st >> 1) * 16 + swz / 64; C = (st & 1) * 32 + (swz % 64) / 2; }
__host__ __device__ __forceinline__ int perm32(int rho) { const int n = rho >> 4, i = rho & 15; return 8 * (i >> 2) + 4 * n + (i & 3); }


struct Unit { int pm, pn; size_t aoff, boff; int npm, par; };
struct Gemm { const bf16_t* A; const bf16_t* Bt; int lda, ldb, K, wv; };

template <int NM, int NN, size_t A_M, size_t A_N, size_t B_B, size_t B_N, int BSHIFT> struct Sched {
    int G, c;
    __device__ bool next(int i, Unit& u) const {
        constexpr int nwg = NM * NN;
        const long L = (long)i * G + c; if (L >= nwg) return false;
        int wgid = (int)L; { constexpr int q = nwg / NXCD, r = nwg % NXCD; const int xcd = wgid % NXCD, off = wgid / NXCD; wgid = (xcd < r ? xcd * (q + 1) : r * (q + 1) + (xcd - r) * q) + off; }
        constexpr int nig = WGM * NN; const int gid = wgid / nig, fm = gid * WGM, gsz = (NM - fm) < WGM ? (NM - fm) : WGM;
        u.pm = fm + ((wgid % nig) % gsz); u.pn = (wgid % nig) / gsz;
        u.aoff = (size_t)u.pm * A_M + (size_t)u.pn * A_N; u.boff = (size_t)(u.pm >> BSHIFT) * B_B + (size_t)u.pn * B_N; return true;
    }
    __device__ __forceinline__ void a_ready(const Unit&) const {}
    __device__ __forceinline__ void done(const Unit&) const {}
};
template <class Epi, class Sched, bool ALIGN_EPI = false, bool SP2 = false>
__device__ __forceinline__ void gemm_phase(PG8_LAS unsigned char* lds, const Gemm g, const Sched& S, const Epi& E) {
    unsigned z_ = 0u; asm volatile("" : "+v"(z_)); const int tid_ = g.wv * 64 + (int)__builtin_amdgcn_mbcnt_hi(~0u, __builtin_amdgcn_mbcnt_lo(~0u, z_)); const int tid = tid_, wid = __builtin_amdgcn_readfirstlane(tid >> 6), lane = tid & 63, wr = wid >> 2, wc = wid & 3, fr = lane & 15, fq = lane >> 4;
    const int K = g.K, nt = K / BK;
    unsigned voffA[2], voffB[2];
#pragma unroll
    for (int i = 0; i < 2; ++i) { int R, C; stage_rc(tid * 16 + i * 8192, R, C); const int Rb = Epi::PERM ? ((R & ~31) + perm32(R & 31)) : R;
        voffA[i] = (unsigned)(R * g.lda + C) * 2u; voffB[i] = (unsigned)(Rb * g.ldb + C) * 2u; }
    const size_t kstep = (size_t)(BK * 2);
    const size_t hstepA = (size_t)HALF * g.lda * 2, hstepB = (size_t)HALF * g.ldb * 2;
    const unsigned ldsw = (unsigned)wid * 1024u;
    const int aoff = lds_byte(wr * 64 + fr, fq * 8), boff = lds_byte(wc * 32 + fr, fq * 8);
#define PG8_SA(b, h) (((b) * 2 + (h)) * HTB)
#define PG8_SB(b, h) ((4 + (b) * 2 + (h)) * HTB)
#define PG8_STAGE(bufoff, gbase, voff) do { _Pragma("unroll") for (int _i = 0; _i < 2; ++_i) \
        __builtin_amdgcn_global_load_lds((const unsigned*)((const char*)(gbase) + (voff)[_i]), (PG8_LAS unsigned*)(lds + (bufoff) + ldsw + _i * 8192), 16, 0, 0); } while (0)
#define PG8_LDA(dst, b, h) do { _Pragma("unroll") for (int m = 0; m < 4; ++m) _Pragma("unroll") for (int k = 0; k < 2; ++k) dst[m][k] = *(const PG8_LAS bf16x8*)(lds + PG8_SA(b, h) + aoff + m * 2048 + k * 1024); } while (0)
#define PG8_LDB(dst, b, h) do { _Pragma("unroll") for (int n = 0; n < 2; ++n) _Pragma("unroll") for (int k = 0; k < 2; ++k) dst[n][k] = *(const PG8_LAS bf16x8*)(lds + PG8_SB(b, h) + boff + n * 2048 + k * 1024); } while (0)
#define PG8_MMA(ai, bj, At, Bt) do { __builtin_amdgcn_s_setprio(1); _Pragma("unroll") for (int m = 0; m < 4; ++m) _Pragma("unroll") for (int n = 0; n < 2; ++n) _Pragma("unroll") for (int k = 0; k < 2; ++k) \
        acc[ai][bj][m][n] = __builtin_amdgcn_mfma_f32_16x16x32_bf16(Bt[n][k], At[m][k], acc[ai][bj][m][n], 0, 0, 0); __builtin_amdgcn_s_setprio(0); } while (0)
#define PG8_WAIT_V(n) asm volatile("s_waitcnt vmcnt(" #n ")" ::: "memory")
#define PG8_WAIT_L(n) asm volatile("s_waitcnt lgkmcnt(" #n ")" ::: "memory")
#define PG8_BAR __builtin_amdgcn_s_barrier()
#define PG8_SCHED __builtin_amdgcn_sched_barrier(0)
    Unit cur, nxt; int ui = 0;
    if (!S.next(0, cur)) return;
    f32x4 acc[2][2][4][2];
#pragma unroll
    for (int a = 0; a < 2; ++a)
#pragma unroll
        for (int b = 0; b < 2; ++b)
#pragma unroll
            for (int m = 0; m < 4; ++m)
#pragma unroll
                for (int n = 0; n < 2; ++n) acc[a][b][m][n] = (f32x4){0.f, 0.f, 0.f, 0.f};
    bf16x8 At[4][2], B0[2][2], B1[2][2];
    const char* cA = (const char*)g.A + cur.aoff; const char* cB = (const char*)g.Bt + cur.boff;
    S.a_ready(cur);
    if constexpr (SP2) {
        PG8_STAGE(PG8_SB(0, 0), cB, voffB); PG8_STAGE(PG8_SB(0, 1), cB + hstepB, voffB); PG8_STAGE(PG8_SA(0, 0), cA, voffA); PG8_STAGE(PG8_SA(0, 1), cA + hstepA, voffA);
        if (wr == 1) PG8_BAR;
        PG8_WAIT_V(2); PG8_BAR;
        PG8_STAGE(PG8_SB(1, 0), cB + kstep, voffB); PG8_STAGE(PG8_SA(1, 0), cA + kstep, voffA); PG8_STAGE(PG8_SB(1, 1), cB + hstepB + kstep, voffB);
        PG8_WAIT_V(6); PG8_BAR;
    } else {
        PG8_STAGE(PG8_SB(0, 0), cB, voffB); PG8_STAGE(PG8_SA(0, 0), cA, voffA); PG8_STAGE(PG8_SB(0, 1), cB + hstepB, voffB); PG8_STAGE(PG8_SA(0, 1), cA + hstepA, voffA);
        if (wr == 1) PG8_BAR;
        PG8_WAIT_V(4); PG8_BAR;
        PG8_STAGE(PG8_SB(1, 0), cB + kstep, voffB); PG8_STAGE(PG8_SA(1, 0), cA + kstep, voffA); PG8_STAGE(PG8_SB(1, 1), cB + hstepB + kstep, voffB);
        PG8_WAIT_V(6); PG8_BAR;
    }
    for (;;) {
        const bool has_next = S.next(ui + 1, nxt);
        const char* nA = has_next ? (const char*)g.A + nxt.aoff : cA; const char* nB = has_next ? (const char*)g.Bt + nxt.boff : cB;
#pragma unroll 1
        for (int t = 0; t < nt; t += 2) {
            const bool last = (t == nt - 2);
            const char* a1 = cA + (size_t)(t + 1) * kstep;
            const char* a2 = last ? nA : cA + (size_t)(t + 2) * kstep; const char* b2 = last ? nB : cB + (size_t)(t + 2) * kstep;
            const char* a3 = a2 + kstep; const char* b3 = b2 + kstep;
            if (last && has_next) S.a_ready(nxt);
            if constexpr (SP2) {
            PG8_LDB(B0, 0, 0); PG8_LDB(B1, 0, 1); PG8_SCHED; PG8_LDA(At, 0, 0); PG8_STAGE(PG8_SA(1, 1), a1 + hstepA, voffA);
            PG8_WAIT_V(8); PG8_WAIT_L(0); PG8_BAR; PG8_MMA(0, 0, At, B0); PG8_MMA(0, 1, At, B1); PG8_BAR; PG8_SCHED;
            PG8_LDA(At, 0, 1); PG8_STAGE(PG8_SB(0, 0), b2, voffB); PG8_STAGE(PG8_SB(0, 1), b2 + hstepB, voffB); PG8_STAGE(PG8_SA(0, 0), a2, voffA);
            PG8_WAIT_V(8); PG8_WAIT_L(0); PG8_BAR; PG8_MMA(1, 0, At, B0); PG8_MMA(1, 1, At, B1); PG8_BAR; PG8_SCHED;
            PG8_LDB(B0, 1, 0); PG8_LDB(B1, 1, 1); PG8_SCHED; PG8_LDA(At, 1, 0); PG8_STAGE(PG8_SA(0, 1), a2 + hstepA, voffA);
            PG8_WAIT_V(8); PG8_WAIT_L(0); PG8_BAR; PG8_MMA(0, 0, At, B0); PG8_MMA(0, 1, At, B1); PG8_BAR; PG8_SCHED;
            PG8_LDA(At, 1, 1); PG8_STAGE(PG8_SB(1, 0), b3, voffB); PG8_STAGE(PG8_SB(1, 1), b3 + hstepB, voffB); PG8_STAGE(PG8_SA(1, 0), a3, voffA);
            PG8_WAIT_V(8); PG8_WAIT_L(0); PG8_BAR; PG8_MMA(1, 0, At, B0); PG8_MMA(1, 1, At, B1); PG8_BAR; PG8_SCHED;
            } else {
            PG8_LDB(B0, 0, 0); PG8_SCHED; PG8_LDA(At, 0, 0); PG8_STAGE(PG8_SA(1, 1), a1 + hstepA, voffA);
            PG8_WAIT_L(8); PG8_BAR; PG8_WAIT_L(0); PG8_MMA(0, 0, At, B0); PG8_BAR; PG8_SCHED;
            PG8_LDB(B1, 0, 1); PG8_STAGE(PG8_SB(0, 0), b2, voffB);
            PG8_BAR; PG8_WAIT_L(0); PG8_MMA(0, 1, At, B1); PG8_BAR;
            PG8_LDA(At, 0, 1); PG8_STAGE(PG8_SA(0, 0), a2, voffA);
            PG8_BAR; PG8_WAIT_L(0); PG8_MMA(1, 0, At, B0); PG8_BAR; PG8_SCHED;
            PG8_STAGE(PG8_SB(0, 1), b2 + hstepB, voffB);
            PG8_WAIT_V(6); PG8_BAR; PG8_MMA(1, 1, At, B1); PG8_BAR;
            PG8_LDB(B0, 1, 0); PG8_SCHED; PG8_LDA(At, 1, 0); PG8_STAGE(PG8_SA(0, 1), a2 + hstepA, voffA);
            PG8_WAIT_L(8); PG8_BAR; PG8_WAIT_L(0); PG8_MMA(0, 0, At, B0); PG8_BAR; PG8_SCHED;
            PG8_LDB(B1, 1, 1); PG8_STAGE(PG8_SB(1, 0), b3, voffB);
            PG8_BAR; PG8_WAIT_L(0); PG8_MMA(0, 1, At, B1); PG8_BAR;
            PG8_LDA(At, 1, 1); PG8_STAGE(PG8_SA(1, 0), a3, voffA);
            PG8_BAR; PG8_WAIT_L(0); PG8_MMA(1, 0, At, B0); PG8_BAR; PG8_SCHED;
            PG8_STAGE(PG8_SB(1, 1), b3 + hstepB, voffB);
            PG8_WAIT_V(6); PG8_BAR; PG8_MMA(1, 1, At, B1); PG8_BAR;
            }
        }
        if constexpr (ALIGN_EPI) { if (wr == 0) PG8_BAR; }
        if constexpr (!Epi::AFTER_DRAIN) { E(acc, cur, wr, wc, fr, fq); S.done(cur); }
        if (!has_next) break;
#pragma unroll
        for (int a = 0; a < 2; ++a)
#pragma unroll
            for (int b = 0; b < 2; ++b)
#pragma unroll
                for (int m = 0; m < 4; ++m)
#pragma unroll
                    for (int n = 0; n < 2; ++n) acc[a][b][m][n] = (f32x4){0.f, 0.f, 0.f, 0.f};
        cur = nxt; cA = nA; cB = nB; ++ui;
        if constexpr (ALIGN_EPI) { if (wr == 1) PG8_BAR; }
    }
    PG8_WAIT_V(0);
    if constexpr (!ALIGN_EPI) { if (wr == 0) PG8_BAR; }
    PG8_BAR;
    if constexpr (Epi::AFTER_DRAIN) { E.fused(acc, cur, wr, wc, fr, fq, lds, wid, lane); S.done(cur); }
#undef PG8_SA
#undef PG8_SB
#undef PG8_STAGE
#undef PG8_LDA
#undef PG8_LDB
#undef PG8_MMA
#undef PG8_WAIT_V
#undef PG8_WAIT_L
#undef PG8_BAR
#undef PG8_SCHED
}}

#define DI __device__ __forceinline__
#define LAS __attribute__((address_space(3)))
typedef unsigned short bf16;
typedef short bf16x8 __attribute__((ext_vector_type(8)));
typedef float f32x4 __attribute__((ext_vector_type(4)));
typedef float f32x16 __attribute__((ext_vector_type(16)));
typedef unsigned u32x4 __attribute__((ext_vector_type(4)));
typedef unsigned u32x2 __attribute__((ext_vector_type(2)));
typedef __bf16 bf16x2_t __attribute__((ext_vector_type(2)));
typedef float f32x2_t __attribute__((ext_vector_type(2)));
using pg8::Unit;

constexpr int D = 1024, S = 16384, NB = 2, MP = NB * S, MS = 256, MT = MP + MS, FF = 2816, NL = 2, NTHR = 512;
constexpr float EPS = 1e-6f, LOG2E = 1.4426950408889634f;
constexpr size_t MiB = 1u << 20;
constexpr size_t WS_SS_OLD = 0;
constexpr size_t WS_LINV = 2 * MiB;
constexpr size_t WS_ROPE = 3 * MiB;
constexpr size_t WS_MN = 7 * MiB;
constexpr size_t WS_MKB = 8 * MiB;
constexpr size_t WS_MVT = 10 * MiB;
constexpr size_t WS_W = 12 * MiB, LW = 47 * MiB;
constexpr size_t W_1 = 0, W_D1 = 11 * MiB, W_IN = W_D1 + 11 * MiB / 2, W_OUT = W_IN + 4 * MiB, W_Q = W_OUT + 2 * MiB, W_O = W_Q + 2 * MiB, W_2 = W_O + 2 * MiB, W_D2 = W_2 + 11 * MiB, W_KV = W_D2 + 11 * MiB / 2;
static_assert(W_KV + 4 * MiB == LW, "weights map");
constexpr size_t WS_XB = WS_W + 2 * LW;
constexpr size_t WS_R = WS_XB + 65 * MiB;
constexpr size_t R_H = 0;
constexpr size_t R_GB = 0, R_CV = R_GB + (size_t)MT * 256 * 2, R_Q = R_CV + (size_t)MT * 256 * 2, R_K = R_Q + (size_t)MT * 512 * 2, R_VT = R_K + (size_t)MT * 128 * 2,
                 R_VS = R_VT + (size_t)NB * 128 * S * 2, R_GLU = R_VS + (size_t)MS * 128 * 2, R_YMIX = 101 * MiB;
static_assert(R_GLU + (size_t)MT * 256 * 2 <= R_YMIX, "R map");
constexpr size_t R_QX = 0, R_P = 68 * MiB;
constexpr size_t WS_SS = WS_R + 178 * MiB;
constexpr size_t WS_END = WS_SS + 19 * MiB;
static_assert((size_t)9 * MT * 64 <= 19 * MiB, "ss");
static_assert((size_t)MT * FF * 2 <= 178 * MiB && (size_t)MT * D * 2 <= 65 * MiB, "sizes");
constexpr size_t O_YP = 0, O_YS = O_YP + (size_t)MP * D, O_KP = O_YS + (size_t)MS * D, O_VP = O_KP + 65536, O_AP = O_VP + 65536, O_CP = O_AP + 2048, O_MK = O_CP + 30720,
                 O_MV = O_MK + 1048576, O_KS = O_MV + 1048576, O_VS = O_KS + 65536, O_AS = O_VS + 65536, O_CS = O_AS + 16384, O_END = O_CS + 245760;
constexpr int LDS_BYTES = 162816, LDS_EPI = 131072, LDS_TAB = 162816 - 512;

struct Args { const float* in[34]; float* out; unsigned char* ws; int ph_lo, ph_hi; };
enum { I_XP = 0, I_XS, I_CK, I_CV, I_SA, I_SC, I_MK, I_MV, I_MEM, I_F1N, I_F1G, I_F1U, I_F1D, I_MIXN, I_WIN, I_CAW, I_SINK, I_CCW, I_CCB, I_LNG, I_LNB, I_MON, I_WOUT,
       I_XAN, I_MEMN, I_WQ, I_WK, I_WV, I_WO, I_F2N, I_F2G, I_F2U, I_F2D, I_FIN };

DI const float* tab_ptr(LAS unsigned char* lds, int idx) { const u32x2 v = *((const LAS u32x2*)(lds + LDS_TAB) + idx); const unsigned lo = __builtin_amdgcn_readfirstlane(v.x), hi = __builtin_amdgcn_readfirstlane(v.y); return (const float*)(((unsigned long long)hi << 32) | lo); }
#define IN(idx) tab_ptr(lds, idx)
DI float ss_row(const float* ss, int row) { const f32x4* p = (const f32x4*)(ss + (size_t)row * 16); const f32x4 a = p[0], b = p[1], c = p[2], d = p[3]; return (((a[0] + a[1]) + (a[2] + a[3])) + ((b[0] + b[1]) + (b[2] + b[3]))) + (((c[0] + c[1]) + (c[2] + c[3])) + ((d[0] + d[1]) + (d[2] + d[3]))); }
DI float bf2f(unsigned short b) { return __uint_as_float((unsigned)b << 16); }
DI unsigned pk2(float lo, float hi) { f32x2_t v = {lo, hi}; bf16x2_t b = __builtin_convertvector(v, bf16x2_t); return __builtin_bit_cast(unsigned, b); }
DI bf16 f2bf(float f) { return (bf16)(pk2(f, 0.f) & 0xffffu); }
DI void st4bf(bf16* p, f32x4 v) { u32x2 w; w.x = pk2(v[0], v[1]); w.y = pk2(v[2], v[3]); *(u32x2*)p = w; }
DI f32x4 unpk4(u32x2 w) { return (f32x4){__uint_as_float(w.x << 16), __uint_as_float(w.x & 0xffff0000u), __uint_as_float(w.y << 16), __uint_as_float(w.y & 0xffff0000u)}; }
DI f32x4 ld4bf(const bf16* p) { return unpk4(*(const u32x2*)p); }
DI void st8bf(bf16* p, f32x4 a, f32x4 b) { u32x4 w; w.x = pk2(a[0], a[1]); w.y = pk2(a[2], a[3]); w.z = pk2(b[0], b[1]); w.w = pk2(b[2], b[3]); *(u32x4*)p = w; }
DI float dpp_f(float v, const int ctrl_tag);
template <int CTRL> DI float dppx(float v) { return __builtin_bit_cast(float, __builtin_amdgcn_update_dpp(0, __builtin_bit_cast(int, v), CTRL, 0xf, 0xf, true)); }
DI float wave_sum(float v) {
    v += dppx<0xB1>(v); v += dppx<0x4E>(v); v += dppx<0x141>(v); v += dppx<0x140>(v);
    const float a = __builtin_bit_cast(float, __builtin_amdgcn_readlane(__builtin_bit_cast(int, v), 0)), b = __builtin_bit_cast(float, __builtin_amdgcn_readlane(__builtin_bit_cast(int, v), 16)),
                c = __builtin_bit_cast(float, __builtin_amdgcn_readlane(__builtin_bit_cast(int, v), 32)), d = __builtin_bit_cast(float, __builtin_amdgcn_readlane(__builtin_bit_cast(int, v), 48));
    return (a + b) + (c + d);
}
DI float wave_max(float v) {
#pragma unroll
    for (int o = 1; o < 64; o <<= 1) v = fmaxf(v, __shfl_xor(v, o));
    return v;
}
DI float sigmoidf_(float x) { return __builtin_amdgcn_rcpf(1.f + __builtin_amdgcn_exp2f(-LOG2E * x)); }
#define LDS_WAIT() asm volatile("s_waitcnt lgkmcnt(0)" ::: "memory")
#define EPI_BAR() do { asm volatile("s_waitcnt lgkmcnt(0)" ::: "memory"); __builtin_amdgcn_s_barrier(); asm volatile("" ::: "memory"); } while (0)

template <class F> struct EpiA {
    static constexpr bool PERM = F::PERM, AFTER_DRAIN = false; F f;
    template <int KIND> DI void body(const f32x4 (&acc)[2][2][4][2], const Unit& u, int wr, int wc, int fr, int fq) const {
#pragma unroll
        for (int ai = 0; ai < 2; ++ai)
#pragma unroll
            for (int m = 0; m < 4; ++m) {
                const int lr = ai * 128 + wr * 64 + m * 16 + fr, row = u.pm * 256 + lr; typename F::Row rc; f.row_begin(rc, row, u.pn, lr);
                if constexpr (F::PERM) f.template apply8<KIND>(rc, row, u.pn, wc * 32 + fq * 8, acc[ai][0][m][0], acc[ai][0][m][1], acc[ai][1][m][0], acc[ai][1][m][1]);
                else {
#pragma unroll
                for (int n = 0; n < 2; ++n) f.template apply<KIND>(rc, row, u.pn, wc * 32 + n * 16 + fq * 4, acc[ai][0][m][n], acc[ai][1][m][n]); }
                f.row_end(rc, row, u.pn, fq, wc);
            }
    }
    DI void operator()(const f32x4 (&acc)[2][2][4][2], const Unit& u, int wr, int wc, int fr, int fq) const {
        asm volatile("" : "+v"(fr), "+v"(fq));
        if constexpr (F::USE_SS) {
            const int t = (wr * 4 + wc) * 64 + fq * 16 + fr;
            if (t < 256) f.rsl[t] = rsqrtf(ss_row(f.ss, u.pm * 256 + t) * (1.f / D) + EPS);
            EPI_BAR();
        }
        if constexpr (F::NKIND == 1) body<0>(acc, u, wr, wc, fr, fq);
        else { const int kd = f.kind(u.pn);
            if (kd == 0) body<0>(acc, u, wr, wc, fr, fq); else if (kd == 1) body<1>(acc, u, wr, wc, fr, fq);
            else if constexpr (F::NKIND > 2) { if (kd == 2) body<2>(acc, u, wr, wc, fr, fq); else if (kd == 3) body<3>(acc, u, wr, wc, fr, fq); else body<4>(acc, u, wr, wc, fr, fq); } }    }
};
template <class F> DI void apply_two(const F& f, int row, int pn, int c, const f32x4 (&v0)[2], const f32x4 (&v1)[2], int fq, int sub) {
    typename F::Row rc; f.row_begin(rc, row, pn, -1);
#pragma unroll
    for (int wb = 0; wb < 2; ++wb) {
        if constexpr (F::NKIND == 1) f.template apply<0>(rc, row, pn, c + wb * 16, v0[wb], v1[wb]);
        else { const int kd = f.kind(pn);
            if (kd == 0) f.template apply<0>(rc, row, pn, c + wb * 16, v0[wb], v1[wb]); else if (kd == 1) f.template apply<1>(rc, row, pn, c + wb * 16, v0[wb], v1[wb]);
            else if constexpr (F::NKIND > 2) { if (kd == 2) f.template apply<2>(rc, row, pn, c + wb * 16, v0[wb], v1[wb]); else if (kd == 3) f.template apply<3>(rc, row, pn, c + wb * 16, v0[wb], v1[wb]); else f.template apply<4>(rc, row, pn, c + wb * 16, v0[wb], v1[wb]); } }
    }
    f.row_end(rc, row, pn, fq, sub);
}

struct FUp {
    static constexpr int NKIND = 1; static constexpr bool USE_SS = true, PERM = true; const float* ss; bf16* h; LAS float* rsl;
    struct Row { float rs; };
    DI void row_begin(Row& rc, int row, int, int lr) const { rc.rs = lr >= 0 ? rsl[lr] : rsqrtf(ss_row(ss, row) * (1.f / D) + EPS); }
    template <int> DI void apply(const Row& rc, int row, int pn, int c, f32x4 v0, f32x4 v1) const {
        f32x4 o;
#pragma unroll
        for (int e = 0; e < 4; ++e) { const float g = v0[e] * rc.rs, u = v1[e] * rc.rs; o[e] = g * sigmoidf_(g) * u; }
        st4bf(h + (size_t)row * FF + pn * 128 + c, o);
    }
    template <int> DI void apply8(const Row& rc, int row, int pn, int c, f32x4 g0, f32x4 g1, f32x4 u0, f32x4 u1) const {
        f32x4 o0, o1;
#pragma unroll
        for (int e = 0; e < 4; ++e) { const float ga = g0[e] * rc.rs, gb = g1[e] * rc.rs; o0[e] = ga * sigmoidf_(ga) * (u0[e] * rc.rs); o1[e] = gb * sigmoidf_(gb) * (u1[e] * rc.rs); }
        st8bf(h + (size_t)row * FF + pn * 128 + c, o0, o1);
    }
    DI void row_end(const Row&, int, int, int, int) const {}
};
struct FUpCheap {
    static constexpr int NKIND = 1; static constexpr bool USE_SS = false, PERM = false; bf16* h;
    struct Row { float rs; };
    DI void row_begin(Row&, int, int, int) const {}
    template <int> DI void apply(const Row&, int row, int pn, int c, f32x4 v0, f32x4 v1) const { st4bf(h + (size_t)row * FF + pn * 128 + c, v0 + v1); }
    DI void row_end(const Row&, int, int, int, int) const {}
};
struct FRes {
    static constexpr int NKIND = 1; static constexpr bool USE_SS = false, PERM = true; bf16* xb; float* ssn; float alpha;
    struct Row { float a; };
    DI void row_begin(Row& rc, int, int, int) const { rc.a = 0.f; }
    template <int> DI void apply(Row& rc, int row, int pn, int c, f32x4 v0, f32x4 v1) const {
#pragma unroll
        for (int bj = 0; bj < 2; ++bj) {
            bf16* p = xb + (size_t)row * D + pn * 256 + bj * 128 + c; const f32x4 x = ld4bf(p); const f32x4 v = bj ? v1 : v0;
            u32x2 w; w.x = pk2(x[0] + alpha * v[0], x[1] + alpha * v[1]); w.y = pk2(x[2] + alpha * v[2], x[3] + alpha * v[3]); *(u32x2*)p = w;
            const f32x4 r = unpk4(w); rc.a += (r[0] * r[0] + r[1] * r[1]) + (r[2] * r[2] + r[3] * r[3]);
        }
    }
    template <int> DI void apply8(Row& rc, int row, int pn, int c, f32x4 a0, f32x4 a1, f32x4 b0, f32x4 b1) const {
#pragma unroll
        for (int bj = 0; bj < 2; ++bj) {
            bf16* p = xb + (size_t)row * D + pn * 256 + bj * 128 + c; const u32x4 xw = *(const u32x4*)p; const f32x4 x0 = unpk4((u32x2){xw.x, xw.y}), x1 = unpk4((u32x2){xw.z, xw.w});
            const f32x4 v0 = bj ? b0 : a0, v1 = bj ? b1 : a1;
            u32x4 w; w.x = pk2(x0[0] + alpha * v0[0], x0[1] + alpha * v0[1]); w.y = pk2(x0[2] + alpha * v0[2], x0[3] + alpha * v0[3]); w.z = pk2(x1[0] + alpha * v1[0], x1[1] + alpha * v1[1]); w.w = pk2(x1[2] + alpha * v1[2], x1[3] + alpha * v1[3]);
            *(u32x4*)p = w; const f32x4 r0 = unpk4((u32x2){w.x, w.y}), r1 = unpk4((u32x2){w.z, w.w});
            rc.a += ((r0[0] * r0[0] + r0[1] * r0[1]) + (r0[2] * r0[2] + r0[3] * r0[3])) + ((r1[0] * r1[0] + r1[1] * r1[1]) + (r1[2] * r1[2] + r1[3] * r1[3]));
        }
    }
    DI void row_end(const Row& rc, int row, int pn, int fq, int sub) const { float s = rc.a; s += __shfl_xor(s, 16); s += __shfl_xor(s, 32); if (fq == 0) ssn[(size_t)row * 16 + pn * 4 + sub] = s; }
};
struct FScale {
    static constexpr int NKIND = 1; static constexpr bool USE_SS = true, PERM = true; const float* ss; bf16* o; float sc; LAS float* rsl;
    struct Row { float rs; };
    DI void row_begin(Row& rc, int row, int, int lr) const { rc.rs = (lr >= 0 ? rsl[lr] : rsqrtf(ss_row(ss, row) * (1.f / D) + EPS)) * sc; }
    template <int> DI void apply(const Row& rc, int row, int pn, int c, f32x4 v0, f32x4 v1) const {
        st4bf(o + (size_t)row * D + pn * 256 + c, v0 * rc.rs); st4bf(o + (size_t)row * D + pn * 256 + 128 + c, v1 * rc.rs);
    }
    template <int> DI void apply8(const Row& rc, int row, int pn, int c, f32x4 a0, f32x4 a1, f32x4 b0, f32x4 b1) const { st8bf(o + (size_t)row * D + pn * 256 + c, a0 * rc.rs, a1 * rc.rs); st8bf(o + (size_t)row * D + pn * 256 + 128 + c, b0 * rc.rs, b1 * rc.rs); }
    DI void row_end(const Row&, int, int, int, int) const {}
};
struct FPV {
    static constexpr int NKIND = 1; static constexpr bool USE_SS = false, PERM = true; const float* linv; bf16* o;
    struct Row { float s; };
    DI void row_begin(Row& rc, int row, int pn, int) const { rc.s = linv[(size_t)row * 4 + pn]; }
    template <int> DI void apply(const Row& rc, int row, int pn, int c, f32x4 v0, f32x4 v1) const {
        st4bf(o + (size_t)row * D + pn * 256 + c, v0 * rc.s); st4bf(o + (size_t)row * D + pn * 256 + 128 + c, v1 * rc.s);
    }
    template <int> DI void apply8(const Row& rc, int row, int pn, int c, f32x4 a0, f32x4 a1, f32x4 b0, f32x4 b1) const { st8bf(o + (size_t)row * D + pn * 256 + c, a0 * rc.s, a1 * rc.s); st8bf(o + (size_t)row * D + pn * 256 + 128 + c, b0 * rc.s, b1 * rc.s); }
    DI void row_end(const Row&, int, int, int, int) const {}
};
struct FMemKV {
    static constexpr int NKIND = 2; static constexpr bool USE_SS = false, PERM = false; float* ok; float* ov; bf16* mkb; bf16* mvt;
    struct Row { int d; };
    DI int kind(int pn) const { return pn < 4 ? 0 : 1; }
    DI void row_begin(Row&, int, int, int) const {}
    template <int KIND> DI void apply(const Row&, int row, int pn, int c, f32x4 v0, f32x4 v1) const {
        if constexpr (KIND == 0) {
#pragma unroll
            for (int bj = 0; bj < 2; ++bj) { const int col = pn * 256 + bj * 128 + c; const f32x4 v = bj ? v1 : v0; *(f32x4*)(ok + (size_t)row * D + col) = v; st4bf(mkb + (size_t)row * D + col, v); }
        } else {
            const int h = pn - 4, b = row >> 8, mem = row & 255;
#pragma unroll
            for (int bj = 0; bj < 2; ++bj) { const int dd = bj * 128 + c; const f32x4 v = bj ? v1 : v0; *(f32x4*)(ov + (size_t)row * D + h * 256 + dd) = v;
#pragma unroll
                for (int e = 0; e < 4; ++e) mvt[((size_t)(b * 4 + h) * 256 + dd + e) * 256 + mem] = f2bf(v[e]); }
        }
    }
    DI void row_end(const Row&, int, int, int, int) const {}
};
struct FWin {
    static constexpr int NKIND = 5; static constexpr bool USE_SS = true, PERM = true; const float* ss; unsigned char* ws; float* out; int l; LAS float* rsl;
    struct Row { float rs; int pos, b, t; bool smp; };
    DI int kind(int pn) const { return pn == 0 ? 0 : pn <= 2 ? 1 : pn <= 4 ? 2 : pn == 5 ? 3 : 4; }
    DI void row_begin(Row& rc, int row, int, int lr) const {
        rc.rs = lr >= 0 ? rsl[lr] : rsqrtf(ss_row(ss, row) * (1.f / D) + EPS);
        if (row < MP) { rc.smp = false; rc.b = row >> 14; rc.pos = row & (S - 1); rc.t = 0; } else { const int sr = row - MP; rc.smp = true; rc.b = sr >> 4; rc.t = sr & 15; rc.pos = 1024 + rc.t; }
    }
    template <int KIND> DI void apply(const Row& rc, int row, int pn, int c, f32x4 v0, f32x4 v1) const {
        unsigned char* R = ws + WS_R; const f32x4 a0 = v0 * rc.rs, a1 = v1 * rc.rs;
        if constexpr (KIND == 0) { bf16* gb = (bf16*)(R + R_GB) + (size_t)row * 256 + c; st4bf(gb, a0); st4bf(gb + 128, a1); }
        else if constexpr (KIND == 1) {
            const int ch = (pn - 1) * 128 + c; const f32x4 p = a0 * a1; st4bf((bf16*)(R + R_CV) + (size_t)row * 256 + ch, p);
            if (!rc.smp) { if (rc.pos >= S - 2) *(f32x4*)(out + O_AP + (size_t)l * 1024 + (size_t)(rc.b * 2 + rc.pos - (S - 2)) * 256 + ch) = p; }
            else if (rc.t >= 14) *(f32x4*)(out + O_AS + (size_t)l * 8192 + (size_t)(rc.b * 2 + rc.t - 14) * 256 + ch) = p;
        } else if constexpr (KIND == 2 || KIND == 3) {
            const int blk = c >> 5, i = c & 31;
            if (KIND == 3 && blk >= 2) {
                const int kvh = blk - 2;
                if (!rc.smp) {
                    bf16* vT = (bf16*)(R + R_VT) + ((size_t)(rc.b * 2 + kvh) * 64 + i) * S + rc.pos;
#pragma unroll
                    for (int e = 0; e < 4; ++e) { vT[(size_t)e * S] = f2bf(a0[e]); vT[(size_t)(32 + e) * S] = f2bf(a1[e]); }
                    if (rc.pos >= S - 128) { float* o = out + O_VP + (size_t)l * 32768 + ((size_t)(rc.b * 128 + rc.pos - (S - 128)) * 2 + kvh) * 64 + i; *(f32x4*)o = a0; *(f32x4*)(o + 32) = a1; }
                } else {
                    bf16* p = (bf16*)(R + R_VS) + (size_t)(row - MP) * 128 + kvh * 64 + i; st4bf(p, a0); st4bf(p + 32, a1);
                    float* o = out + O_VS + (size_t)l * 32768 + ((size_t)(rc.b * 16 + rc.t) * 2 + kvh) * 64 + i; *(f32x4*)o = a0; *(f32x4*)(o + 32) = a1;
                }
            } else {
                const float* rcos = (const float*)(ws + WS_ROPE) + (size_t)rc.pos * 32 + i;
                const f32x4 cs = *(const f32x4*)rcos, sn = *(const f32x4*)(rcos + (size_t)S * 32);
                const f32x4 o1 = a0 * cs - a1 * sn, o2 = a1 * cs + a0 * sn;
                if constexpr (KIND == 2) { const int head = (pn - 3) * 4 + blk; const float QS = 0.125f * LOG2E; bf16* p = (bf16*)(R + R_Q) + (size_t)row * 512 + head * 64 + i; st4bf(p, o1 * QS); st4bf(p + 32, o2 * QS); }
                else {
                    bf16* p = (bf16*)(R + R_K) + (size_t)row * 128 + blk * 64 + i; st4bf(p, o1); st4bf(p + 32, o2);
                    if (!rc.smp) { if (rc.pos >= S - 128) { float* o = out + O_KP + (size_t)l * 32768 + ((size_t)(rc.b * 128 + rc.pos - (S - 128)) * 2 + blk) * 64 + i; *(f32x4*)o = o1; *(f32x4*)(o + 32) = o2; } }
                    else { float* o = out + O_KS + (size_t)l * 32768 + ((size_t)(rc.b * 16 + rc.t) * 2 + blk) * 64 + i; *(f32x4*)o = o1; *(f32x4*)(o + 32) = o2; }
                }
            }
        } else {
            const int ch = (pn - 6) * 128 + c; f32x4 g;
#pragma unroll
            for (int e = 0; e < 4; ++e) g[e] = a0[e] * sigmoidf_(a1[e]);
            st4bf((bf16*)(R + R_GLU) + (size_t)row * 256 + ch, g);
            if (!rc.smp) { if (rc.pos >= S - 30) *(f32x4*)(out + O_CP + (size_t)l * 15360 + (size_t)(rc.b * 30 + rc.pos - (S - 30)) * 256 + ch) = g; }
            else *(f32x4*)(out + O_CS + (size_t)l * 122880 + (size_t)(rc.b * 30 + 14 + rc.t) * 256 + ch) = g;
        }
    }
    template <int KIND> DI void apply8(const Row& rc, int row, int pn, int c, f32x4 v0a, f32x4 v0b, f32x4 v1a, f32x4 v1b) const {
        unsigned char* R = ws + WS_R; const f32x4 a0 = v0a * rc.rs, a1 = v0b * rc.rs, b0 = v1a * rc.rs, b1 = v1b * rc.rs;
        if constexpr (KIND == 0) { bf16* gb = (bf16*)(R + R_GB) + (size_t)row * 256 + c; st8bf(gb, a0, a1); st8bf(gb + 128, b0, b1); }
        else if constexpr (KIND == 1) {
            const int ch = (pn - 1) * 128 + c; const f32x4 p0 = a0 * b0, p1 = a1 * b1; st8bf((bf16*)(R + R_CV) + (size_t)row * 256 + ch, p0, p1);
            if (rc.pos >= S - 2) { float* o = out + O_AP + (size_t)l * 1024 + (size_t)(rc.b * 2 + rc.pos - (S - 2)) * 256 + ch; *(f32x4*)o = p0; *(f32x4*)(o + 4) = p1; }
        } else if constexpr (KIND == 2 || KIND == 3) {
            const int blk = c >> 5, i = c & 31;
            if (KIND == 3 && blk >= 2) { apply<3>(rc, row, pn, c, v0a, v1a); apply<3>(rc, row, pn, c + 4, v0b, v1b); }
            else {
                const float* rcos = (const float*)(ws + WS_ROPE) + (size_t)rc.pos * 32 + i; const float* rsin = rcos + (size_t)S * 32;
                const f32x4 c0 = *(const f32x4*)rcos, c1 = *(const f32x4*)(rcos + 4), s0 = *(const f32x4*)rsin, s1 = *(const f32x4*)(rsin + 4);
                const f32x4 o1a = a0 * c0 - b0 * s0, o1b = a1 * c1 - b1 * s1, o2a = b0 * c0 + a0 * s0, o2b = b1 * c1 + a1 * s1;
                if constexpr (KIND == 2) { const int head = (pn - 3) * 4 + blk; const float QS = 0.125f * LOG2E; bf16* p = (bf16*)(R + R_Q) + (size_t)row * 512 + head * 64 + i; st8bf(p, o1a * QS, o1b * QS); st8bf(p + 32, o2a * QS, o2b * QS); }
                else {
                    bf16* p = (bf16*)(R + R_K) + (size_t)row * 128 + blk * 64 + i; st8bf(p, o1a, o1b); st8bf(p + 32, o2a, o2b);
                    if (rc.pos >= S - 128) { float* o = out + O_KP + (size_t)l * 32768 + ((size_t)(rc.b * 128 + rc.pos - (S - 128)) * 2 + blk) * 64 + i; *(f32x4*)o = o1a; *(f32x4*)(o + 4) = o1b; *(f32x4*)(o + 32) = o2a; *(f32x4*)(o + 36) = o2b; }
                }
            }
        } else {
            const int ch = (pn - 6) * 128 + c; f32x4 g0, g1;
#pragma unroll
            for (int e = 0; e < 4; ++e) { g0[e] = a0[e] * sigmoidf_(b0[e]); g1[e] = a1[e] * sigmoidf_(b1[e]); }
            st8bf((bf16*)(R + R_GLU) + (size_t)row * 256 + ch, g0, g1);
            if (rc.pos >= S - 30) { float* o = out + O_CP + (size_t)l * 15360 + (size_t)(rc.b * 30 + rc.pos - (S - 30)) * 256 + ch; *(f32x4*)o = g0; *(f32x4*)(o + 4) = g1; }
        }
    }
    DI void row_end(const Row&, int, int, int, int) const {}
};
struct EpiS {
    static constexpr bool PERM = true, AFTER_DRAIN = false;
    bf16* P; float* linv; LAS float* sc;
    DI void operator()(const f32x4 (&acc)[2][2][4][2], const Unit& u, int wr, int wc, int fr, int fq) const {
        LAS float* Pm = sc; LAS float* Ps = sc + 1024;
#pragma unroll
        for (int ai = 0; ai < 2; ++ai)
#pragma unroll
            for (int m = 0; m < 4; ++m) {
                float mx = -3.0e38f;
#pragma unroll
                for (int bj = 0; bj < 2; ++bj)
#pragma unroll
                    for (int n = 0; n < 2; ++n) { const f32x4 x = acc[ai][bj][m][n]; mx = fmaxf(mx, fmaxf(fmaxf(x[0], x[1]), fmaxf(x[2], x[3]))); }
                mx = fmaxf(mx, __shfl_xor(mx, 16)); mx = fmaxf(mx, __shfl_xor(mx, 32));
                if (fq == 0) Pm[(ai * 128 + wr * 64 + m * 16 + fr) * 4 + wc] = mx;
            }
        EPI_BAR();
#pragma unroll
        for (int ai = 0; ai < 2; ++ai)
#pragma unroll
            for (int m = 0; m < 4; ++m) {
                const int r = ai * 128 + wr * 64 + m * 16 + fr; const f32x4 m4 = *(LAS f32x4*)(Pm + r * 4);
                const float mx = fmaxf(fmaxf(m4[0], m4[1]), fmaxf(m4[2], m4[3])); float sum = 0.f;
                bf16* prow = P + (size_t)(u.pm * 256 + r) * D + u.pn * 256 + wc * 32 + fq * 8;
#pragma unroll
                for (int bj = 0; bj < 2; ++bj) {
                    const f32x4 x = acc[ai][bj][m][0], y = acc[ai][bj][m][1]; u32x4 w;
                    w.x = pk2(__builtin_amdgcn_exp2f(x[0] - mx), __builtin_amdgcn_exp2f(x[1] - mx)); w.y = pk2(__builtin_amdgcn_exp2f(x[2] - mx), __builtin_amdgcn_exp2f(x[3] - mx));
                    w.z = pk2(__builtin_amdgcn_exp2f(y[0] - mx), __builtin_amdgcn_exp2f(y[1] - mx)); w.w = pk2(__builtin_amdgcn_exp2f(y[2] - mx), __builtin_amdgcn_exp2f(y[3] - mx));
                    *(u32x4*)(prow + bj * 128) = w; const f32x4 p0 = unpk4((u32x2){w.x, w.y}), p1 = unpk4((u32x2){w.z, w.w}); sum += ((p0[0] + p0[1]) + (p0[2] + p0[3])) + ((p1[0] + p1[1]) + (p1[2] + p1[3]));
                }
                sum += __shfl_xor(sum, 16); sum += __shfl_xor(sum, 32);
                if (fq == 0) Ps[r * 4 + wc] = sum;
            }
        EPI_BAR();
        const int tid = (wr * 4 + wc) * 64 + fq * 16 + fr;
        if (tid < 256) { const f32x4 s4 = *(LAS f32x4*)(Ps + tid * 4); linv[(size_t)(u.pm * 256 + tid) * 4 + u.pn] = 1.f / ((s4[0] + s4[1]) + (s4[2] + s4[3])); }
    }
};

template <int K, class F> DI void sample_gemm(int wv, LAS unsigned char* lds, const bf16* A, int lda, const bf16* Bt, int ldb, int nN, const F& f, int G, int c0) {
    unsigned z_ = 0u; asm volatile("" : "+v"(z_)); const int tid_ = wv * 64 + (int)__builtin_amdgcn_mbcnt_hi(~0u, __builtin_amdgcn_mbcnt_lo(~0u, z_)); const int tid = tid_, w = __builtin_amdgcn_readfirstlane(tid >> 6), lane = tid & 63, fr = lane & 15, fq = lane >> 4;
    LAS float* red = (LAS float*)lds;
    constexpr int kw = K / 8, NKS = kw / 32, KB = 4;
    const int n_mu = 16 * nN * 4;
    for (int mu = c0; mu < n_mu; mu += G) {
        const int rb = mu & 15, t = mu >> 4, pn = t >> 2, s = t & 3, row0 = MP + rb * 16;
        f32x4 acc[4];
#pragma unroll
        for (int j = 0; j < 4; ++j) acc[j] = (f32x4){0.f, 0.f, 0.f, 0.f};
        const bf16* ap = A + (size_t)(row0 + fr) * lda + w * kw + fq * 8;
        const bf16* bp = Bt + (size_t)(pn * 256 + s * 32 + fr) * ldb + w * kw + fq * 8;
#pragma unroll
        for (int k0 = 0; k0 < NKS; k0 += KB) {
            bf16x8 a[KB], b[KB][4];
#pragma unroll
            for (int kk = 0; kk < KB; ++kk) if (k0 + kk < NKS) {
                a[kk] = *(const bf16x8*)(ap + (k0 + kk) * 32);
#pragma unroll
                for (int j = 0; j < 4; ++j) b[kk][j] = *(const bf16x8*)(bp + (size_t)((j >> 1) * 128 + (j & 1) * 16) * ldb + (k0 + kk) * 32);
            }
#pragma unroll
            for (int kk = 0; kk < KB; ++kk) if (k0 + kk < NKS) {
#pragma unroll
                for (int j = 0; j < 4; ++j) acc[j] = __builtin_amdgcn_mfma_f32_16x16x32_bf16(b[kk][j], a[kk], acc[j], 0, 0, 0);
            }
        }
#pragma unroll
        for (int j = 0; j < 4; ++j) *(LAS f32x4*)(red + ((w * 4 + j) * 64 + lane) * 4) = acc[j];
        __syncthreads();
        if (w == 0) {
            f32x4 v0[2], v1[2];
#pragma unroll
            for (int wb = 0; wb < 2; ++wb) { v0[wb] = (f32x4){0.f, 0.f, 0.f, 0.f}; v1[wb] = v0[wb];
#pragma unroll
                for (int ww = 0; ww < 8; ++ww) { v0[wb] += *(LAS f32x4*)(red + ((ww * 4 + wb) * 64 + lane) * 4); v1[wb] += *(LAS f32x4*)(red + ((ww * 4 + wb + 2) * 64 + lane) * 4); } }
            apply_two(f, row0 + fr, pn, s * 32 + fq * 4, v0, v1, fq, s);
        }
        __syncthreads();
    }
}

template <class F> DI void sample_gemm_wide(int wv, LAS unsigned char* lds, const bf16* A, const bf16* Bt, int nN, const F& f, int G, int c0) {
    unsigned z_ = 0u; asm volatile("" : "+v"(z_)); const int lane = (int)__builtin_amdgcn_mbcnt_hi(~0u, __builtin_amdgcn_mbcnt_lo(~0u, z_)), fr = lane & 15, fq = lane >> 4, w = wv;
    constexpr int K = D;
    LAS float* red = (LAS float*)lds;
    const int n_mu = 4 * nN * 4;
    for (int mu = c0; mu < n_mu; mu += G) {
        const int rg = mu & 3, t = mu >> 2, pn = t >> 2, s = t & 3, row0 = MP + rg * 64;
        f32x4 acc[4][4];
#pragma unroll
        for (int rb = 0; rb < 4; ++rb)
#pragma unroll
            for (int j = 0; j < 4; ++j) acc[rb][j] = (f32x4){0.f, 0.f, 0.f, 0.f};
        const bf16* ap = A + (size_t)(row0 + fr) * K + w * 128 + fq * 8;
        const bf16* bp = Bt + (size_t)(pn * 256 + s * 32 + fr) * K + w * 128 + fq * 8;
        bf16x8 a[4][4], b[4][4];
#pragma unroll
        for (int kk = 0; kk < 4; ++kk)
#pragma unroll
            for (int x = 0; x < 4; ++x) { a[kk][x] = *(const bf16x8*)(ap + (size_t)x * 16 * K + kk * 32); b[kk][x] = *(const bf16x8*)(bp + (size_t)((x >> 1) * 128 + (x & 1) * 16) * K + kk * 32); }
#pragma unroll
        for (int kk = 0; kk < 4; ++kk)
#pragma unroll
            for (int rb = 0; rb < 4; ++rb)
#pragma unroll
                for (int j = 0; j < 4; ++j) acc[rb][j] = __builtin_amdgcn_mfma_f32_16x16x32_bf16(b[kk][j], a[kk][rb], acc[rb][j], 0, 0, 0);
#pragma unroll
        for (int rb = 0; rb < 4; ++rb)
#pragma unroll
            for (int j = 0; j < 4; ++j) *(LAS f32x4*)(red + ((w * 16 + rb * 4 + j) * 64 + lane) * 4) = acc[rb][j];
        __syncthreads();
        {
            const int rb = w >> 1, wb = w & 1; f32x4 v0 = (f32x4){0.f, 0.f, 0.f, 0.f}, v1 = v0;
#pragma unroll
            for (int ww = 0; ww < 8; ++ww) { v0 += *(LAS f32x4*)(red + ((ww * 16 + rb * 4 + wb) * 64 + lane) * 4); v1 += *(LAS f32x4*)(red + ((ww * 16 + rb * 4 + wb + 2) * 64 + lane) * 4); }
            const int row = row0 + rb * 16 + fr, c = s * 32 + wb * 16 + fq * 4; typename F::Row rc; f.row_begin(rc, row, pn, -1);
            if constexpr (F::NKIND == 1) f.template apply<0>(rc, row, pn, c, v0, v1);
            else { const int kd = f.kind(pn);
                if (kd == 0) f.template apply<0>(rc, row, pn, c, v0, v1); else if (kd == 1) f.template apply<1>(rc, row, pn, c, v0, v1);
                else if constexpr (F::NKIND > 2) { if (kd == 2) f.template apply<2>(rc, row, pn, c, v0, v1); else if (kd == 3) f.template apply<3>(rc, row, pn, c, v0, v1); else f.template apply<4>(rc, row, pn, c, v0, v1); } }
        }
        __syncthreads();
    }
}

DI void tr_item(const float* W, int N, int sc0, const float* gain, bf16* WT, int K, int n0, int k0, LAS float* scr, int lane) {
#pragma unroll
    for (int i = 0; i < 8; ++i) { const int kk = 8 * i + (lane >> 3), n4 = (lane & 7) * 4; const float g = gain ? gain[k0 + kk] : 1.f; const f32x4 v = *(const f32x4*)(W + (size_t)(k0 + kk) * N + sc0 + n4);
        LAS float* d = scr + kk * 33 + n4; d[0] = v[0] * g; d[1] = v[1] * g; d[2] = v[2] * g; d[3] = v[3] * g; }
    LDS_WAIT();
    const int c = lane & 7;
#pragma unroll
    for (int j = 0; j < 4; ++j) { const int n = (lane >> 3) + 8 * j; const LAS float* s = scr + (8 * c) * 33 + n;
        u32x4 o; o.x = pk2(s[0 * 33], s[1 * 33]); o.y = pk2(s[2 * 33], s[3 * 33]); o.z = pk2(s[4 * 33], s[5 * 33]); o.w = pk2(s[6 * 33], s[7 * 33]);
        *(u32x4*)(WT + (size_t)(n0 + n) * K + k0 + 8 * c) = o; }
    LDS_WAIT();
}
DI int map_win(int n0) {
    const int t = n0 >> 8, r = n0 & 255, hb = r >> 7, rr = r & 127;
    switch (t) {
        case 0: return r;
        case 1: case 2: return (hb ? 512 : 256) + (t - 1) * 128 + rr;
        case 3: case 4: return 768 + ((t - 3) * 4 + (rr >> 5)) * 64 + hb * 32 + (rr & 31);
        case 5: { const int blk = rr >> 5; return (blk < 2 ? 1280 + blk * 64 : 1408 + (blk - 2) * 64) + hb * 32 + (rr & 31); }
        default: return (hb ? 1792 : 1536) + (t - 6) * 128 + rr;
    }
}
DI void sincos_d(double a, float& sn, float& cs) {
    const double k = rint(a * 0.6366197723675814); double r = fma(-k, 1.5707963267948966, a); r = fma(-k, 6.123233995736766e-17, r); const double r2 = r * r;
    const double s = r * (1.0 + r2 * (-1.0 / 6 + r2 * (1.0 / 120 + r2 * (-1.0 / 5040 + r2 * (1.0 / 362880 + r2 * (-1.0 / 39916800 + r2 * (1.0 / 6227020800.0)))))));
    const double c = 1.0 + r2 * (-0.5 + r2 * (1.0 / 24 + r2 * (-1.0 / 720 + r2 * (1.0 / 40320 + r2 * (-1.0 / 3628800 + r2 * (1.0 / 479001600 + r2 * (-1.0 / 87178291200.0)))))));
    const int q = (int)((long long)k & 3);
    sn = (float)(q == 0 ? s : q == 1 ? c : q == 2 ? -s : -c); cs = (float)(q == 0 ? c : q == 1 ? -s : q == 2 ? -c : s);
}
DI void prologue(int wv, unsigned char* ws, float* out, LAS unsigned char* lds) {
    unsigned z_ = 0u; asm volatile("" : "+v"(z_)); const int tid_ = wv * 64 + (int)__builtin_amdgcn_mbcnt_hi(~0u, __builtin_amdgcn_mbcnt_lo(~0u, z_)); const int tid = tid_, w = __builtin_amdgcn_readfirstlane(tid >> 6), lane = tid & 63, G = gridDim.x;
    const int gw = blockIdx.x * 8 + w, NGW = G * 8; const int gt = blockIdx.x * NTHR + tid, NGT = G * NTHR;
    { float* rc = (float*)(ws + WS_ROPE); float* rs = rc + (size_t)S * 32;
      for (int i = gt; i < S * 32; i += NGT) { const int pos = i >> 5, j = i & 31; double inv = 1.0; for (int q = 0; q < j; ++q) inv *= 0.74989420933245587; float sn, cs; sincos_d((double)pos * inv, sn, cs); rc[i] = cs; rs[i] = sn; } }
    { bf16* xb = (bf16*)(ws + WS_XB); float* ss0 = (float*)(ws + WS_SS); bf16* mn = (bf16*)(ws + WS_MN);
      for (int m = gw; m < MT + 512; m += NGW) {
          const float* src = m < MP ? IN(I_XP) + (size_t)m * D : m < MT ? IN(I_XS) + (size_t)(m - MP) * D : IN(I_MEM) + (size_t)(m - MT) * D;
          f32x4 v[4]; float s = 0.f;
#pragma unroll
          for (int j = 0; j < 4; ++j) { v[j] = *((const f32x4*)src + lane + 64 * j); }
          if (m < MT) {
              bf16* o = xb + (size_t)m * D;
#pragma unroll
              for (int j = 0; j < 4; ++j) { u32x2 wv; wv.x = pk2(v[j][0], v[j][1]); wv.y = pk2(v[j][2], v[j][3]); *((u32x2*)o + lane + 64 * j) = wv; const f32x4 r = unpk4(wv); s += (r[0] * r[0] + r[1] * r[1]) + (r[2] * r[2] + r[3] * r[3]); }
              s = wave_sum(s); if (lane < 16) ss0[(size_t)m * 16 + lane] = lane == 0 ? s : 0.f;
          } else {
#pragma unroll
              for (int j = 0; j < 4; ++j) s += (v[j][0] * v[j][0] + v[j][1] * v[j][1]) + (v[j][2] * v[j][2] + v[j][3] * v[j][3]);
              const float rstd = rsqrtf(wave_sum(s) * (1.f / D) + EPS); bf16* o = mn + (size_t)(m - MT) * D;
#pragma unroll
              for (int j = 0; j < 4; ++j) st4bf(o + 4 * (lane + 64 * j), v[j] * rstd);
          }
      } }
    { LAS float* scr = (LAS float*)(lds + w * 16384);
      constexpr int I1 = 16 * 176, ID = 44 * 32, IIN = 16 * 64, ISQ = 16 * 32, IKV = 16 * 64, IL = 2 * I1 + 2 * ID + IIN + 3 * ISQ + IKV;
      for (int it = gw; it < NL * IL; it += NGW) {
          const int l = it / IL; int r = it % IL; unsigned char* wl = ws + WS_W + (size_t)l * LW;
          if (r < 2 * I1) { const int second = r >= I1; if (second) r -= I1; const int nb = r % 176, kb = r / 176, n0 = nb * 32, pn = n0 >> 8, rr = n0 & 255;
              const float* W = (second ? (rr >= 128 ? IN(I_F2U) : IN(I_F2G)) : (rr >= 128 ? IN(I_F1U) : IN(I_F1G))) + (size_t)l * D * FF;
              tr_item(W, FF, pn * 128 + (rr & 127), (second ? IN(I_F2N) : IN(I_F1N)) + l * D, (bf16*)(wl + (second ? W_2 : W_1)), D, n0, kb * 64, scr, lane); continue; }
          r -= 2 * I1;
          if (r < 2 * ID) { const int second = r >= ID; if (second) r -= ID; const int nb = r % 32, kb = r / 32;
              tr_item((second ? IN(I_F2D) : IN(I_F1D)) + (size_t)l * FF * D, D, nb * 32, nullptr, (bf16*)(wl + (second ? W_D2 : W_D1)), FF, nb * 32, kb * 64, scr, lane); continue; }
          r -= 2 * ID;
          if (r < IIN) { const int nb = r % 64, kb = r / 64; tr_item(IN(I_WIN) + (size_t)l * D * 2048, 2048, map_win(nb * 32), IN(I_MIXN) + l * D, (bf16*)(wl + W_IN), D, nb * 32, kb * 64, scr, lane); continue; }
          r -= IIN;
          if (r < 3 * ISQ) { const int which = r / ISQ; r -= which * ISQ; const int nb = r % 32, kb = r / 32;
              const float* W = (which == 0 ? IN(I_WOUT) : which == 1 ? IN(I_WQ) : IN(I_WO)) + (size_t)l * D * D; const float* g = which == 0 ? IN(I_MON) + l * D : which == 1 ? IN(I_XAN) + l * D : nullptr;
              tr_item(W, D, nb * 32, g, (bf16*)(wl + (which == 0 ? W_OUT : which == 1 ? W_Q : W_O)), D, nb * 32, kb * 64, scr, lane); continue; }
          r -= 3 * ISQ;
          { const int nb = r % 64, kb = r / 64, n0 = nb * 32; tr_item((n0 < 1024 ? IN(I_WK) : IN(I_WV)) + (size_t)l * D * D, D, n0 & 1023, IN(I_MEMN) + l * D, (bf16*)(wl + W_KV), D, n0, kb * 64, scr, lane); }
      } }
}

DI f32x16 mfma32(bf16x8 a, bf16x8 b, f32x16 c) { return __builtin_amdgcn_mfma_f32_32x32x16_bf16(a, b, c, 0, 0, 0); }
constexpr int MX_KSZ = 192 * 144, MX_VOFF = 2 * MX_KSZ, MX_VP = 392, MX_SSB = MX_VOFF + 128 * MX_VP, MX_WC = MX_SSB + 2048, MX_END = MX_WC + 48 * 256 * 4;
static_assert(MX_END <= LDS_TAB, "mixer LDS");

template <int TW, class LA, class LC, class LCP, class LG> DI void conv_tokens(int l, LAS unsigned char* lds, int lane, LA ldA, LC ldC, LCP ldCp, LG ldG, bf16* ymix_row0  ) {
    const int ch = 4 * lane;
    const float* caw = IN(I_CAW) + (size_t)l * 3 * 256 + ch; const f32x4 wa0 = *(const f32x4*)caw, wa1 = *(const f32x4*)(caw + 256), wa2 = *(const f32x4*)(caw + 512);
    const LAS float* wc = (const LAS float*)(lds + MX_WC) + ch;
    f32x4 accA[TW], accC[TW];
    const f32x4 bias = *(const f32x4*)(IN(I_CCB) + l * 256 + ch);
#pragma unroll
    for (int t = 0; t < TW; ++t) { accA[t] = (f32x4){0.f, 0.f, 0.f, 0.f}; accC[t] = bias; }
#pragma unroll
    for (int i = 0; i < TW + 2; ++i) { const f32x4 x = ldA(i);
#pragma unroll
        for (int t = 0; t < TW; ++t) { const int j = i - t; if (j == 0) accA[t] += wa0 * x; else if (j == 1) accA[t] += wa1 * x; else if (j == 2) accA[t] += wa2 * x; } }
    constexpr int NWIN = TW + 30;
    {
#pragma unroll 1
        for (int ib = 0; ib < NWIN; ib += 16) {
            f32x4 x[16];
#pragma unroll
            for (int ii = 0; ii < 16; ++ii) x[ii] = ldC(ib + ii);
#pragma unroll
            for (int ii = 0; ii < 16; ++ii)
#pragma unroll
                for (int t = 0; t < TW; ++t) accC[t] += *(const LAS f32x4*)(wc + (ib + ii - t + 8) * 256) * x[ii];
        }
    }
    const f32x4 lng = *(const f32x4*)(IN(I_LNG) + l * 256 + ch), lnb = *(const f32x4*)(IN(I_LNB) + l * 256 + ch);
#pragma unroll
    for (int t = 0; t < TW; ++t) {
        const f32x4 ya = ldG(t) * accA[t];
        const float ssa = wave_sum((ya[0] * ya[0] + ya[1] * ya[1]) + (ya[2] * ya[2] + ya[3] * ya[3]));
        st4bf(ymix_row0 + (size_t)t * D + ch, ya * rsqrtf(ssa * (1.f / 256) + EPS));
        const f32x4 cc = accC[t];
        const float mean = wave_sum((cc[0] + cc[1]) + (cc[2] + cc[3])) * (1.f / 256); const f32x4 dc = cc - mean;
        const float var = wave_sum((dc[0] * dc[0] + dc[1] * dc[1]) + (dc[2] * dc[2] + dc[3] * dc[3])) * (1.f / 256);
        const f32x4 ln = dc * rsqrtf(var + EPS) * lng + lnb; f32x4 yc;
#pragma unroll
        for (int e = 0; e < 4; ++e) yc[e] = ln[e] * sigmoidf_(ln[e]);
        const float ssc = wave_sum((yc[0] * yc[0] + yc[1] * yc[1]) + (yc[2] * yc[2] + yc[3] * yc[3]));
        st4bf(ymix_row0 + (size_t)t * D + 768 + ch, yc * rsqrtf(ssc * (1.f / 256) + EPS));
    }
}

template <bool SMP> DI void attn_qb(const LAS unsigned char* Kl, const LAS unsigned char* Vl, const bf16* qp, float sink2, int kb0, f32x16 (&o)[2]) {
    bf16x8 qf[4];
#pragma unroll
    for (int ks = 0; ks < 4; ++ks) qf[ks] = *(const bf16x8*)(qp + ks * 16);
    f32x16 s[6];
#pragma unroll
    for (int kb = 0; kb < 6; ++kb)
#pragma unroll
        for (int i = 0; i < 16; ++i) s[kb][i] = 0.f;
#pragma unroll
    for (int ks = 0; ks < 4; ++ks)
#pragma unroll
        for (int kb = 0; kb < 6; ++kb) { const bf16x8 a = *(const LAS bf16x8*)(Kl + kb * 32 * 144 + ks * 32); s[kb] = mfma32(a, qf[ks], s[kb]); }
#pragma unroll
    for (int kb = 0; kb < 6; ++kb) { if (SMP ? kb == 5 : kb < kb0) {
#pragma unroll
            for (int i = 0; i < 16; ++i) s[kb][i] = -3.0e38f; }
        if (SMP && kb == 4) {
#pragma unroll
            for (int i = 8; i < 16; ++i) s[kb][i] = -3.0e38f; } }
    float m4[4] = {sink2, sink2, sink2, sink2};
#pragma unroll
    for (int kb = 0; kb < 6; ++kb)
#pragma unroll
        for (int i = 0; i < 16; ++i) m4[i & 3] = fmaxf(m4[i & 3], s[kb][i]);
    float mx = fmaxf(fmaxf(m4[0], m4[1]), fmaxf(m4[2], m4[3]));
    mx = fmaxf(mx, __shfl_xor(mx, 32));
    float s4[4] = {0.f, 0.f, 0.f, 0.f};
#pragma unroll
    for (int kb = 0; kb < 6; ++kb)
#pragma unroll
        for (int i = 0; i < 16; ++i) { s[kb][i] = __builtin_amdgcn_exp2f(s[kb][i] - mx); s4[i & 3] += s[kb][i]; }
    float sum = (s4[0] + s4[1]) + (s4[2] + s4[3]);
    sum += __shfl_xor(sum, 32);
    const float inv = __builtin_amdgcn_rcpf(sum + __builtin_amdgcn_exp2f(sink2 - mx));
    f32x16 o2[2][2];
#pragma unroll
    for (int hb = 0; hb < 2; ++hb)
#pragma unroll
        for (int t = 0; t < 2; ++t)
#pragma unroll
            for (int i = 0; i < 16; ++i) o2[hb][t][i] = 0.f;
#pragma unroll
    for (int kb = 0; kb < 6; ++kb)
#pragma unroll
        for (int t = 0; t < 2; ++t) {
            u32x4 pw; pw.x = pk2(s[kb][8 * t] * inv, s[kb][8 * t + 1] * inv); pw.y = pk2(s[kb][8 * t + 2] * inv, s[kb][8 * t + 3] * inv);
            pw.z = pk2(s[kb][8 * t + 4] * inv, s[kb][8 * t + 5] * inv); pw.w = pk2(s[kb][8 * t + 6] * inv, s[kb][8 * t + 7] * inv);
            const bf16x8 pf = __builtin_bit_cast(bf16x8, pw);
#pragma unroll
            for (int hb = 0; hb < 2; ++hb) {
                const LAS unsigned char* vp = Vl + hb * 32 * MX_VP + (kb * 32 + t * 16) * 2;
                const u32x2 lo = *(const LAS u32x2*)vp, hi = *(const LAS u32x2*)(vp + 16);
                const bf16x8 vf = __builtin_bit_cast(bf16x8, (u32x4){lo.x, lo.y, hi.x, hi.y});
                o2[hb][t] = mfma32(vf, pf, o2[hb][t]);
            }
        }
#pragma unroll
    for (int hb = 0; hb < 2; ++hb) o[hb] = o2[hb][0] + o2[hb][1];
}

DI void mixer_phase(int wv, unsigned char* ws, float* out, int l, LAS unsigned char* lds, int G, int bx) {
    unsigned z_ = 0u; asm volatile("" : "+v"(z_)); const int tid_ = wv * 64 + (int)__builtin_amdgcn_mbcnt_hi(~0u, __builtin_amdgcn_mbcnt_lo(~0u, z_)); const int tid = tid_, w = __builtin_amdgcn_readfirstlane(tid >> 6), lane = tid & 63, r = lane & 31, hf = lane >> 5;
    unsigned char* R = ws + WS_R;
    const bf16* gb = (const bf16*)(R + R_GB); const bf16* cv = (const bf16*)(R + R_CV); const bf16* qb_ = (const bf16*)(R + R_Q); const bf16* kb_ = (const bf16*)(R + R_K);
    const bf16* vT = (const bf16*)(R + R_VT); const bf16* vS = (const bf16*)(R + R_VS); const bf16* glu = (const bf16*)(R + R_GLU); bf16* ymix = (bf16*)(R + R_YMIX);
    { const float* src = IN(I_CCW) + (size_t)l * 31 * 256; LAS float* dst = (LAS float*)(lds + MX_WC);
#pragma unroll
      for (int it = 0; it < 6; ++it) { const int i4 = tid + it * NTHR, j = (i4 >> 6) - 8; const bool ok = j >= 0 && j <= 30; const f32x4 v = *(const f32x4*)(src + (ok ? j : 0) * 256 + (i4 & 63) * 4);
          *(LAS f32x4*)(dst + i4 * 4) = ok ? v : (f32x4){0.f, 0.f, 0.f, 0.f}; } }
    const float sink2 = IN(I_SINK)[l * 8 + w] * LOG2E;
    LAS float* ssb = (LAS float*)(lds + MX_SSB);
    __syncthreads();
#ifndef PROBE
#define PROBE 0
#endif
    for (int rep_ = 0; rep_ < (PROBE == 12 ? 2 : 1); ++rep_)
    for (int u = bx; u < NB * 256; u += G) {
        const int b = u >> 8, n = u & 255; const size_t row0 = (size_t)b * S + n * 64;
        u32x4 kreg[6], vreg[6];
#pragma unroll
        for (int it = 0; it < 6; ++it) {
            const int p = tid + it * NTHR, key = p >> 4, part = p & 15, pos = n * 64 - 128 + key;
            kreg[it] = *(const u32x4*)(kb_ + ((size_t)b * S + (pos >= 0 ? pos : 0)) * 128 + part * 8);
            const int rr = p / 24, pc = p % 24, pos0 = n * 64 - 128 + pc * 8;
            vreg[it] = *(const u32x4*)(vT + ((size_t)(b * 128 + rr)) * S + (pos0 >= 0 ? pos0 : 0));
        }
        const int t0 = w * 8, p0 = n * 64 + t0; const size_t brow = (size_t)b * S;
        auto ldP = [&](const bf16* base, int p) -> u32x2 { const u32x2 v = *(const u32x2*)(base + (brow + (p >= 0 ? p : 0)) * 256 + 4 * lane); return p >= 0 ? v : (u32x2){0u, 0u}; };
        u32x2 wa_[10], wg_[8], w0_[8], nw_[8];
#pragma unroll
        for (int i = 0; i < 10; ++i) wa_[i] = ldP(cv, p0 - 2 + i);
#pragma unroll
        for (int i = 0; i < 8; ++i) { wg_[i] = ldP(gb, p0 + i); w0_[i] = ldP(glu, p0 - 30 + i); nw_[i] = ldP(glu, p0 - 22 + i); }
#pragma unroll
        for (int it = 0; it < 6; ++it) {
            const int p = tid + it * NTHR, key = p >> 4, part = p & 15, pos = n * 64 - 128 + key;
            *(LAS u32x4*)(lds + (part >> 3) * MX_KSZ + key * 144 + (part & 7) * 16) = pos >= 0 ? kreg[it] : (u32x4){0u, 0u, 0u, 0u};
            const int rr = p / 24, pc = p % 24, pos0 = n * 64 - 128 + pc * 8; const u32x4 v = pos0 >= 0 ? vreg[it] : (u32x4){0u, 0u, 0u, 0u};
            LAS u32x2* d = (LAS u32x2*)(lds + MX_VOFF + rr * MX_VP + pc * 16); d[0] = (u32x2){v.x, v.y}; d[1] = (u32x2){v.z, v.w};
        }
        {
            const int ch = 4 * lane;
            const float* caw = IN(I_CAW) + (size_t)l * 3 * 256 + ch; const f32x4 wa0 = *(const f32x4*)caw, wa1 = *(const f32x4*)(caw + 256), wa2 = *(const f32x4*)(caw + 512);
            const LAS float* wc = (const LAS float*)(lds + MX_WC) + ch;
            const f32x4 bias = *(const f32x4*)(IN(I_CCB) + l * 256 + ch);
            const f32x4 lng = *(const f32x4*)(IN(I_LNG) + l * 256 + ch), lnb = *(const f32x4*)(IN(I_LNB) + l * 256 + ch);
            f32x4 accC[8], Rg[8];
#pragma unroll
            for (int t = 0; t < 8; ++t) { accC[t] = bias; Rg[t] = unpk4(w0_[t]); }
#pragma unroll 1
            for (int jb = 0; jb < 32; jb += 8) {
                u32x2 nx[8];
#pragma unroll
                for (int s = 0; s < 8; ++s) { const int i = jb + 16 + s; nx[s] = (i < 38) ? ldP(glu, p0 - 30 + i) : (u32x2){0u, 0u}; }
#pragma unroll
                for (int s = 0; s < 8; ++s) { const f32x4 wt = *(const LAS f32x4*)(wc + (jb + s + 8) * 256);
#pragma unroll
                    for (int t = 0; t < 8; ++t) accC[t] += wt * Rg[(t + s) & 7];
                    Rg[s] = unpk4(nw_[s]); }
#pragma unroll
                for (int s = 0; s < 8; ++s) nw_[s] = nx[s];
            }
            bf16* yrow = ymix + (brow + p0) * D;
#pragma unroll
            for (int t = 0; t < 8; ++t) {
                const f32x4 ya = unpk4(wg_[t]) * (wa0 * unpk4(wa_[t]) + wa1 * unpk4(wa_[t + 1]) + wa2 * unpk4(wa_[t + 2]));
                const float ssa = wave_sum((ya[0] * ya[0] + ya[1] * ya[1]) + (ya[2] * ya[2] + ya[3] * ya[3]));
                st4bf(yrow + (size_t)t * D + ch, ya * rsqrtf(ssa * (1.f / 256) + EPS));
                const f32x4 cc = accC[t];
                const float mean = wave_sum((cc[0] + cc[1]) + (cc[2] + cc[3])) * (1.f / 256); const f32x4 dc = cc - mean;
                const float var = wave_sum((dc[0] * dc[0] + dc[1] * dc[1]) + (dc[2] * dc[2] + dc[3] * dc[3])) * (1.f / 256);
                const f32x4 ln = dc * rsqrtf(var + EPS) * lng + lnb; f32x4 yc;
#pragma unroll
                for (int e = 0; e < 4; ++e) yc[e] = ln[e] * sigmoidf_(ln[e]);
                const float ssc = wave_sum((yc[0] * yc[0] + yc[1] * yc[1]) + (yc[2] * yc[2] + yc[3] * yc[3]));
                st4bf(yrow + (size_t)t * D + 768 + ch, yc * rsqrtf(ssc * (1.f / 256) + EPS));
            }
        }
        __syncthreads();
        const int kvh = w >> 2, kb0 = n >= 2 ? 0 : (2 - n) * 2;
        const LAS unsigned char* Kl = lds + kvh * MX_KSZ + r * 144 + hf * 16; const LAS unsigned char* Vl = lds + MX_VOFF + (kvh * 64 + r) * MX_VP + hf * 8;
#pragma unroll 1
        for (int qb = 0; qb < (PROBE == 17 ? 4 : 2); ++qb) {
            f32x16 o[2]; attn_qb<false>(Kl, Vl, qb_ + (row0 + (qb & 1) * 32 + r) * 512 + w * 64 + hf * 8, sink2, kb0, o);
            float sq = 0.f;
#pragma unroll
            for (int hb = 0; hb < 2; ++hb)
#pragma unroll
                for (int i = 0; i < 16; ++i) sq += o[hb][i] * o[hb][i];
            sq += __shfl_xor(sq, 32);
            if (hf == 0) ssb[((qb & 1) * 8 + w) * 32 + r] = sq;
            __syncthreads();
            float tot = 0.f;
#pragma unroll
            for (int hh = 0; hh < 8; ++hh) tot += ssb[((qb & 1) * 8 + hh) * 32 + r];
            const float rs = rsqrtf(tot * (1.f / 512) + EPS); bf16* yp = ymix + (row0 + (qb & 1) * 32 + r) * D + 256 + w * 64 + 4 * hf;
#pragma unroll
            for (int hb = 0; hb < 2; ++hb)
#pragma unroll
                for (int g = 0; g < 4; ++g) st4bf(yp + hb * 32 + 8 * g, (f32x4){o[hb][4 * g] * rs, o[hb][4 * g + 1] * rs, o[hb][4 * g + 2] * rs, o[hb][4 * g + 3] * rs});
        }
        __syncthreads();
    }
    for (int rep_ = 0; rep_ < ((PROBE == 13 || PROBE == 14) ? 2 : 1); ++rep_)
    for (int sb = bx - (G - 32); sb >= 0 && sb < 16; sb += G) {
        const size_t srow0 = (size_t)MP + sb * 16;
        const int t0 = w * 2; const float* sa = IN(I_SA) + ((size_t)(l * 16 + sb) * 2) * 256; const float* sc = IN(I_SC) + ((size_t)(l * 16 + sb) * 30) * 256;
        auto ldA = [&](int i) -> f32x4 { const int p = t0 - 2 + i; return p >= 0 ? ld4bf(cv + (srow0 + p) * 256 + 4 * lane) : *(const f32x4*)(sa + (2 + p) * 256 + 4 * lane); };
        auto ldC = [&](int i) -> f32x4 { const int p = t0 - 30 + i; return p >= 0 ? ld4bf(glu + (srow0 + p) * 256 + 4 * lane) : *(const f32x4*)(sc + (30 + p) * 256 + 4 * lane); };
        auto ldG = [&](int t) -> f32x4 { return ld4bf(gb + (srow0 + t0 + t) * 256 + 4 * lane); };
        conv_tokens<2>(l, lds, lane, ldA, ldC, ldC, ldG, ymix + (srow0 + t0) * D);
        float* oc = out + O_CS + ((size_t)(l * 16 + sb) * 30) * 256;
        for (int i = tid; i < 14 * 256; i += NTHR) oc[i] = sc[16 * 256 + i];
    }
    __syncthreads();
    for (int rep_ = 0; rep_ < ((PROBE == 13 || PROBE == 15) ? 2 : 1); ++rep_)
    for (int sb = bx - (G - 16); sb >= 0 && sb < 16; sb += G) {
        const size_t srow0 = (size_t)MP + sb * 16;
        const float* ck = IN(I_CK) + ((size_t)(l * 16 + sb) * 128) * 128; const float* cvv = IN(I_CV) + ((size_t)(l * 16 + sb) * 128) * 128;
        f32x4 kr_[8], vr_[8];
#pragma unroll
        for (int it = 0; it < 8; ++it) { const int i = tid + it * NTHR; kr_[it] = *(const f32x4*)(ck + (size_t)i * 4); vr_[it] = *(const f32x4*)(cvv + (size_t)i * 4); }
        u32x4 kn_ = (u32x4){0u, 0u, 0u, 0u}, vn_ = kn_;
        if (tid < 256) { kn_ = *(const u32x4*)(kb_ + (srow0 + (tid >> 4)) * 128 + (tid & 15) * 8); vn_ = *(const u32x4*)(vS + ((size_t)sb * 16 + (tid >> 4)) * 128 + (tid & 15) * 8); }
        for (int i = tid; i < 128 * 12; i += NTHR) { const int rr = i / 12, pc = i % 12; *(LAS u32x2*)(lds + MX_VOFF + rr * MX_VP + 288 + pc * 8) = (u32x2){0u, 0u}; }
#pragma unroll
        for (int it = 0; it < 8; ++it) {
            const int i = tid + it * NTHR, key = i >> 5, c = (i & 31) * 4;
            *(LAS u32x2*)(lds + (c >> 6) * MX_KSZ + key * 144 + (c & 63) * 2) = (u32x2){pk2(kr_[it][0], kr_[it][1]), pk2(kr_[it][2], kr_[it][3])};
#pragma unroll
            for (int e = 0; e < 4; ++e) *(LAS bf16*)(lds + MX_VOFF + (c + e) * MX_VP + key * 2) = f2bf(vr_[it][e]);
        }
        if (tid < 256) {
            const int key = 128 + (tid >> 4), part = tid & 15;
            *(LAS u32x4*)(lds + (part >> 3) * MX_KSZ + key * 144 + (part & 7) * 16) = kn_;
            const unsigned vw[4] = {vn_.x, vn_.y, vn_.z, vn_.w};
#pragma unroll
            for (int e = 0; e < 8; ++e) *(LAS bf16*)(lds + MX_VOFF + (part * 8 + e) * MX_VP + key * 2) = (bf16)((vw[e >> 1] >> ((e & 1) * 16)) & 0xffffu);
        }
        __syncthreads();
        {
            const int kvh = w >> 2, tq = r & 15;
            const LAS unsigned char* Kl = lds + kvh * MX_KSZ + r * 144 + hf * 16; const LAS unsigned char* Vl = lds + MX_VOFF + (kvh * 64 + r) * MX_VP + hf * 8;
            f32x16 o[2]; attn_qb<true>(Kl, Vl, qb_ + (srow0 + tq) * 512 + w * 64 + hf * 8, sink2, 0, o);
            float sq = 0.f;
#pragma unroll
            for (int hb = 0; hb < 2; ++hb)
#pragma unroll
                for (int i = 0; i < 16; ++i) sq += o[hb][i] * o[hb][i];
            sq += __shfl_xor(sq, 32);
            if (hf == 0) ssb[w * 32 + r] = sq;
            __syncthreads();
            float tot = 0.f;
#pragma unroll
            for (int hh = 0; hh < 8; ++hh) tot += ssb[hh * 32 + r];
            const float rs = rsqrtf(tot * (1.f / 512) + EPS); bf16* yp = ymix + (srow0 + tq) * D + 256 + w * 64 + 4 * hf;
            if (r < 16) {
#pragma unroll
                for (int hb = 0; hb < 2; ++hb)
#pragma unroll
                    for (int g = 0; g < 4; ++g) st4bf(yp + hb * 32 + 8 * g, (f32x4){o[hb][4 * g] * rs, o[hb][4 * g + 1] * rs, o[hb][4 * g + 2] * rs, o[hb][4 * g + 3] * rs});
            }
        }
        __syncthreads();
    }
}

DI void xattn_sample(int wv, unsigned char* ws, float* out, int l, LAS unsigned char* lds, int G, int bx) {
    unsigned z_ = 0u; asm volatile("" : "+v"(z_)); const int tid_ = wv * 64 + (int)__builtin_amdgcn_mbcnt_hi(~0u, __builtin_amdgcn_mbcnt_lo(~0u, z_)); const int tid = tid_, w = __builtin_amdgcn_readfirstlane(tid >> 6), lane = tid & 63, fr = lane & 15, fq = lane >> 4;
    bf16* qx = (bf16*)(ws + WS_R + R_QX);
    LAS float* PS = (LAS float*)lds;
    LAS float* RM = (LAS float*)(lds + 16 * 260 * 4);
    for (int u = bx - (G - 64); u >= 0 && u < 64; u += G) {
        const int sb = u >> 2, h = u & 3; const size_t srow0 = (size_t)MP + sb * 16;
        const float* mk = IN(I_MK) + (((size_t)(l * 16 + sb) * 256) * 4 + h) * 256; const float* mv = IN(I_MV) + (((size_t)(l * 16 + sb) * 256) * 4 + h) * 256;
        f32x4 acc[2] = {(f32x4){0.f, 0.f, 0.f, 0.f}, (f32x4){0.f, 0.f, 0.f, 0.f}};
        const bf16* qp = qx + (srow0 + fr) * D + h * 256 + fq * 8;
#pragma unroll
        for (int ks = 0; ks < 8; ++ks) {
            const bf16x8 qf = *(const bf16x8*)(qp + ks * 32);
#pragma unroll
            for (int kbk = 0; kbk < 2; ++kbk) {
                const float* kp = mk + (size_t)(w * 32 + kbk * 16 + fr) * 1024 + ks * 32 + fq * 8; const f32x4 k0 = *(const f32x4*)kp, k1 = *(const f32x4*)(kp + 4);
                u32x4 kw; kw.x = pk2(k0[0], k0[1]); kw.y = pk2(k0[2], k0[3]); kw.z = pk2(k1[0], k1[1]); kw.w = pk2(k1[2], k1[3]);
                acc[kbk] = __builtin_amdgcn_mfma_f32_16x16x32_bf16(__builtin_bit_cast(bf16x8, kw), qf, acc[kbk], 0, 0, 0);
            }
        }
#pragma unroll
        for (int kbk = 0; kbk < 2; ++kbk)
#pragma unroll
            for (int i = 0; i < 4; ++i) PS[fr * 260 + w * 32 + kbk * 16 + 4 * fq + i] = acc[kbk][i];
        __syncthreads();
#pragma unroll
        for (int tt = 0; tt < 2; ++tt) { LAS float* sp = PS + (2 * w + tt) * 260; const f32x4 x = *(LAS f32x4*)(sp + 4 * lane);
            const float mx = wave_max(fmaxf(fmaxf(x[0], x[1]), fmaxf(x[2], x[3])));
            f32x4 e; for (int i = 0; i < 4; ++i) e[i] = __builtin_amdgcn_exp2f(x[i] - mx);
            const float inv = 1.f / wave_sum((e[0] + e[1]) + (e[2] + e[3]));
            for (int i = 0; i < 4; ++i) e[i] = bf2f(f2bf(e[i] * inv));
            *(LAS f32x4*)(sp + 4 * lane) = e; }
        __syncthreads();
        {
            f32x4 acc[16];
#pragma unroll
            for (int t = 0; t < 16; ++t) acc[t] = (f32x4){0.f, 0.f, 0.f, 0.f};
#pragma unroll 1
            for (int jb = 0; jb < 32; jb += 8) {
                f32x4 vv[8];
#pragma unroll
                for (int jj = 0; jj < 8; ++jj) vv[jj] = *(const f32x4*)(mv + (size_t)(w + 8 * (jb + jj)) * 1024 + 4 * lane);
#pragma unroll
                for (int jj = 0; jj < 8; ++jj) { const int key = w + 8 * (jb + jj);
#pragma unroll
                    for (int t = 0; t < 16; ++t) acc[t] += PS[t * 260 + key] * vv[jj]; }
            }
            LAS float* OP = (LAS float*)(lds + 32768);
#pragma unroll
            for (int half = 0; half < 2; ++half) {
#pragma unroll
                for (int tt = 0; tt < 8; ++tt) *(LAS f32x4*)(OP + (w * 8 + tt) * 256 + 4 * lane) = acc[half * 8 + tt];
                __syncthreads();
                f32x4 sum = (f32x4){0.f, 0.f, 0.f, 0.f};
#pragma unroll
                for (int ww = 0; ww < 8; ++ww) sum += *(LAS f32x4*)(OP + (ww * 8 + w) * 256 + 4 * lane);
                st4bf(qx + (srow0 + half * 8 + w) * D + h * 256 + 4 * lane, sum);
                __syncthreads();
            }
        }
    }
    (void)RM;
}

DI void final_norm(int wv, unsigned char* ws, float* out, LAS unsigned char* lds) {
    unsigned z_ = 0u; asm volatile("" : "+v"(z_)); const int tid_ = wv * 64 + (int)__builtin_amdgcn_mbcnt_hi(~0u, __builtin_amdgcn_mbcnt_lo(~0u, z_)); const int tid = tid_, w = __builtin_amdgcn_readfirstlane(tid >> 6), lane = tid & 63, gw = blockIdx.x * 8 + w, NGW = gridDim.x * 8;
    const bf16* xb = (const bf16*)(ws + WS_XB); const float* ss = (const float*)(ws + WS_SS) + (size_t)8 * MT * 16; const float* g = IN(I_FIN);
    f32x4 gv[4];
#pragma unroll
    for (int j = 0; j < 4; ++j) gv[j] = *((const f32x4*)g + lane + 64 * j);
    for (int m0 = gw; m0 < MT; m0 += 4 * NGW) {
        u32x2 xr[4][4]; f32x4 sq[4][4];
#pragma unroll
        for (int r = 0; r < 4; ++r) { const int m = m0 + r * NGW; if (m < MT) {
#pragma unroll
            for (int j = 0; j < 4; ++j) { xr[r][j] = *(const u32x2*)(xb + (size_t)m * D + 4 * (lane + 64 * j)); sq[r][j] = *((const f32x4*)(ss + (size_t)m * 16) + j); } } }
#pragma unroll
        for (int r = 0; r < 4; ++r) { const int m = m0 + r * NGW; if (m < MT) {
            const f32x4 a = sq[r][0], b = sq[r][1], c = sq[r][2], d = sq[r][3];
            const float rs = rsqrtf(((((a[0] + a[1]) + (a[2] + a[3])) + ((b[0] + b[1]) + (b[2] + b[3]))) + (((c[0] + c[1]) + (c[2] + c[3])) + ((d[0] + d[1]) + (d[2] + d[3])))) * (1.f / D) + EPS);
            float* o = out + (m < MP ? O_YP + (size_t)m * D : O_YS + (size_t)(m - MP) * D);
#pragma unroll
            for (int j = 0; j < 4; ++j) *((f32x4*)o + lane + 64 * j) = unpk4(xr[r][j]) * rs * gv[j]; } }
    }
}

#ifndef EN
#define EN 0xFFFFF
#endif
#ifndef ONE_LAUNCH
#define ONE_LAUNCH 1
#endif
constexpr int N_PHASES = 24;

template <int NM, int NN, size_t A_M, size_t A_N, size_t B_B, size_t B_N, int BSHIFT, class F>
DI void run_gemm(int wv, LAS unsigned char* lds, int G, int bx, const bf16* A_, int lda, const bf16* Bt, int ldb, int K, const F& f) {
    pg8::Gemm g{A_, Bt, lda, ldb, K, wv}; pg8::Sched<NM, NN, A_M, A_N, B_B, B_N, BSHIFT> Sc; Sc.G = G; Sc.c = bx;
    EpiA<F> E{f};
    pg8::gemm_phase<EpiA<F>, pg8::Sched<NM, NN, A_M, A_N, B_B, B_N, BSHIFT>, true, true>(lds, g, Sc, E);
}
template <int K, int N, class F> DI void prompt_gemm(int wv, LAS unsigned char* lds, int G, int bx, const bf16* A_, const bf16* Bt, const F& f) {
    run_gemm<MP / 256, N / 256, (size_t)256 * K * 2, 0, 0, (size_t)256 * K * 2, 31>(wv, lds, G, bx, A_, K, Bt, K, K, f);
}


#define XB_TMO      128
#define XB_XCNT(j)  (256  + 64 * (j))
#define XB_XSUB(j)  (1280 + 64 * (j))
#define XB_XGEN(j)  (2304 + 64 * (j))
#define XB_TOP      3328
#define XB_TOPGEN   3392
#define XCD_BAR_WORDS 3456
#define XB_SPIN_CAP (1u << 18)
DI unsigned xb_ld(unsigned* p)              { return __hip_atomic_load(p, __ATOMIC_RELAXED, __HIP_MEMORY_SCOPE_AGENT); }
DI unsigned xb_add(unsigned* p, unsigned v) { return __hip_atomic_fetch_add(p, v, __ATOMIC_RELAXED, __HIP_MEMORY_SCOPE_AGENT); }
DI unsigned xb_xcc_id() { return (unsigned)__builtin_amdgcn_s_getreg((3 << 11) | 20) & 0xFu; }
#define XB_SPIN(cond, bar) do { unsigned _sp = 0; while (cond) { __builtin_amdgcn_s_sleep(1); \
    if ((++_sp & 255u) == 0u) { if (xb_ld(&(bar)[XB_TMO])) break; if (_sp > XB_SPIN_CAP) { atomicAdd(&(bar)[XB_TMO], 1u); break; } } } } while (0)
DI void xcd_barrier_complete(unsigned* bar, unsigned x, unsigned G, unsigned& nloc, unsigned& nx) {
    unsigned sum, cnt, mine, sp = 0u;
    for (;;) {
        sum = 0u; cnt = 0u; mine = 0u;
#pragma unroll
        for (unsigned j = 0; j < 16; ++j) { const unsigned c = xb_ld(&bar[XB_XCNT(j)]); sum += c; cnt += (c > 0u) ? 1u : 0u; mine = (j == x) ? c : mine; }
        if (sum == G) break;
        __builtin_amdgcn_s_sleep(1);
        if ((++sp & 255u) == 0u) { if (xb_ld(&bar[XB_TMO])) break; if (sp > XB_SPIN_CAP) { atomicAdd(&bar[XB_TMO], 1u); break; } }
    }
    nloc = mine > 0u ? mine : 1u; nx = cnt > 0u ? cnt : 1u;
}
DI void xcd_barrier(unsigned* bar, volatile LAS unsigned* st, bool first_thread, unsigned G) {
    asm volatile("s_waitcnt vmcnt(0)" ::: "memory");
    __syncthreads();
    if (first_thread) {
        const unsigned x = xb_xcc_id();
        __builtin_amdgcn_s_waitcnt(0);
        unsigned nloc = st[0], nx = st[1];
        if (nloc == 0u) { xcd_barrier_complete(bar, x, G, nloc, nx); st[0] = nloc; st[1] = nx; }
        const unsigned old = xb_add(&bar[XB_XSUB(x)], 1u);
        const unsigned gen = old / nloc;
        if (old + 1u == (gen + 1u) * nloc) {
            __builtin_amdgcn_fence(__ATOMIC_RELEASE, "agent");
            asm volatile("s_waitcnt vmcnt(0)" ::: "memory");
            const unsigned og = xb_add(&bar[XB_TOP], 1u);
            const unsigned tg = og / nx;
            if (og + 1u == (tg + 1u) * nx) xb_add(&bar[XB_TOPGEN], 1u);
            else XB_SPIN(xb_ld(&bar[XB_TOPGEN]) == tg, bar);
            __builtin_amdgcn_fence(__ATOMIC_ACQUIRE, "agent");
            xb_add(&bar[XB_XGEN(x)], 1u);
            asm volatile("s_waitcnt vmcnt(0)" ::: "memory");
        } else {
            XB_SPIN(xb_ld(&bar[XB_XGEN(x)]) == gen, bar);
            __builtin_amdgcn_fence(__ATOMIC_ACQUIRE, "agent");
            asm volatile("s_waitcnt vmcnt(0)" ::: "memory");
        }
    }
    __syncthreads();
}

__global__ void __launch_bounds__(NTHR, 2) fwd_kernel(Args A) {
    extern __shared__ __attribute__((aligned(16))) unsigned char lds_raw[];
    LAS unsigned char* lds = (LAS unsigned char*)lds_raw;
    const int lo = A.ph_lo, hi = A.ph_hi; const int wv = __builtin_amdgcn_readfirstlane((int)threadIdx.x >> 6);
    unsigned char* ws = A.ws; float* out = A.out;
    if (threadIdx.x == 0) { LAS unsigned long long* T = (LAS unsigned long long*)(lds + LDS_TAB);
        T[0] = (unsigned long long)A.in[0];
        T[1] = (unsigned long long)A.in[1];
        T[2] = (unsigned long long)A.in[2];
        T[3] = (unsigned long long)A.in[3];
        T[4] = (unsigned long long)A.in[4];
        T[5] = (unsigned long long)A.in[5];
        T[6] = (unsigned long long)A.in[6];
        T[7] = (unsigned long long)A.in[7];
        T[8] = (unsigned long long)A.in[8];
        T[9] = (unsigned long long)A.in[9];
        T[10] = (unsigned long long)A.in[10];
        T[11] = (unsigned long long)A.in[11];
        T[12] = (unsigned long long)A.in[12];
        T[13] = (unsigned long long)A.in[13];
        T[14] = (unsigned long long)A.in[14];
        T[15] = (unsigned long long)A.in[15];
        T[16] = (unsigned long long)A.in[16];
        T[17] = (unsigned long long)A.in[17];
        T[18] = (unsigned long long)A.in[18];
        T[19] = (unsigned long long)A.in[19];
        T[20] = (unsigned long long)A.in[20];
        T[21] = (unsigned long long)A.in[21];
        T[22] = (unsigned long long)A.in[22];
        T[23] = (unsigned long long)A.in[23];
        T[24] = (unsigned long long)A.in[24];
        T[25] = (unsigned long long)A.in[25];
        T[26] = (unsigned long long)A.in[26];
        T[27] = (unsigned long long)A.in[27];
        T[28] = (unsigned long long)A.in[28];
        T[29] = (unsigned long long)A.in[29];
        T[30] = (unsigned long long)A.in[30];
        T[31] = (unsigned long long)A.in[31];
        T[32] = (unsigned long long)A.in[32];
        T[33] = (unsigned long long)A.in[33];
        *(LAS unsigned*)(lds + LDS_TAB + 384) = 0u; *(LAS unsigned*)(lds + LDS_TAB + 388) = 0u;
        (void)xb_add(&((unsigned*)ws)[XB_XCNT(xb_xcc_id())], 1u);
    }
    __syncthreads();
#ifndef CG_ALL
#define CG_ALL 0
#endif
#define SYNC(ph) do { if ((ph) + 1 < hi) { if (CG_ALL || (ph) == 0) cg::this_grid().sync(); else for (int rb_ = 0; rb_ < (PROBE == 16 ? 2 : 1); ++rb_) { unsigned z2_ = 0u; asm volatile("" : "+v"(z2_)); const bool ft_ = wv == 0 && __builtin_amdgcn_mbcnt_hi(~0u, __builtin_amdgcn_mbcnt_lo(~0u, z2_)) == 0u; xcd_barrier((unsigned*)ws, (volatile LAS unsigned*)(lds + LDS_TAB + 384), ft_, gridDim.x); } } } while (0)
    if (lo == 0) { if (EN & 0x10000) prologue(wv, ws, out, lds); __syncthreads();
#if PROBE == 3
        prologue(wv, ws, out, lds); __syncthreads();
#endif
        SYNC(0); }
    for (int ph = (lo > 1 ? lo : 1); ph < (hi < N_PHASES - 1 ? hi : N_PHASES - 1); ++ph) {
        int G = gridDim.x, bx = blockIdx.x; asm volatile("" : "+s"(G), "+s"(bx), "+s"(out));
        const int smp_c0 = (bx + G / 2) % G;
        const int l = (ph - 1) / 11, k = (ph - 1) % 11;
        asm volatile("" : "+s"(ws));
        unsigned char* R = ws + WS_R; bf16* xb = (bf16*)(ws + WS_XB); float* ss = (float*)(ws + WS_SS); bf16* hb = (bf16*)(R + R_H);
        unsigned char* wl = ws + WS_W + (size_t)l * LW;
        float* ssl = ss + (size_t)(4 * l) * MT * 16;
        if (!((EN >> k) & 1)) continue;
        switch (k) {
        case 0: case 9: {
            const bool second = k == 9;
            if (!second) {
                FMemKV f{out + O_MK + (size_t)l * 512 * D, out + O_MV + (size_t)l * 512 * D, (bf16*)(ws + WS_MKB) + (size_t)l * 512 * D, (bf16*)(ws + WS_MVT) + (size_t)l * 8 * 65536};
                run_gemm<2, 8, (size_t)256 * D * 2, 0, 0, (size_t)256 * D * 2, 31>(wv, lds, G, bx, (const bf16*)(ws + WS_MN), D, (const bf16*)(wl + W_KV), D, D, f);
                __syncthreads();
            }
            FUp f{ssl + (second ? 3 : 0) * (size_t)MT * 16, hb, (LAS float*)(lds + LDS_EPI)};
#if PROBE == 11
            { FUpCheap f0{hb}; prompt_gemm<D, 2 * FF>(wv, lds, G, bx, xb, (const bf16*)(wl + (second ? W_2 : W_1)), f0); __syncthreads(); }
#endif
            prompt_gemm<D, 2 * FF>(wv, lds, G, bx, xb, (const bf16*)(wl + (second ? W_2 : W_1)), f);
#if PROBE == 1
            __syncthreads(); prompt_gemm<D, 2 * FF>(wv, lds, G, bx, xb, (const bf16*)(wl + (second ? W_2 : W_1)), f);
#endif
            __syncthreads();
            sample_gemm_wide(wv, lds, xb, (const bf16*)(wl + (second ? W_2 : W_1)), 2 * FF / 256, f, G, smp_c0);
        } break;
        case 1: case 10: {
            const bool second = k == 10;
            FRes f{xb, ssl + (second ? 4 : 1) * (size_t)MT * 16, 0.5f};
#if PROBE == 4
            { FRes f0{xb, ssl + (second ? 4 : 1) * (size_t)MT * 16, 0.0f}; prompt_gemm<FF, D>(wv, lds, G, bx, hb, (const bf16*)(wl + (second ? W_D2 : W_D1)), f0); __syncthreads(); }
#endif
            prompt_gemm<FF, D>(wv, lds, G, bx, hb, (const bf16*)(wl + (second ? W_D2 : W_D1)), f);
            __syncthreads();
            sample_gemm<FF>(wv, lds, hb, FF, (const bf16*)(wl + (second ? W_D2 : W_D1)), FF, D / 256, f, G, smp_c0);
        } break;
        case 2: {
            FWin f{ssl + (size_t)MT * 16, ws, out, l, (LAS float*)(lds + LDS_EPI)};
            prompt_gemm<D, 2048>(wv, lds, G, bx, xb, (const bf16*)(wl + W_IN), f);
#if PROBE == 8
            __syncthreads(); prompt_gemm<D, 2048>(wv, lds, G, bx, xb, (const bf16*)(wl + W_IN), f);
#endif
            __syncthreads();
            sample_gemm_wide(wv, lds, xb, (const bf16*)(wl + W_IN), 8, f, G, smp_c0);
        } break;
        case 3: mixer_phase(wv, ws, out, l, lds, G, bx);
#if PROBE == 2
            __syncthreads(); mixer_phase(wv, ws, out, l, lds, G, bx);
#endif
            break;
        case 4: case 8: {
            const bool xo = k == 8;
            FRes f{xb, ssl + (xo ? 3 : 2) * (size_t)MT * 16, 1.0f};
            const bf16* Ain = xo ? (const bf16*)(R + R_QX) : (const bf16*)(R + R_YMIX);
            prompt_gemm<D, D>(wv, lds, G, bx, Ain, (const bf16*)(wl + (xo ? W_O : W_OUT)), f);
            __syncthreads();
            sample_gemm<D>(wv, lds, Ain, D, (const bf16*)(wl + (xo ? W_O : W_OUT)), D, 4, f, G, smp_c0);
        } break;
        case 5: {
            FScale f{ssl + 2 * (size_t)MT * 16, (bf16*)(R + R_QX), 0.0625f * LOG2E, (LAS float*)(lds + LDS_EPI)};
            prompt_gemm<D, D>(wv, lds, G, bx, xb, (const bf16*)(wl + W_Q), f);
#if PROBE == 5
            __syncthreads(); prompt_gemm<D, D>(wv, lds, G, bx, xb, (const bf16*)(wl + W_Q), f);
#endif
            __syncthreads();
            sample_gemm<D>(wv, lds, xb, D, (const bf16*)(wl + W_Q), D, 4, f, G, smp_c0);
#if PROBE == 10
            sample_gemm<D>(wv, lds, xb, D, (const bf16*)(wl + W_Q), D, 4, f, G, smp_c0);
#endif
        } break;
        case 6: {
            pg8::Gemm g{(const bf16*)(R + R_QX), (const bf16*)(ws + WS_MKB) + (size_t)l * 512 * D, D, D, 256, wv};
            typedef pg8::Sched<MP / 256, 4, (size_t)256 * D * 2, 512, (size_t)256 * D * 2, 512, 6> SchS; SchS Sc; Sc.G = G; Sc.c = bx;
            EpiS E{(bf16*)(R + R_P), (float*)(ws + WS_LINV), (LAS float*)(lds + LDS_EPI)};
            pg8::gemm_phase<EpiS, SchS, true, true>(lds, g, Sc, E);
#if PROBE == 9
            __syncthreads(); pg8::gemm_phase<EpiS, SchS, true, true>(lds, g, Sc, E);
#endif
            __syncthreads();
            xattn_sample(wv, ws, out, l, lds, G, bx);
            asm volatile("s_waitcnt vmcnt(0)" ::: "memory"); __syncthreads();
            FPV f{(const float*)(ws + WS_LINV), (bf16*)(R + R_QX)};
            run_gemm<MP / 256, 4, (size_t)256 * D * 2, 512, (size_t)4 * 65536 * 2, (size_t)65536 * 2, 6>(wv, lds, G, bx, (const bf16*)(ws + WS_R + R_P), D, (const bf16*)(ws + WS_MVT) + (size_t)l * 8 * 65536, 256, 256, f);
#if PROBE == 9
            __syncthreads();
            run_gemm<MP / 256, 4, (size_t)256 * D * 2, 512, (size_t)4 * 65536 * 2, (size_t)65536 * 2, 6>(wv, lds, G, bx, (const bf16*)(ws + WS_R + R_P), D, (const bf16*)(ws + WS_MVT) + (size_t)l * 8 * 65536, 256, 256, f);
#endif
        } break;
        case 7: break;
        }
        __syncthreads();
        if (k != 6) SYNC(ph);
    }
    if (hi == N_PHASES) { if (EN & 0x20000) final_norm(wv, ws, out, lds); }
#undef SYNC
}

extern "C" void kernel_launch(void* const* d_in, const int* in_sizes, int n_in, void* d_out, int out_size, void* d_ws, size_t ws_size, hipStream_t stream) {
    static int grid = 0;
    if (grid == 0) {
        if (n_in != 34 || (size_t)out_size != O_END || ws_size < WS_END) { fprintf(stderr, "kernel_launch: unexpected shapes n_in %d out %d ws %zu (need %zu)\n", n_in, out_size, ws_size, (size_t)WS_END); grid = -1; return; }
        int dev = 0, cus = 0, per_cu = 0;
        hipGetDevice(&dev); hipDeviceGetAttribute(&cus, hipDeviceAttributeMultiprocessorCount, dev);
        if (hipFuncSetAttribute((const void*)fwd_kernel, hipFuncAttributeMaxDynamicSharedMemorySize, LDS_BYTES) != hipSuccess) { fprintf(stderr, "kernel_launch: hipFuncSetAttribute failed\n"); grid = -1; return; }
        if (hipOccupancyMaxActiveBlocksPerMultiprocessor(&per_cu, (const void*)fwd_kernel, NTHR, LDS_BYTES) != hipSuccess || per_cu < 1) { fprintf(stderr, "kernel_launch: occupancy query says %d\n", per_cu); per_cu = 1; }
        (void)hipGetLastError();
        grid = cus;
    }
    if (grid < 0) return;
    Args a{};
    for (int i = 0; i < 34; ++i) a.in[i] = (const float*)d_in[i];
    a.out = (float*)d_out; a.ws = (unsigned char*)d_ws;
    if (hipMemsetAsync(d_ws, 0, 16384, stream) != hipSuccess) { fprintf(stderr, "kernel_launch: memset failed\n"); return; }
#if ONE_LAUNCH
    a.ph_lo = 0; a.ph_hi = N_PHASES;
    void* args[] = {&a};
    hipError_t e = hipLaunchCooperativeKernel((const void*)fwd_kernel, dim3(grid), dim3(NTHR), args, LDS_BYTES, stream);
    if (e != hipSuccess) fprintf(stderr, "cooperative launch failed: %s (grid %d)\n", hipGetErrorString(e), grid);
#else
    for (int ph = 0; ph < N_PHASES; ++ph) { a.ph_lo = ph; a.ph_hi = ph + 1; hipLaunchKernelGGL(fwd_kernel, dim3(grid), dim3(NTHR), LDS_BYTES, stream, a); }
#endif
}
```
